# Optimizing an MI355X kernel written in HIP

```python
import math
import jax, jax.numpy as jnp
from jax import lax
import numpy as np

D_MODEL = 1024
BATCH = 2
SEQ = 8192
DEPTH = 2

N_MIXERS = 2
ATTN_HEADS = 16
ATTN_HEAD_DIM = D_MODEL // ATTN_HEADS
ROT_DIM = ATTN_HEAD_DIM // 4
ROPE_THETA = 500000.0
MOBA_BLOCK = 256
MOBA_TOPK = 3
Q_CHUNK = 64
MLSTM_HEADS = 8
MLSTM_QK_DIM = D_MODEL // (2 * MLSTM_HEADS)
MLSTM_V_DIM = D_MODEL // MLSTM_HEADS
MLSTM_CHUNK = 64
GATE_SOFTCAP = 15.0
MLSTM_IN_WIDTH = 2 * MLSTM_HEADS * MLSTM_QK_DIM + MLSTM_HEADS * MLSTM_V_DIM + D_MODEL + 2 * MLSTM_HEADS
D_FF = ((8 * D_MODEL + 3 * 256 - 1) // (3 * 256)) * 256
RMS_EPS = 1e-6

kernel_name = "hybrid_moba_mlstm_swiglu"


def rmsnorm(x, w):
    xf = x.astype(jnp.float32)
    y = xf * lax.rsqrt(jnp.mean(xf * xf, axis=-1, keepdims=True) + RMS_EPS)
    return (y * w.astype(jnp.float32)).astype(x.dtype)


def rotary_tables(seq):
    pos = jnp.arange(seq, dtype=jnp.float32)
    inv_freq = ROPE_THETA ** (-jnp.arange(0, ROT_DIM, 2, dtype=jnp.float32) / ROT_DIM)
    ang = pos[:, None] * inv_freq[None, :]
    return jnp.cos(ang), jnp.sin(ang)


def partial_rotary(x, cos, sin):
    xf = x.astype(jnp.float32)
    half = ROT_DIM // 2
    x1, x2, rest = xf[..., :half], xf[..., half:ROT_DIM], xf[..., ROT_DIM:]
    rot = jnp.concatenate([x1 * cos - x2 * sin, x2 * cos + x1 * sin, rest], axis=-1)
    return rot.astype(x.dtype)


def moba_attention(q, k, v):
    B, H, S, Dh = q.shape
    nb = -(-S // MOBA_BLOCK)
    pad = nb * MOBA_BLOCK - S
    kp = jnp.pad(k, ((0, 0), (0, 0), (0, pad), (0, 0)))
    vp = jnp.pad(v, ((0, 0), (0, 0), (0, pad), (0, 0)))
    kb = kp.reshape(B, H, nb, MOBA_BLOCK, Dh)
    vb = vp.reshape(B, H, nb, MOBA_BLOCK, Dh)
    kmean = jnp.mean(kb.astype(jnp.float32), axis=3)
    topk = min(MOBA_TOPK, nb)
    scale = Dh ** -0.5
    blk_ids = jnp.arange(nb)
    gather_blocks = jax.vmap(jax.vmap(lambda t, i: t[i]))

    def one_chunk(c):
        q0 = c * Q_CHUNK
        cur = q0 // MOBA_BLOCK
        qc = lax.dynamic_slice_in_dim(q, q0, Q_CHUNK, axis=2) * scale
        gate = jnp.einsum('bhqd,bhnd->bhqn', qc.astype(jnp.float32), kmean)
        gate = jnp.where(blk_ids[None, None, None, :] < cur, gate, -jnp.inf)
        _, sel = lax.top_k(gate, topk)
        valid = sel < cur
        kg = gather_blocks(kb, sel)
        vg = gather_blocks(vb, sel)
        s_sel = jnp.einsum('bhqd,bhqjkd->bhqjk', qc, kg, preferred_element_type=jnp.float32)
        s_sel = jnp.where(valid[..., None], s_sel, -jnp.inf).reshape(B, H, Q_CHUNK, topk * MOBA_BLOCK)
        k_own = lax.dynamic_index_in_dim(kb, cur, axis=2, keepdims=False)
        v_own = lax.dynamic_index_in_dim(vb, cur, axis=2, keepdims=False)
        s_own = jnp.einsum('bhqd,bhkd->bhqk', qc, k_own, preferred_element_type=jnp.float32)
        qpos = q0 + jnp.arange(Q_CHUNK)
        kpos = cur * MOBA_BLOCK + jnp.arange(MOBA_BLOCK)
        s_own = jnp.where(kpos[None, :] <= qpos[:, None], s_own, -jnp.inf)
        p = jax.nn.softmax(jnp.concatenate([s_sel, s_own], axis=-1), axis=-1)
        p_sel = p[..., :topk * MOBA_BLOCK].reshape(B, H, Q_CHUNK, topk, MOBA_BLOCK).astype(v.dtype)
        p_own = p[..., topk * MOBA_BLOCK:].astype(v.dtype)
        out = (jnp.einsum('bhqjk,bhqjkd->bhqd', p_sel, vg, preferred_element_type=jnp.float32)
               + jnp.einsum('bhqk,bhkd->bhqd', p_own, v_own, preferred_element_type=jnp.float32))
        return out.astype(q.dtype)

    outs = lax.map(one_chunk, jnp.arange(S // Q_CHUNK))
    return jnp.moveaxis(outs, 0, 2).reshape(B, H, S, Dh)


def moba_mixer(xn, w_qkv, w_o, cos, sin):
    B, S, _ = xn.shape
    qkv = jnp.einsum('bsd,de->bse', xn, w_qkv).reshape(B, S, 3, ATTN_HEADS, ATTN_HEAD_DIM)
    qkv = jnp.transpose(qkv, (2, 0, 3, 1, 4))
    q = partial_rotary(qkv[0], cos, sin)
    k = partial_rotary(qkv[1], cos, sin)
    o = moba_attention(q, k, qkv[2])
    o = jnp.transpose(o, (0, 2, 1, 3)).reshape(B, S, D_MODEL)
    return jnp.einsum('bsd,de->bse', o, w_o)


def mlstm_chunkwise(q, k, v, i_pre, f_pre):
    B, H, S, dk = q.shape
    dv = v.shape[-1]
    L = MLSTM_CHUNK
    NC = S // L
    qf = q.astype(jnp.float32).reshape(B, H, NC, L, dk) * (dk ** -0.5)
    kf = k.astype(jnp.float32).reshape(B, H, NC, L, dk)
    vf = v.astype(jnp.float32).reshape(B, H, NC, L, dv)
    logf = jax.nn.log_sigmoid(f_pre).reshape(B, H, NC, L)
    ig = i_pre.reshape(B, H, NC, L)
    b = jnp.cumsum(logf, axis=-1)
    bL = b[..., -1]
    causal = jnp.tril(jnp.ones((L, L), dtype=bool))
    dmat = jnp.where(causal, b[..., :, None] - b[..., None, :] + ig[..., None, :], -jnp.inf)
    m_intra = jnp.max(dmat, axis=-1)
    a = bL[..., None] - b + ig
    m_loc = jnp.max(a, axis=-1)
    w = jnp.exp(a - m_loc[..., None])
    c_loc = jnp.einsum('bhcl,bhclv,bhclk->bhcvk', w, vf, kf)
    n_loc = jnp.einsum('bhcl,bhclk->bhck', w, kf)

    def step(carry, inp):
        c_prev, n_prev, m_prev = carry
        c_l, n_l, m_l, bl = inp
        m_new = jnp.maximum(bl + m_prev, m_l)
        decay = jnp.exp(bl + m_prev - m_new)
        sc = jnp.exp(m_l - m_new)
        c_new = decay[..., None, None] * c_prev + sc[..., None, None] * c_l
        n_new = decay[..., None] * n_prev + sc[..., None] * n_l
        return (c_new, n_new, m_new), (c_prev, n_prev, m_prev)

    init = (jnp.zeros((B, H, dv, dk), jnp.float32), jnp.zeros((B, H, dk), jnp.float32),
            jnp.zeros((B, H), jnp.float32))
    xs = (jnp.moveaxis(c_loc, 2, 0), jnp.moveaxis(n_loc, 2, 0), jnp.moveaxis(m_loc, 2, 0),
          jnp.moveaxis(bL, 2, 0))
    _, (c_in, n_in, m_in) = lax.scan(step, init, xs)
    c_in = jnp.moveaxis(c_in, 0, 2)
    n_in = jnp.moveaxis(n_in, 0, 2)
    m_in = jnp.moveaxis(m_in, 0, 2)

    b_inter = b + m_in[..., None]
    m_t = jnp.maximum(b_inter, m_intra)
    inter = jnp.exp(b_inter - m_t)
    s_qk = jnp.einsum('bhcld,bhcsd->bhcls', qf, kf) * jnp.exp(dmat - m_t[..., None])
    num = (inter[..., None] * jnp.einsum('bhcld,bhcvd->bhclv', qf, c_in)
           + jnp.einsum('bhcls,bhcsv->bhclv', s_qk, vf))
    den = inter * jnp.einsum('bhcld,bhcd->bhcl', qf, n_in) + jnp.sum(s_qk, axis=-1)
    h = num / jnp.maximum(jnp.abs(den), jnp.exp(-m_t))[..., None]
    return h.reshape(B, H, S, dv)


def mlstm_mixer(xn, w_in, b_gates, head_norm, w_out):
    B, S, _ = xn.shape
    H, dk, dv = MLSTM_HEADS, MLSTM_QK_DIM, MLSTM_V_DIM
    proj = jnp.einsum('bsd,de->bse', xn, w_in)
    q_end = H * dk
    k_end = 2 * H * dk
    v_end = k_end + H * dv
    o_end = v_end + D_MODEL
    q = jnp.transpose(proj[..., :q_end].reshape(B, S, H, dk), (0, 2, 1, 3))
    k = jnp.transpose(proj[..., q_end:k_end].reshape(B, S, H, dk), (0, 2, 1, 3))
    v = jnp.transpose(proj[..., k_end:v_end].reshape(B, S, H, dv), (0, 2, 1, 3))
    o_gate = jax.nn.sigmoid(proj[..., v_end:o_end].astype(jnp.float32))
    gates = proj[..., o_end:].astype(jnp.float32) + b_gates.astype(jnp.float32)
    gates = GATE_SOFTCAP * jnp.tanh(gates / GATE_SOFTCAP)
    i_pre = jnp.transpose(gates[..., :H], (0, 2, 1))
    f_pre = jnp.transpose(gates[..., H:], (0, 2, 1))
    h = mlstm_chunkwise(q, k, v, i_pre, f_pre)
    h = h * lax.rsqrt(jnp.mean(h * h, axis=-1, keepdims=True) + RMS_EPS)
    h = jnp.transpose(h, (0, 2, 1, 3)).reshape(B, S, D_MODEL) * head_norm.astype(jnp.float32)
    y = (o_gate * h).astype(xn.dtype)
    return jnp.einsum('bsd,de->bse', y, w_out)


def swiglu(xn, w_gate_up, w_down):
    gu = jnp.einsum('bsd,df->bsf', xn, w_gate_up)
    g, u = gu[..., :D_FF], gu[..., D_FF:]
    return jnp.einsum('bsf,fd->bsd', jax.nn.silu(g) * u, w_down)


def setup_inputs(seed: int = 0) -> dict:
    key = jax.random.key(seed)
    ks = jax.random.split(key, 16)
    n_attn = (DEPTH + 1) // 2
    n_mlstm = DEPTH // 2
    out_scale = (2 * DEPTH) ** -0.5

    def dense(k, shape, fan_in, scale=1.0):
        return jax.random.normal(k, shape, jnp.float32) * (scale * fan_in ** -0.5)

    def gain(k, shape):
        return 1.0 + 0.02 * jax.random.normal(k, shape, jnp.float32)

    x = jax.random.normal(ks[0], (BATCH, SEQ, D_MODEL), jnp.float32)
    attn_norm = gain(ks[1], (n_attn, D_MODEL))
    attn_w_qkv = dense(ks[2], (n_attn, D_MODEL, 3 * D_MODEL), D_MODEL)
    attn_w_o = dense(ks[3], (n_attn, D_MODEL, D_MODEL), D_MODEL, out_scale)
    mlstm_norm = gain(ks[4], (n_mlstm, D_MODEL))
    mlstm_w_in = dense(ks[5], (n_mlstm, D_MODEL, MLSTM_IN_WIDTH), D_MODEL)
    i_bias = 0.1 * jax.random.normal(ks[6], (n_mlstm, MLSTM_HEADS), jnp.float32)
    f_bias = (jnp.linspace(3.0, 6.0, MLSTM_HEADS, dtype=jnp.float32)[None, :]
              + 0.1 * jax.random.normal(ks[7], (n_mlstm, MLSTM_HEADS), jnp.float32))
    mlstm_b_gates = jnp.concatenate([i_bias, f_bias], axis=-1)
    mlstm_head_norm = gain(ks[8], (n_mlstm, D_MODEL))
    mlstm_w_out = dense(ks[9], (n_mlstm, D_MODEL, D_MODEL), D_MODEL, out_scale)
    ffn_norm = gain(ks[10], (DEPTH, D_MODEL))
    ffn_w_gate_up = dense(ks[11], (DEPTH, D_MODEL, 2 * D_FF), D_MODEL)
    ffn_w_down = dense(ks[12], (DEPTH, D_FF, D_MODEL), D_FF, out_scale)
    final_norm = gain(ks[13], (D_MODEL,))
    return {"x": x, "attn_norm": attn_norm, "attn_w_qkv": attn_w_qkv, "attn_w_o": attn_w_o,
            "mlstm_norm": mlstm_norm, "mlstm_w_in": mlstm_w_in, "mlstm_b_gates": mlstm_b_gates,
            "mlstm_head_norm": mlstm_head_norm, "mlstm_w_out": mlstm_w_out,
            "ffn_norm": ffn_norm, "ffn_w_gate_up": ffn_w_gate_up, "ffn_w_down": ffn_w_down,
            "final_norm": final_norm}


def reference(x, attn_norm, attn_w_qkv, attn_w_o, mlstm_norm, mlstm_w_in, mlstm_b_gates,
              mlstm_head_norm, mlstm_w_out, ffn_norm, ffn_w_gate_up, ffn_w_down, final_norm):
    S = x.shape[1]
    cos, sin = rotary_tables(S)
    h = x
    for i in range(DEPTH):
        j = i // N_MIXERS
        if i % N_MIXERS == 0:
            h = h + moba_mixer(rmsnorm(h, attn_norm[j]), attn_w_qkv[j], attn_w_o[j], cos, sin)
        else:
            h = h + mlstm_mixer(rmsnorm(h, mlstm_norm[j]), mlstm_w_in[j], mlstm_b_gates[j],
                                mlstm_head_norm[j], mlstm_w_out[j])
        h = h + swiglu(rmsnorm(h, ffn_norm[i]), ffn_w_gate_up[i], ffn_w_down[i])
    return rmsnorm(h, final_norm)
```

```cpp
#include <hip/hip_runtime.h>
#include <cstdio>
#include <cstdint>
namespace pg8 {
#define PG8_LAS __attribute__((address_space(3)))
typedef unsigned short bf16_t;
typedef short bf16x8 __attribute__((ext_vector_type(8)));
typedef float f32x4 __attribute__((ext_vector_type(4)));
typedef unsigned u32x4 __attribute__((ext_vector_type(4)));
constexpr int BM = 256, BK = 64, HALF = 128, HTB = HALF * BK * 2  , STAGE_BYTES = 8 * HTB, NXCD = 8, WGM = 8;

__host__ __device__ __forceinline__ int lds_byte(int r, int c) { const int st = (r >> 4) * 2 + (c >> 5), rr = r & 15, cc = c & 31, ob = rr * 64 + cc * 2; return st * 1024 + (ob ^ (((ob >> 9) & 1) << 5)); }
__host__ __device__ __forceinline__ void stage_rc(int b, int& R, int& C) { const int st = b / 1024, sb = b % 1024, swz = sb ^ (((sb >> 9) & 1) << 5); R = (st >> 1) * 16 + swz / 64; C = (st & 1) * 32 + (swz % 64) / 2; }
__host__ __device__ __forceinline__ int perm32(int rho) { const int n = rho >> 4, i = rho & 15; return 8 * (i >> 2) + 4 * n + (i & 3); }

struct Unit { int pm, pn; };
struct Gemm { const bf16_t* A; const bf16_t* Bt; int M, N, K; };

struct StaticOrder {
    int nM, nN, nwg, G, c;
    __host__ __device__ void init(int M, int N, int G_, int c_) { nM = M / BM; nN = N / BM; nwg = nM * nN; G = G_; c = c_; }
    __host__ __device__ bool next(int i, Unit& u) const {
        const long L = (long)i * G + c; if (L >= nwg) return false;
        int wgid = (int)L; { const int q = nwg / NXCD, r = nwg % NXCD, xcd = wgid % NXCD, off = wgid / NXCD; wgid = (xcd < r ? xcd * (q + 1) : r * (q + 1) + (xcd - r) * q) + off; }
        const int nig = WGM * nN, gid = wgid / nig, fm = gid * WGM, gsz = (nM - fm) < WGM ? (nM - fm) : WGM;
        u.pm = fm + ((wgid % nig) % gsz); u.pn = (wgid % nig) / gsz; return true;
    }
    __device__ __forceinline__ void a_ready(const Unit&) const {}
    __device__ __forceinline__ void done(const Unit&) const {}
};
__device__ __forceinline__ unsigned cvt_pk_bf16(float lo, float hi) { unsigned r; asm volatile("v_cvt_pk_bf16_f32 %0, %1, %2" : "=v"(r) : "v"(lo), "v"(hi)); return r; }
typedef float f32x2 __attribute__((ext_vector_type(2)));
constexpr float RMS_EPS_F = 1e-6f;
constexpr float QSCALE_LOG2 = 0.18033688011112042f;
__device__ __forceinline__ float row_rstd(const float* ssq, int row) {
    const f32x4* p = (const f32x4*)(ssq + (size_t)row * 16);
    const f32x4 a = p[0], b = p[1], c = p[2], d = p[3];
    const float s = (((a[0] + a[1]) + (a[2] + a[3])) + ((b[0] + b[1]) + (b[2] + b[3]))) + (((c[0] + c[1]) + (c[2] + c[3])) + ((d[0] + d[1]) + (d[2] + d[3])));
    return __builtin_amdgcn_rsqf(s * (1.0f / 1024.0f) + RMS_EPS_F);
}
__device__ __forceinline__ u32x4 pack8(const f32x4& v0, const f32x4& v1) { u32x4 w; w.x = cvt_pk_bf16(v0[0], v0[1]); w.y = cvt_pk_bf16(v0[2], v0[3]); w.z = cvt_pk_bf16(v1[0], v1[1]); w.w = cvt_pk_bf16(v1[2], v1[3]); return w; }

struct EpiQKV {
    static constexpr bool PERM = true, AFTER_DRAIN = false;
    bf16_t* QKV; size_t tstride; const float* ssq; const float* rope; float* kmean;
    __device__ __forceinline__ void operator()(const f32x4 (&acc)[2][2][4][2], const Unit& u, int wr, int wc, int fr, int fq) const {
        const int t = u.pn >> 2;
        bf16_t* base = QKV + (size_t)t * tstride;
        const int col0 = (u.pn & 3) * BM + wc * 32 + 8 * fq;
        const bool rot = (t < 2) && ((wc & 1) == 0) && (fq < 2);
        const float sc = (t == 0) ? QSCALE_LOG2 : 1.0f;
        const int lane = fq * 16 + fr;
        float rv[2];
#pragma unroll
        for (int ai = 0; ai < 2; ++ai) rv[ai] = row_rstd(ssq, u.pm * BM + ai * HALF + wr * 64 + lane);
        f32x4 ks[2][2];
#pragma unroll
        for (int bj = 0; bj < 2; ++bj)
#pragma unroll
            for (int n = 0; n < 2; ++n) ks[bj][n] = (f32x4){0.f, 0.f, 0.f, 0.f};
#pragma unroll
        for (int ai = 0; ai < 2; ++ai)
#pragma unroll
            for (int m = 0; m < 4; ++m) {
                const int row = u.pm * BM + ai * HALF + wr * 64 + m * 16 + fr;
                const float rs = __shfl(rv[ai], m * 16 + fr);
                f32x4 c = (f32x4){1.f, 1.f, 1.f, 1.f}, s = (f32x4){0.f, 0.f, 0.f, 0.f};
                if (rot) { const f32x4* rp = (const f32x4*)(rope + (size_t)(row & 8191) * 16 + 8 * fq); const f32x4 cs0 = rp[0], cs1 = rp[1];
                    c = (f32x4){cs0[0], cs0[2], cs1[0], cs1[2]}; s = (f32x4){cs0[1], cs0[3], cs1[1], cs1[3]}; }
#pragma unroll
                for (int bj = 0; bj < 2; ++bj) {
                    f32x4 v0 = acc[ai][bj][m][0] * rs, v1 = acc[ai][bj][m][1] * rs;
                    if (rot) { const f32x4 x1 = v0, x2 = v1; v0 = x1 * c - x2 * s; v1 = x2 * c + x1 * s; }
                    if (t == 1) { ks[bj][0] += v0; ks[bj][1] += v1; }
                    v0 = v0 * sc; v1 = v1 * sc;
                    *(u32x4*)(base + (size_t)row * 1024 + col0 + bj * HALF) = pack8(v0, v1);
                }
                if (m & 1) asm volatile("" ::: "memory");
            }
        if (t == 1) {
            float* km = kmean + (size_t)u.pm * 1024 + col0;
#pragma unroll
            for (int bj = 0; bj < 2; ++bj)
#pragma unroll
                for (int n = 0; n < 2; ++n)
#pragma unroll
                    for (int j = 0; j < 4; ++j) {
                        float r = ks[bj][n][j]; r += __shfl_xor(r, 1); r += __shfl_xor(r, 2); r += __shfl_xor(r, 4); r += __shfl_xor(r, 8);
                        if (fr == 0) atomicAdd(km + bj * HALF + 4 * n + j, r * (1.0f / 256.0f));
                    }
        }
    }
};

template <bool WRITE_HB> struct EpiRes {
    static constexpr bool PERM = true, AFTER_DRAIN = false;
    const float* base; float* out; bf16_t* hb; float* ssq_out;
    __device__ __forceinline__ void operator()(const f32x4 (&acc)[2][2][4][2], const Unit& u, int wr, int wc, int fr, int fq) const {
        const int col0 = u.pn * BM + wc * 32 + 8 * fq;
#pragma unroll
        for (int ai = 0; ai < 2; ++ai)
#pragma unroll
            for (int m = 0; m < 4; ++m) {
                const int row = u.pm * BM + ai * HALF + wr * 64 + m * 16 + fr;
                float ss = 0.f;
#pragma unroll
                for (int bj = 0; bj < 2; ++bj) {
                    const size_t off = (size_t)row * 1024 + col0 + bj * HALF;
                    const f32x4 b0 = *(const f32x4*)(base + off), b1 = *(const f32x4*)(base + off + 4);
                    const f32x4 v0 = acc[ai][bj][m][0] + b0, v1 = acc[ai][bj][m][1] + b1;
                    *(f32x4*)(out + off) = v0; *(f32x4*)(out + off + 4) = v1;
                    ss += ((v0[0] * v0[0] + v0[1] * v0[1]) + (v0[2] * v0[2] + v0[3] * v0[3])) + ((v1[0] * v1[0] + v1[1] * v1[1]) + (v1[2] * v1[2] + v1[3] * v1[3]));
                    if (WRITE_HB) *(u32x4*)(hb + off) = pack8(v0, v1);
                }
                if (WRITE_HB) { ss += __shfl_xor(ss, 16); ss += __shfl_xor(ss, 32); if (fq == 0) ssq_out[(size_t)row * 16 + u.pn * 4 + wc] = ss; }
            }
    }
};

struct EpiSwiGLU {
    static constexpr bool PERM = true, AFTER_DRAIN = false;
    bf16_t* act; const float* ssq;
    __device__ __forceinline__ void operator()(const f32x4 (&acc)[2][2][4][2], const Unit& u, int wr, int wc, int fr, int fq) const {
        const int col0 = u.pn * HALF + wc * 32 + 8 * fq;
#pragma unroll
        for (int ai = 0; ai < 2; ++ai)
#pragma unroll
            for (int m = 0; m < 4; ++m) {
                const int row = u.pm * BM + ai * HALF + wr * 64 + m * 16 + fr;
                const float rs = row_rstd(ssq, row);
                f32x4 o[2];
#pragma unroll
                for (int n = 0; n < 2; ++n) {
                    const f32x4 g = acc[ai][0][m][n] * rs, up = acc[ai][1][m][n] * rs;
#pragma unroll
                    for (int j = 0; j < 4; ++j) { const float e = __builtin_amdgcn_exp2f(g[j] * -1.4426950408889634f); o[n][j] = g[j] * up[j] * __builtin_amdgcn_rcpf(1.0f + e); }
                }
                *(u32x4*)(act + (size_t)row * 2816 + col0) = pack8(o[0], o[1]);
            }
    }
};

struct EpiMlstmIn {
    static constexpr bool PERM = true, AFTER_DRAIN = false;
    bf16_t* MQ; bf16_t* MK; bf16_t* MV; bf16_t* OG; const float* ssq;
    __device__ __forceinline__ void operator()(const f32x4 (&acc)[2][2][4][2], const Unit& u, int wr, int wc, int fr, int fq) const {
        bf16_t* base; int ld, colt; float sc = 1.0f; bool sig = false;
        if (u.pn < 2) { base = MQ; ld = 512; colt = u.pn * BM; sc = 0.125f; }
        else if (u.pn < 4) { base = MK; ld = 512; colt = (u.pn - 2) * BM; }
        else if (u.pn < 8) { base = MV; ld = 1024; colt = (u.pn - 4) * BM; }
        else { base = OG; ld = 1024; colt = (u.pn - 8) * BM; sig = true; }
        const int col0 = colt + wc * 32 + 8 * fq;
#pragma unroll
        for (int ai = 0; ai < 2; ++ai)
#pragma unroll
            for (int m = 0; m < 4; ++m) {
                const int row = u.pm * BM + ai * HALF + wr * 64 + m * 16 + fr;
                const float rs = row_rstd(ssq, row) * sc;
#pragma unroll
                for (int bj = 0; bj < 2; ++bj) {
                    f32x4 v0 = acc[ai][bj][m][0] * rs, v1 = acc[ai][bj][m][1] * rs;
                    if (sig) {
#pragma unroll
                        for (int j = 0; j < 4; ++j) { v0[j] = __builtin_amdgcn_rcpf(1.0f + __builtin_amdgcn_exp2f(v0[j] * -1.4426950408889634f)); v1[j] = __builtin_amdgcn_rcpf(1.0f + __builtin_amdgcn_exp2f(v1[j] * -1.4426950408889634f)); }
                    }
                    *(u32x4*)(base + (size_t)row * ld + col0 + bj * HALF) = pack8(v0, v1);
                }
            }
    }
};
template <class Epi, class Sched, bool ALIGN_EPI = false, bool SP2 = false>
__device__ __forceinline__ void gemm_phase(PG8_LAS unsigned char* lds, const Gemm g, const Sched& S, const Epi& E) {
    const int tid = threadIdx.x, wid = __builtin_amdgcn_readfirstlane(tid >> 6), lane = tid & 63, wr = wid >> 2, wc = wid & 3, fr = lane & 15, fq = lane >> 4;
    const int K = g.K, nt = K / BK;
    unsigned voffA[2], voffB[2];
#pragma unroll
    for (int i = 0; i < 2; ++i) { int R, C; stage_rc(tid * 16 + i * 8192, R, C); const int Rb = Epi::PERM ? ((R & ~31) + perm32(R & 31)) : R;
        voffA[i] = (unsigned)(R * K + C) * 2u; voffB[i] = (unsigned)(Rb * K + C) * 2u; }
    const size_t kstep = (size_t)(BK * 2);
    const size_t hstep = (size_t)HALF * K * 2;
    const size_t tstep = 2 * hstep;
    const unsigned ldsw = (unsigned)wid * 1024u;
    const int aoff = lds_byte(wr * 64 + fr, fq * 8), boff = lds_byte(wc * 32 + fr, fq * 8);
#define PG8_SA(b, h) (((b) * 2 + (h)) * HTB)
#define PG8_SB(b, h) ((4 + (b) * 2 + (h)) * HTB)
#define PG8_STAGE(bufoff, gbase, voff) do { _Pragma("unroll") for (int _i = 0; _i < 2; ++_i) \
        __builtin_amdgcn_global_load_lds((const unsigned*)((const char*)(gbase) + (voff)[_i]), (PG8_LAS unsigned*)(lds + (bufoff) + ldsw + _i * 8192), 16, 0, 0); } while (0)
#define PG8_LDA(dst, b, h) do { _Pragma("unroll") for (int m = 0; m < 4; ++m) _Pragma("unroll") for (int k = 0; k < 2; ++k) dst[m][k] = *(const PG8_LAS bf16x8*)(lds + PG8_SA(b, h) + aoff + m * 2048 + k * 1024); } while (0)
#define PG8_LDB(dst, b, h) do { _Pragma("unroll") for (int n = 0; n < 2; ++n) _Pragma("unroll") for (int k = 0; k < 2; ++k) dst[n][k] = *(const PG8_LAS bf16x8*)(lds + PG8_SB(b, h) + boff + n * 2048 + k * 1024); } while (0)
#define PG8_MMA(ai, bj, At, Bt) do { __builtin_amdgcn_s_setprio(1); _Pragma("unroll") for (int m = 0; m < 4; ++m) _Pragma("unroll") for (int n = 0; n < 2; ++n) _Pragma("unroll") for (int k = 0; k < 2; ++k) \
        acc[ai][bj][m][n] = __builtin_amdgcn_mfma_f32_16x16x32_bf16(Bt[n][k], At[m][k], acc[ai][bj][m][n], 0, 0, 0); __builtin_amdgcn_s_setprio(0); } while (0)
#define PG8_WAIT_V(n) asm volatile("s_waitcnt vmcnt(" #n ")" ::: "memory")
#define PG8_WAIT_L(n) asm volatile("s_waitcnt lgkmcnt(" #n ")" ::: "memory")
#define PG8_BAR __builtin_amdgcn_s_barrier()
#define PG8_SCHED __builtin_amdgcn_sched_barrier(0)
    Unit cur, nxt; int ui = 0;
    if (!S.next(0, cur)) return;
    f32x4 acc[2][2][4][2];
#pragma unroll
    for (int a = 0; a < 2; ++a)
#pragma unroll
        for (int b = 0; b < 2; ++b)
#pragma unroll
            for (int m = 0; m < 4; ++m)
#pragma unroll
                for (int n = 0; n < 2; ++n) acc[a][b][m][n] = (f32x4){0.f, 0.f, 0.f, 0.f};
    bf16x8 At[4][2], B0[2][2], B1[2][2];
    const char* cA = (const char*)g.A + (size_t)cur.pm * tstep; const char* cB = (const char*)g.Bt + (size_t)cur.pn * tstep;
    S.a_ready(cur);
    if constexpr (SP2) {
        PG8_STAGE(PG8_SB(0, 0), cB, voffB); PG8_STAGE(PG8_SB(0, 1), cB + hstep, voffB); PG8_STAGE(PG8_SA(0, 0), cA, voffA); PG8_STAGE(PG8_SA(0, 1), cA + hstep, voffA);
        if (wr == 1) PG8_BAR;
        PG8_WAIT_V(2); PG8_BAR;
        PG8_STAGE(PG8_SB(1, 0), cB + kstep, voffB); PG8_STAGE(PG8_SA(1, 0), cA + kstep, voffA); PG8_STAGE(PG8_SB(1, 1), cB + hstep + kstep, voffB);
        PG8_WAIT_V(6); PG8_BAR;
    } else {
        PG8_STAGE(PG8_SB(0, 0), cB, voffB); PG8_STAGE(PG8_SA(0, 0), cA, voffA); PG8_STAGE(PG8_SB(0, 1), cB + hstep, voffB); PG8_STAGE(PG8_SA(0, 1), cA + hstep, voffA);
        if (wr == 1) PG8_BAR;
        PG8_WAIT_V(4); PG8_BAR;
        PG8_STAGE(PG8_SB(1, 0), cB + kstep, voffB); PG8_STAGE(PG8_SA(1, 0), cA + kstep, voffA); PG8_STAGE(PG8_SB(1, 1), cB + hstep + kstep, voffB);
        PG8_WAIT_V(6); PG8_BAR;
    }
    for (;;) {
        const bool has_next = S.next(ui + 1, nxt);
        const char* nA = has_next ? (const char*)g.A + (size_t)nxt.pm * tstep : cA; const char* nB = has_next ? (const char*)g.Bt + (size_t)nxt.pn * tstep : cB;
        for (int t = 0; t < nt; t += 2) {
            const bool last = (t == nt - 2);
            const char* a1 = cA + (size_t)(t + 1) * kstep;
            const char* a2 = last ? nA : cA + (size_t)(t + 2) * kstep; const char* b2 = last ? nB : cB + (size_t)(t + 2) * kstep;
            const char* a3 = a2 + kstep; const char* b3 = b2 + kstep;
            if (last && has_next) S.a_ready(nxt);
            if constexpr (SP2) {
            PG8_LDB(B0, 0, 0); PG8_LDB(B1, 0, 1); PG8_SCHED; PG8_LDA(At, 0, 0); PG8_STAGE(PG8_SA(1, 1), a1 + hstep, voffA);
            PG8_WAIT_V(8); PG8_WAIT_L(0); PG8_BAR; PG8_MMA(0, 0, At, B0); PG8_MMA(0, 1, At, B1); PG8_BAR; PG8_SCHED;
            PG8_LDA(At, 0, 1); PG8_STAGE(PG8_SB(0, 0), b2, voffB); PG8_STAGE(PG8_SB(0, 1), b2 + hstep, voffB); PG8_STAGE(PG8_SA(0, 0), a2, voffA);
            PG8_WAIT_V(8); PG8_WAIT_L(0); PG8_BAR; PG8_MMA(1, 0, At, B0); PG8_MMA(1, 1, At, B1); PG8_BAR; PG8_SCHED;
            PG8_LDB(B0, 1, 0); PG8_LDB(B1, 1, 1); PG8_SCHED; PG8_LDA(At, 1, 0); PG8_STAGE(PG8_SA(0, 1), a2 + hstep, voffA);
            PG8_WAIT_V(8); PG8_WAIT_L(0); PG8_BAR; PG8_MMA(0, 0, At, B0); PG8_MMA(0, 1, At, B1); PG8_BAR; PG8_SCHED;
            PG8_LDA(At, 1, 1); PG8_STAGE(PG8_SB(1, 0), b3, voffB); PG8_STAGE(PG8_SB(1, 1), b3 + hstep, voffB); PG8_STAGE(PG8_SA(1, 0), a3, voffA);
            PG8_WAIT_V(8); PG8_WAIT_L(0); PG8_BAR; PG8_MMA(1, 0, At, B0); PG8_MMA(1, 1, At, B1); PG8_BAR; PG8_SCHED;
            } else {
            PG8_LDB(B0, 0, 0); PG8_SCHED; PG8_LDA(At, 0, 0); PG8_STAGE(PG8_SA(1, 1), a1 + hstep, voffA);
            PG8_WAIT_L(8); PG8_BAR; PG8_WAIT_L(0); PG8_MMA(0, 0, At, B0); PG8_BAR; PG8_SCHED;
            PG8_LDB(B1, 0, 1); PG8_STAGE(PG8_SB(0, 0), b2, voffB);
            PG8_BAR; PG8_WAIT_L(0); PG8_MMA(0, 1, At, B1); PG8_BAR;
            PG8_LDA(At, 0, 1); PG8_STAGE(PG8_SA(0, 0), a2, voffA);
            PG8_BAR; PG8_WAIT_L(0); PG8_MMA(1, 0, At, B0); PG8_BAR; PG8_SCHED;
            PG8_STAGE(PG8_SB(0, 1), b2 + hstep, voffB);
            PG8_WAIT_V(6); PG8_BAR; PG8_MMA(1, 1, At, B1); PG8_BAR;
            PG8_LDB(B0, 1, 0); PG8_SCHED; PG8_LDA(At, 1, 0); PG8_STAGE(PG8_SA(0, 1), a2 + hstep, voffA);
            PG8_WAIT_L(8); PG8_BAR; PG8_WAIT_L(0); PG8_MMA(0, 0, At, B0); PG8_BAR; PG8_SCHED;
            PG8_LDB(B1, 1, 1); PG8_STAGE(PG8_SB(1, 0), b3, voffB);
            PG8_BAR; PG8_WAIT_L(0); PG8_MMA(0, 1, At, B1); PG8_BAR;
            PG8_LDA(At, 1, 1); PG8_STAGE(PG8_SA(1, 0), a3, voffA);
            PG8_BAR; PG8_WAIT_L(0); PG8_MMA(1, 0, At, B0); PG8_BAR; PG8_SCHED;
            PG8_STAGE(PG8_SB(1, 1), b3 + hstep, voffB);
            PG8_WAIT_V(6); PG8_BAR; PG8_MMA(1, 1, At, B1); PG8_BAR;
            }
        }
        if constexpr (ALIGN_EPI) { if (wr == 0) PG8_BAR; }
        if constexpr (!Epi::AFTER_DRAIN) { E(acc, cur, wr, wc, fr, fq); S.done(cur); }
        if (!has_next) break;
#pragma unroll
        for (int a = 0; a < 2; ++a)
#pragma unroll
            for (int b = 0; b < 2; ++b)
#pragma unroll
                for (int m = 0; m < 4; ++m)
#pragma unroll
                    for (int n = 0; n < 2; ++n) acc[a][b][m][n] = (f32x4){0.f, 0.f, 0.f, 0.f};
        cur = nxt; cA = nA; cB = nB; ++ui;
        if constexpr (ALIGN_EPI) { if (wr == 1) PG8_BAR; }
    }
    PG8_WAIT_V(0);
    if constexpr (!ALIGN_EPI) { if (wr == 0) PG8_BAR; }
    PG8_BAR;
    if constexpr (Epi::AFTER_DRAIN) { E.fused(acc, cur, wr, wc, fr, fq, lds, wid, lane); S.done(cur); }
#undef PG8_SA
#undef PG8_SB
#undef PG8_STAGE
#undef PG8_LDA
#undef PG8_LDB
#undef PG8_MMA
#undef PG8_WAIT_V
#undef PG8_WAIT_L
#undef PG8_BAR
#undef PG8_SCHED
}
}

#ifndef PG8_SP2
#define PG8_SP2 true
#endif
#ifndef PG8_ALIGN
#define PG8_ALIGN true
#endif
#define GAS __attribute__((address_space(1)))
#define LAS __attribute__((address_space(3)))
typedef unsigned short bf16;
typedef unsigned v4u __attribute__((ext_vector_type(4)));
typedef float f32x4 __attribute__((ext_vector_type(4)));
typedef short bf16x8 __attribute__((ext_vector_type(8)));
typedef GAS unsigned gu32;
typedef GAS unsigned long long gu64;
#define RLX_AGENT __ATOMIC_RELAXED, __HIP_MEMORY_SCOPE_AGENT
#define LDS_WAIT() asm volatile("s_waitcnt lgkmcnt(0)" ::: "memory")
#define VM_WAIT() asm volatile("s_waitcnt vmcnt(0)" ::: "memory")
__device__ __forceinline__ unsigned long long rt() { return __builtin_amdgcn_s_memrealtime(); }
__device__ __forceinline__ unsigned f2bf(float f) { unsigned u = __builtin_bit_cast(unsigned, f); return (u + 0x7fffu + ((u >> 16) & 1u)) >> 16; }
__device__ __forceinline__ unsigned pk2(float lo, float hi) { return f2bf(lo) | (f2bf(hi) << 16); }

#define XB_TMO      128
#define XB_XCNT(j)  (256  + 64 * (j))
#define XB_XSUB(j)  (1280 + 64 * (j))
#define XB_XGEN(j)  (2304 + 64 * (j))
#define XB_TOP      3328
#define XB_TOPGEN   3392
#define XCD_BAR_WORDS 3456
#define XB_SPIN_CAP (1u << 18)

__device__ __forceinline__ unsigned xb_ld(unsigned* p)              { return __hip_atomic_load(p, __ATOMIC_RELAXED, __HIP_MEMORY_SCOPE_AGENT); }
__device__ __forceinline__ unsigned xb_add(unsigned* p, unsigned v) { return __hip_atomic_fetch_add(p, v, __ATOMIC_RELAXED, __HIP_MEMORY_SCOPE_AGENT); }
__device__ __forceinline__ unsigned xb_xcc_id() { return (unsigned)__builtin_amdgcn_s_getreg((3 << 11) | 20) & 0xFu; }
#define XB_SPIN(cond, bar) do { unsigned _sp = 0; while (cond) { __builtin_amdgcn_s_sleep(1); \
    if ((++_sp & 255u) == 0u) { if (xb_ld(&(bar)[XB_TMO])) break; if (_sp > XB_SPIN_CAP) { atomicAdd(&(bar)[XB_TMO], 1u); break; } } } } while (0)

struct XcdBarrier {
    unsigned* bar; unsigned x;
    volatile LAS unsigned* st;
};

__device__ __forceinline__ XcdBarrier xcd_barrier_post(unsigned* bar, volatile LAS unsigned* st) {
    XcdBarrier b; b.bar = bar; b.x = xb_xcc_id(); b.st = st;
    if (threadIdx.x == 0) (void)xb_add(&bar[XB_XCNT(b.x)], 1u);
    return b;
}
__device__ __forceinline__ void xcd_barrier_complete(unsigned* bar, unsigned x, unsigned& nloc, unsigned& nx) {
    const unsigned G = gridDim.x * gridDim.y * gridDim.z;
    unsigned sum, cnt, mine, sp = 0u;
    for (;;) {
        sum = 0u; cnt = 0u; mine = 0u;
#pragma unroll
        for (unsigned j = 0; j < 16; ++j) { const unsigned c = xb_ld(&bar[XB_XCNT(j)]); sum += c; cnt += (c > 0u) ? 1u : 0u; mine = (j == x) ? c : mine; }
        if (sum == G) break;
        __builtin_amdgcn_s_sleep(1);
        if ((++sp & 255u) == 0u) { if (xb_ld(&bar[XB_TMO])) break; if (sp > XB_SPIN_CAP) { atomicAdd(&bar[XB_TMO], 1u); break; } }
    }
    nloc = mine > 0u ? mine : 1u; nx = cnt > 0u ? cnt : 1u;
}

__device__ __forceinline__ void xcd_barrier(const XcdBarrier& b) {
    asm volatile("s_waitcnt vmcnt(0)" ::: "memory");
    __syncthreads();
    if (threadIdx.x == 0) {
        unsigned* bar = b.bar;
        __builtin_amdgcn_s_waitcnt(0);
        unsigned nloc = b.st[0], nx = b.st[1];
        if (nloc == 0u) { xcd_barrier_complete(bar, b.x, nloc, nx); b.st[0] = nloc; b.st[1] = nx; }
        const unsigned old = xb_add(&bar[XB_XSUB(b.x)], 1u);
        const unsigned gen = old / nloc;
        if (old + 1u == (gen + 1u) * nloc) {
            __builtin_amdgcn_fence(__ATOMIC_RELEASE, "agent");
            asm volatile("s_waitcnt vmcnt(0)" ::: "memory");
            const unsigned og = xb_add(&bar[XB_TOP], 1u);
            const unsigned tg = og / nx;
            if (og + 1u == (tg + 1u) * nx) xb_add(&bar[XB_TOPGEN], 1u);
            else XB_SPIN(xb_ld(&bar[XB_TOPGEN]) == tg, bar);
            __builtin_amdgcn_fence(__ATOMIC_ACQUIRE, "agent");
            xb_add(&bar[XB_XGEN(b.x)], 1u);
            asm volatile("s_waitcnt vmcnt(0)" ::: "memory");
        } else {
            XB_SPIN(xb_ld(&bar[XB_XGEN(b.x)]) == gen, bar);
            __builtin_amdgcn_fence(__ATOMIC_ACQUIRE, "agent");
            asm volatile("s_waitcnt vmcnt(0)" ::: "memory");
        }
    }
    __syncthreads();
}
constexpr int NWAVES = 8;
constexpr int BATCH = 2, SEQ = 8192, D = 1024, M = BATCH * SEQ, NH = 16, HD = 64, MB = 256, NBLK = SEQ / MB;
constexpr int DFF = 2816, NGU = 2 * DFF;
constexpr int MH = 8, DK = 64, DV = 128, LCH = 64, NCH = SEQ / LCH, NUNIT = BATCH * MH * NCH;
constexpr int NIN = 3072, NINW = 3088;
constexpr float RMS_EPS = 1e-6f, SOFTCAP = 15.0f, LOG2E = 1.4426950408889634f;

constexpr size_t MiB = 1u << 20;
constexpr size_t WS_CTL = 0, CTL_ZERO_BYTES = 1 * MiB;
constexpr size_t WS_KMEAN = 512 * 1024;
constexpr size_t WS_SSQ = 1 * MiB;
constexpr size_t WS_BIG = 5 * MiB;
constexpr size_t WS_SEL = 6 * MiB;
constexpr size_t WS_ROPE = 7 * MiB;
constexpr size_t WS_WG = 7 * MiB + 512 * 1024;
constexpr size_t WS_WQKV = 8 * MiB, WS_WO = 14 * MiB, WS_WIN = 16 * MiB, WS_WOUT = 22 * MiB, WS_WGU = 24 * MiB  , WS_WD = 46 * MiB  ;
constexpr size_t WS_NLOC = 57 * MiB;
constexpr size_t WS_SCAL = 57 * MiB + 512 * 1024;
constexpr size_t WS_AB = 64 * MiB;
constexpr size_t WS_Q = 96 * MiB, WS_K = 128 * MiB, WS_V = 160 * MiB;
constexpr size_t WS_HB1 = 96 * MiB;
constexpr size_t WS_ACT = 128 * MiB;
constexpr size_t WS_MQ = 96 * MiB, WS_MK = 112 * MiB, WS_MV = 128 * MiB, WS_OG = 160 * MiB, WS_CLOC = 192 * MiB;
constexpr size_t WS_END = 256 * MiB;
constexpr int CW_BAR = 4096;

constexpr int RING_OFF = 0, RING_BYTES = 131072;
constexpr int LDSCTL_OFF = RING_BYTES, MISC_OFF = LDSCTL_OFF + 320;
constexpr int LDS_BYTES = 147456;
static_assert(MISC_OFF + 128 <= LDS_BYTES, "LDS map");

__device__ __forceinline__ float bf2f(unsigned short h) { return __builtin_bit_cast(float, (unsigned)h << 16); }
__device__ __forceinline__ float bflo(unsigned w) { return __builtin_bit_cast(float, w << 16); }
__device__ __forceinline__ float bfhi(unsigned w) { return __builtin_bit_cast(float, w & 0xffff0000u); }
__device__ __forceinline__ float wave_sum(float v) {
#pragma unroll
    for (int o = 1; o < 64; o <<= 1) v += __shfl_xor(v, o);
    return v;
}
__device__ __forceinline__ float wave_max(float v) {
#pragma unroll
    for (int o = 1; o < 64; o <<= 1) v = fmaxf(v, __shfl_xor(v, o));
    return v;
}
__device__ __forceinline__ float fexp(float x) { return __builtin_amdgcn_exp2f(x * LOG2E); }

struct Frame {
    LAS unsigned char* lds;
    volatile LAS unsigned* MISC;
    gu32* ctl;
    int tid, lane, wave, vcu, G;
};

template <int MODE> __device__ __forceinline__ int src_col(int n) {
    if (MODE == 1) {
        if (n >= 2048) return n;
        const int s = n & 63; int d = s;
        if (s < 16) d = (s & 3) | ((s & 4) << 1) | ((s & 8) >> 1);
        return (n & ~63) | d;
    }
    if (MODE == 2) { const int pn = n >> 8, r = n & 255; return (r < 128) ? pn * 128 + r : DFF + pn * 128 + (r - 128); }
    return n;
}
template <int MODE> __device__ __forceinline__ void p0_transpose_item(const float* W, int K, int Nsrc, int Nout, const float* kscale, bf16* WT, LAS float* scr, int item, int lane) {
    const int nblk = Nout / 32, kb = item / nblk, nb = item % nblk, k0 = 64 * kb, n0 = 32 * nb;
    const int sc = src_col<MODE>(n0 + (lane & 31));
#pragma unroll 8
    for (int i = 0; i < 32; ++i) { const int kk = 2 * i + (lane >> 5); float w = W[(size_t)(k0 + kk) * Nsrc + sc]; if (kscale) w *= kscale[k0 + kk]; scr[kk * 33 + (lane & 31)] = w; }
    LDS_WAIT(); asm volatile("" ::: "memory");
    const int c = lane & 7;
#pragma unroll
    for (int j = 0; j < 4; ++j) { const int n = (lane >> 3) + 8 * j; const LAS float* s = scr + (8 * c) * 33 + n;
        v4u o; o.x = pk2(s[0 * 33], s[1 * 33]); o.y = pk2(s[2 * 33], s[3 * 33]); o.z = pk2(s[4 * 33], s[5 * 33]); o.w = pk2(s[6 * 33], s[7 * 33]);
        *(GAS v4u*)(WT + (size_t)(n0 + n) * K + k0 + 8 * c) = o; }
    LDS_WAIT(); asm volatile("" ::: "memory");
}

struct Ptrs {
    const float *x, *attn_norm, *w_qkv, *w_o, *mlstm_norm, *w_in, *b_gates, *head_norm, *w_out, *ffn_norm, *w_gu, *w_down, *final_norm;
    float* out; unsigned char* ws;
};

__device__ __forceinline__ void p0_prologue(Frame& F, const Ptrs& P) {
    LAS float* scr = (LAS float*)(F.lds + RING_OFF + F.wave * 16384);
    unsigned char* ws = P.ws;
    const int gw = F.vcu * NWAVES + F.wave, NGW = F.G * NWAVES;
    constexpr int I_QKV = (D / 64) * (3 * D / 32), I_O = (D / 64) * (D / 32), I_IN = (D / 64) * (NIN / 32), I_GU = (D / 64) * (NGU / 32), I_DN = (DFF / 64) * (D / 32);
    constexpr int NITEMS = I_QKV + I_O + I_IN + I_O + 2 * I_GU + 2 * I_DN;
    for (int it = gw; it < NITEMS; it += NGW) {
        int r = it;
        if (r < I_QKV) { p0_transpose_item<1>(P.w_qkv, D, 3 * D, 3 * D, P.attn_norm, (bf16*)(ws + WS_WQKV), scr, r, F.lane); continue; } r -= I_QKV;
        if (r < I_O) { p0_transpose_item<0>(P.w_o, D, D, D, nullptr, (bf16*)(ws + WS_WO), scr, r, F.lane); continue; } r -= I_O;
        if (r < I_IN) { p0_transpose_item<0>(P.w_in, D, NINW, NIN, P.mlstm_norm, (bf16*)(ws + WS_WIN), scr, r, F.lane); continue; } r -= I_IN;
        if (r < I_O) { p0_transpose_item<0>(P.w_out, D, D, D, nullptr, (bf16*)(ws + WS_WOUT), scr, r, F.lane); continue; } r -= I_O;
        if (r < 2 * I_GU) { const int l = r / I_GU; p0_transpose_item<2>(P.w_gu + (size_t)l * D * NGU, D, NGU, NGU, P.ffn_norm + l * D, (bf16*)(ws + WS_WGU) + (size_t)l * NGU * D, scr, r % I_GU, F.lane); continue; } r -= 2 * I_GU;
        { const int l = r / I_DN; p0_transpose_item<0>(P.w_down + (size_t)l * DFF * D, DFF, D, D, nullptr, (bf16*)(ws + WS_WD) + (size_t)l * D * DFF, scr, r % I_DN, F.lane); }
    }
    const int gt = F.vcu * (NWAVES * 64) + F.tid, NGT = F.G * NWAVES * 64;
    { float* WG = (float*)(ws + WS_WG); for (int i = gt; i < 16 * D; i += NGT) { const int j = i >> 10, k = i & 1023; WG[i] = P.mlstm_norm[k] * P.w_in[(size_t)k * NINW + NIN + j]; } }
    { float* rope = (float*)(ws + WS_ROPE);
      for (int i = gt; i < SEQ * 8; i += NGT) { const int pos = i >> 3, j = i & 7;
          const float invf = j == 0 ? 1.0f : j == 1 ? 0.1939227432012558f : j == 2 ? 0.03760603070259094f : j == 3 ? 0.007292664609849453f : j == 4 ? 0.0014142135623842478f : j == 5 ? 0.00027424818836152554f : j == 6 ? 5.3182957344688475e-05f : 1.0313385246263351e-05f;
          const float ang = __fmul_rn((float)pos, invf);
          const double rev = (double)ang * 0.15915494309189533577; const float fr = (float)(rev - __builtin_rint(rev));
          rope[2 * i] = __builtin_amdgcn_cosf(fr); rope[2 * i + 1] = __builtin_amdgcn_sinf(fr); } }
    { bf16* xb = (bf16*)(ws + WS_AB); float* ssq0 = (float*)(ws + WS_SSQ);
      for (int m = gw; m < M; m += NGW) {
          const GAS f32x4* xr = (const GAS f32x4*)(P.x + (size_t)m * D) + F.lane; f32x4 v[4]; float s = 0.f;
#pragma unroll
          for (int j = 0; j < 4; ++j) { v[j] = xr[64 * j]; s += (v[j].x * v[j].x + v[j].y * v[j].y) + (v[j].z * v[j].z + v[j].w * v[j].w); }
          s = wave_sum(s);
          GAS unsigned long long* o8 = (GAS unsigned long long*)(xb + (size_t)m * D) + F.lane;
#pragma unroll
          for (int j = 0; j < 4; ++j) o8[64 * j] = (unsigned long long)pk2(v[j].x, v[j].y) | ((unsigned long long)pk2(v[j].z, v[j].w) << 32);
          if (F.lane < 16) ssq0[(size_t)m * 16 + F.lane] = (F.lane == 0) ? s : 0.f;
      } }
}

__device__ __forceinline__ void p2_gating(Frame& F, const Ptrs& P) {
    const bf16* Q = (const bf16*)(P.ws + WS_Q); const float* kmean = (const float*)(P.ws + WS_KMEAN); unsigned* sel = (unsigned*)(P.ws + WS_SEL);
    const int gt = F.vcu * (NWAVES * 64) + F.tid, NGT = F.G * NWAVES * 64;
    for (int idx = gt; idx < M * NH; idx += NGT) {
        const int t = idx >> 4, h = idx & 15, b = t >> 13, cur = (t & (SEQ - 1)) >> 8;
        float q[64];
        const v4u* qp = (const v4u*)(Q + (size_t)t * D + h * HD);
#pragma unroll
        for (int i = 0; i < 8; ++i) { const v4u w = qp[i]; q[8 * i] = bflo(w.x); q[8 * i + 1] = bfhi(w.x); q[8 * i + 2] = bflo(w.y); q[8 * i + 3] = bfhi(w.y); q[8 * i + 4] = bflo(w.z); q[8 * i + 5] = bfhi(w.z); q[8 * i + 6] = bflo(w.w); q[8 * i + 7] = bfhi(w.w); }
        float g1 = -INFINITY, g2 = -INFINITY, g3 = -INFINITY; unsigned i1 = 255u, i2 = 255u, i3 = 255u;
        for (int n = 0; n < cur; ++n) {
            const f32x4* kp = (const f32x4*)(kmean + (size_t)(b * NBLK + n) * D + h * HD);
            float g = 0.f;
#pragma unroll
            for (int i = 0; i < 16; ++i) { const f32x4 k = kp[i]; g += (q[4 * i] * k.x + q[4 * i + 1] * k.y) + (q[4 * i + 2] * k.z + q[4 * i + 3] * k.w); }
            if (g > g1) { g3 = g2; i3 = i2; g2 = g1; i2 = i1; g1 = g; i1 = (unsigned)n; }
            else if (g > g2) { g3 = g2; i3 = i2; g2 = g; i2 = (unsigned)n; }
            else if (g > g3) { g3 = g; i3 = (unsigned)n; }
        }
        sel[idx] = i1 | (i2 << 8) | (i3 << 16);
    }
}

__device__ __forceinline__ void p3_attention_naive(Frame& F, const Ptrs& P) {
    const bf16* Q = (const bf16*)(P.ws + WS_Q); const bf16* K = (const bf16*)(P.ws + WS_K); const bf16* V = (const bf16*)(P.ws + WS_V);
    bf16* O = (bf16*)(P.ws + WS_AB); const unsigned* sel = (const unsigned*)(P.ws + WS_SEL);
    LAS float* pl = (LAS float*)(F.lds + RING_OFF + F.wave * 4096);
    const int gw = F.vcu * NWAVES + F.wave, NGW = F.G * NWAVES, lane = F.lane;
    for (int task = gw; task < M * NH; task += NGW) {
        const int t = task >> 4, h = task & 15, b = t >> 13, tl = t & (SEQ - 1), cur = tl >> 8;
        const unsigned sw = sel[task];
        float q[64];
        const v4u* qp = (const v4u*)(Q + (size_t)t * D + h * HD);
#pragma unroll
        for (int i = 0; i < 8; ++i) { const v4u w = qp[i]; q[8 * i] = bflo(w.x); q[8 * i + 1] = bfhi(w.x); q[8 * i + 2] = bflo(w.y); q[8 * i + 3] = bfhi(w.y); q[8 * i + 4] = bflo(w.z); q[8 * i + 5] = bfhi(w.z); q[8 * i + 6] = bflo(w.w); q[8 * i + 7] = bfhi(w.w); }
        int blk[4], nk[4];
#pragma unroll
        for (int s = 0; s < 3; ++s) { const unsigned bi = (sw >> (8 * s)) & 255u; blk[s] = (int)bi; nk[s] = (bi < (unsigned)cur) ? MB : 0; }
        blk[3] = cur; nk[3] = tl - cur * MB + 1;
        float sc[16]; float mx = -INFINITY;
#pragma unroll
        for (int s = 0; s < 4; ++s)
#pragma unroll
            for (int kk = 0; kk < 4; ++kk) {
                const int key = kk * 64 + lane; float a = -INFINITY;
                if (key < nk[s]) {
                    const v4u* kp = (const v4u*)(K + (size_t)(b * SEQ + blk[s] * MB + key) * D + h * HD); a = 0.f;
#pragma unroll
                    for (int i = 0; i < 8; ++i) { const v4u w = kp[i];
                        a += (q[8 * i] * bflo(w.x) + q[8 * i + 1] * bfhi(w.x)) + (q[8 * i + 2] * bflo(w.y) + q[8 * i + 3] * bfhi(w.y)) + (q[8 * i + 4] * bflo(w.z) + q[8 * i + 5] * bfhi(w.z)) + (q[8 * i + 6] * bflo(w.w) + q[8 * i + 7] * bfhi(w.w)); }
                }
                sc[s * 4 + kk] = a; mx = fmaxf(mx, a);
            }
        mx = wave_max(mx);
        float l = 0.f;
#pragma unroll
        for (int i = 0; i < 16; ++i) { const float p = __builtin_amdgcn_exp2f(sc[i] - mx); l += p; pl[i * 64 + lane] = p; }
        l = wave_sum(l);
        LDS_WAIT(); asm volatile("" ::: "memory");
        const int kq = lane >> 3, dg = lane & 7;
        float o[8];
#pragma unroll
        for (int j = 0; j < 8; ++j) o[j] = 0.f;
#pragma unroll
        for (int s = 0; s < 4; ++s) {
            const bf16* vp = V + (size_t)(b * SEQ + blk[s] * MB) * D + h * HD + dg * 8;
            const int n = nk[s];
#pragma unroll 4
            for (int key = kq; key < n; key += 8) { const float p = pl[s * 256 + key]; const v4u w = *(const v4u*)(vp + (size_t)key * D);
                o[0] += p * bflo(w.x); o[1] += p * bfhi(w.x); o[2] += p * bflo(w.y); o[3] += p * bfhi(w.y); o[4] += p * bflo(w.z); o[5] += p * bfhi(w.z); o[6] += p * bflo(w.w); o[7] += p * bfhi(w.w); }
        }
        const float rl = 1.0f / l;
#pragma unroll
        for (int j = 0; j < 8; ++j) { o[j] += __shfl_xor(o[j], 8); o[j] += __shfl_xor(o[j], 16); o[j] += __shfl_xor(o[j], 32); o[j] *= rl; }
        if (kq == 0) { v4u w; w.x = pk2(o[0], o[1]); w.y = pk2(o[2], o[3]); w.z = pk2(o[4], o[5]); w.w = pk2(o[6], o[7]); *(v4u*)(O + (size_t)t * D + h * HD + dg * 8) = w; }
        LDS_WAIT(); asm volatile("" ::: "memory");
    }
}

__device__ __forceinline__ float softcap_f(float g) { const float x = g * (1.0f / SOFTCAP); const float e = fexp(2.0f * x); return SOFTCAP * (e - 1.0f) / (e + 1.0f); }
__device__ __forceinline__ float logsigmoid_f(float f) { return fminf(f, 0.f) - __builtin_amdgcn_logf(1.0f + fexp(-fabsf(f))) * 0.6931471805599453f; }

__device__ __forceinline__ void pa_mlstm_local(Frame& F, const Ptrs& P) {
    unsigned char* ws = P.ws;
    const bf16* HB = (const bf16*)(ws + WS_AB); const bf16* MK = (const bf16*)(ws + WS_MK); const bf16* MV = (const bf16*)(ws + WS_MV);
    const float* WG = (const float*)(ws + WS_WG); const float* ssq = (const float*)(ws + WS_SSQ) + (size_t)2 * M * 16;
    float* cloc = (float*)(ws + WS_CLOC); float* nloc = (float*)(ws + WS_NLOC); float* scal = (float*)(ws + WS_SCAL); float* BIG = (float*)(ws + WS_BIG);
    LAS float* kf = (LAS float*)(F.lds + RING_OFF); LAS float* vf = kf + 64 * 64; LAS float* lf = vf + 64 * 128; LAS float* ig = lf + 64; LAS float* bb = ig + 64; LAS float* wv = bb + 64;
    const int tid = F.tid;
    for (int unit = F.vcu; unit < NUNIT; unit += F.G) {
        const int bh = unit >> 7, c = unit & 127, b = bh >> 3, h = bh & 7, t0 = b * SEQ + c * LCH;
        { const int row = tid >> 3, c8 = (tid & 7) * 8; const v4u w = *(const v4u*)(MK + (size_t)(t0 + row) * 512 + h * DK + c8); LAS float* d = kf + row * 64 + c8;
          d[0] = bflo(w.x); d[1] = bfhi(w.x); d[2] = bflo(w.y); d[3] = bfhi(w.y); d[4] = bflo(w.z); d[5] = bfhi(w.z); d[6] = bflo(w.w); d[7] = bfhi(w.w);
          const int c16 = (tid & 7) * 16; const v4u* vp = (const v4u*)(MV + (size_t)(t0 + row) * 1024 + h * DV + c16); LAS float* e = vf + row * 128 + c16;
#pragma unroll
          for (int i = 0; i < 2; ++i) { const v4u u = vp[i]; e[8 * i] = bflo(u.x); e[8 * i + 1] = bfhi(u.x); e[8 * i + 2] = bflo(u.y); e[8 * i + 3] = bfhi(u.y); e[8 * i + 4] = bflo(u.z); e[8 * i + 5] = bfhi(u.z); e[8 * i + 6] = bflo(u.w); e[8 * i + 7] = bfhi(u.w); } }
        { const int dp = tid >> 2, part = tid & 3, row = dp >> 1, g = dp & 1, col = g * 8 + h;
          const v4u* hp = (const v4u*)(HB + (size_t)(t0 + row) * D + part * 256); const f32x4* wp = (const f32x4*)(WG + (size_t)col * D + part * 256);
          float a = 0.f;
          for (int i = 0; i < 32; ++i) { const v4u w = hp[i]; const f32x4 w0 = wp[2 * i], w1 = wp[2 * i + 1];
              a += (bflo(w.x) * w0.x + bfhi(w.x) * w0.y) + (bflo(w.y) * w0.z + bfhi(w.y) * w0.w) + (bflo(w.z) * w1.x + bfhi(w.z) * w1.y) + (bflo(w.w) * w1.z + bfhi(w.w) * w1.w); }
          a += __shfl_xor(a, 1); a += __shfl_xor(a, 2);
          if (part == 0) { const float val = softcap_f(a * pg8::row_rstd(ssq, t0 + row) + P.b_gates[col]); if (g == 0) ig[row] = val; else lf[row] = logsigmoid_f(val); } }
        LDS_WAIT(); __syncthreads();
        if (tid < 64) { float s = 0.f; for (int j = 0; j <= tid; ++j) s += lf[j]; bb[tid] = s; }
        LDS_WAIT(); __syncthreads();
        if (tid < 64) { const float bL = bb[63], a = bL - bb[tid] + ig[tid], ml = wave_max(a); wv[tid] = fexp(a - ml);
            BIG[(size_t)unit * 128 + tid] = bb[tid]; BIG[(size_t)unit * 128 + 64 + tid] = ig[tid];
            if (tid == 0) { scal[unit] = ml; scal[NUNIT + unit] = bL; } }
        LDS_WAIT(); __syncthreads();
        { const int v = tid >> 2, kb = (tid & 3) * 16; float acc[16];
#pragma unroll
          for (int j = 0; j < 16; ++j) acc[j] = 0.f;
          for (int s = 0; s < 64; ++s) { const float wvv = wv[s] * vf[s * 128 + v];
#pragma unroll
              for (int j = 0; j < 16; ++j) acc[j] += wvv * kf[s * 64 + kb + j]; }
          f32x4* cp = (f32x4*)(cloc + (size_t)unit * 8192 + v * 64 + kb);
#pragma unroll
          for (int j = 0; j < 4; ++j) cp[j] = (f32x4){acc[4 * j], acc[4 * j + 1], acc[4 * j + 2], acc[4 * j + 3]};
          if (tid < 64) { float n = 0.f; for (int s = 0; s < 64; ++s) n += wv[s] * kf[s * 64 + tid]; nloc[(size_t)unit * 64 + tid] = n; } }
        LDS_WAIT(); __syncthreads();
    }
}
__device__ __forceinline__ void pb_mlstm_scan(Frame& F, const Ptrs& P) {
    unsigned char* ws = P.ws;
    float* cloc = (float*)(ws + WS_CLOC); float* nloc = (float*)(ws + WS_NLOC); float* scal = (float*)(ws + WS_SCAL);
    const int gt = F.vcu * (NWAVES * 64) + F.tid, NGT = F.G * NWAVES * 64;
    for (int idx = gt; idx < BATCH * MH * 8256; idx += NGT) {
        const int bh = idx / 8256, e = idx - bh * 8256;
        float st = 0.f, mp = 0.f;
        for (int c = 0; c < NCH; ++c) {
            const int unit = bh * NCH + c; const float ml = scal[unit], bl = scal[NUNIT + unit];
            const float mn = fmaxf(bl + mp, ml), decay = fexp(bl + mp - mn), sc = fexp(ml - mn);
            float* p = (e < 8192) ? cloc + (size_t)unit * 8192 + e : nloc + (size_t)unit * 64 + (e - 8192);
            const float x = *p; *p = st;
            if (e == 0) scal[2 * NUNIT + unit] = mp;
            st = decay * st + sc * x; mp = mn;
        }
    }
}
__device__ __forceinline__ void pc_mlstm_out(Frame& F, const Ptrs& P) {
    unsigned char* ws = P.ws;
    const bf16* MQ = (const bf16*)(ws + WS_MQ); const bf16* MK = (const bf16*)(ws + WS_MK); const bf16* MV = (const bf16*)(ws + WS_MV); const bf16* OG = (const bf16*)(ws + WS_OG);
    const float* cin = (const float*)(ws + WS_CLOC); const float* nin = (const float*)(ws + WS_NLOC); const float* scal = (const float*)(ws + WS_SCAL); const float* BIG = (const float*)(ws + WS_BIG);
    bf16* Y = (bf16*)(ws + WS_AB);
    LAS float* qf = (LAS float*)(F.lds + RING_OFF); LAS float* kf = qf + 64 * 64; LAS float* vf = kf + 64 * 64; LAS float* cf = vf + 64 * 128; LAS float* sq = cf + 128 * 65; LAS float* bb = sq + 64 * 65;
    LAS float* ig = bb + 64; LAS float* mt = ig + 64; LAS float* itr = mt + 64; LAS float* qn = itr + 64; LAS float* dd = qn + 64; LAS float* nn = dd + 64;
    const int tid = F.tid;
    for (int unit = F.vcu; unit < NUNIT; unit += F.G) {
        const int bh = unit >> 7, c = unit & 127, b = bh >> 3, h = bh & 7, t0 = b * SEQ + c * LCH;
        const float m_in = scal[2 * NUNIT + unit];
        { const int row = tid >> 3, c8 = (tid & 7) * 8;
          { const v4u w = *(const v4u*)(MQ + (size_t)(t0 + row) * 512 + h * DK + c8); LAS float* d = qf + row * 64 + c8;
            d[0] = bflo(w.x); d[1] = bfhi(w.x); d[2] = bflo(w.y); d[3] = bfhi(w.y); d[4] = bflo(w.z); d[5] = bfhi(w.z); d[6] = bflo(w.w); d[7] = bfhi(w.w); }
          { const v4u w = *(const v4u*)(MK + (size_t)(t0 + row) * 512 + h * DK + c8); LAS float* d = kf + row * 64 + c8;
            d[0] = bflo(w.x); d[1] = bfhi(w.x); d[2] = bflo(w.y); d[3] = bfhi(w.y); d[4] = bflo(w.z); d[5] = bfhi(w.z); d[6] = bflo(w.w); d[7] = bfhi(w.w); }
          const int c16 = (tid & 7) * 16; const v4u* vp = (const v4u*)(MV + (size_t)(t0 + row) * 1024 + h * DV + c16); LAS float* e = vf + row * 128 + c16;
#pragma unroll
          for (int i = 0; i < 2; ++i) { const v4u u = vp[i]; e[8 * i] = bflo(u.x); e[8 * i + 1] = bfhi(u.x); e[8 * i + 2] = bflo(u.y); e[8 * i + 3] = bfhi(u.y); e[8 * i + 4] = bflo(u.z); e[8 * i + 5] = bfhi(u.z); e[8 * i + 6] = bflo(u.w); e[8 * i + 7] = bfhi(u.w); }
          const int v = tid >> 2, kb = (tid & 3) * 16; const f32x4* cp = (const f32x4*)(cin + (size_t)unit * 8192 + v * 64 + kb);
#pragma unroll
          for (int j = 0; j < 4; ++j) { const f32x4 x = cp[j]; cf[v * 65 + kb + 4 * j] = x.x; cf[v * 65 + kb + 4 * j + 1] = x.y; cf[v * 65 + kb + 4 * j + 2] = x.z; cf[v * 65 + kb + 4 * j + 3] = x.w; }
          if (tid < 64) { nn[tid] = nin[(size_t)unit * 64 + tid]; bb[tid] = BIG[(size_t)unit * 128 + tid]; ig[tid] = BIG[(size_t)unit * 128 + 64 + tid]; } }
        LDS_WAIT(); __syncthreads();
        if (tid < 64) { float mi = -INFINITY; for (int s = 0; s <= tid; ++s) mi = fmaxf(mi, bb[tid] - bb[s] + ig[s]);
            const float bi = bb[tid] + m_in, m = fmaxf(bi, mi); mt[tid] = m; itr[tid] = fexp(bi - m);
            float a = 0.f; for (int d = 0; d < 64; ++d) a += qf[tid * 64 + d] * nn[d]; qn[tid] = a; }
        LDS_WAIT(); __syncthreads();
#pragma unroll 1
        for (int i = 0; i < 8; ++i) { const int e = tid + 512 * i, l = e >> 6, s = e & 63; float val = 0.f;
            if (s <= l) { float a = 0.f; for (int d = 0; d < 64; ++d) a += qf[l * 64 + d] * kf[s * 64 + d]; val = a * fexp(bb[l] - bb[s] + ig[s] - mt[l]); }
            sq[l * 65 + s] = val; }
        LDS_WAIT(); __syncthreads();
        if (tid < 64) { float den = itr[tid] * qn[tid]; for (int s = 0; s < 64; ++s) den += sq[tid * 65 + s]; dd[tid] = fmaxf(fabsf(den), fexp(-mt[tid])); }
        LDS_WAIT(); __syncthreads();
        { const int l = tid >> 3, vb = (tid & 7) * 16; float hv[16], a[16]; const float it = itr[l], rd = 1.0f / dd[l]; float ss = 0.f;
#pragma unroll
          for (int j = 0; j < 16; ++j) { hv[j] = 0.f; a[j] = 0.f; }
#pragma unroll 2
          for (int d = 0; d < 64; ++d) { const float qd = qf[l * 64 + d];
#pragma unroll
              for (int j = 0; j < 16; ++j) a[j] += qd * cf[(vb + j) * 65 + d]; }
#pragma unroll 2
          for (int s = 0; s <= l; ++s) { const float sv = sq[l * 65 + s];
#pragma unroll
              for (int j = 0; j < 16; ++j) hv[j] += sv * vf[s * 128 + vb + j]; }
#pragma unroll
          for (int j = 0; j < 16; ++j) { hv[j] = (it * a[j] + hv[j]) * rd; ss += hv[j] * hv[j]; }
          ss += __shfl_xor(ss, 1); ss += __shfl_xor(ss, 2); ss += __shfl_xor(ss, 4);
          const float r = __builtin_amdgcn_rsqf(ss * (1.0f / 128.0f) + RMS_EPS);
          const size_t off = (size_t)(t0 + l) * D + h * DV + vb; const v4u* gp = (const v4u*)(OG + off); const f32x4* np = (const f32x4*)(P.head_norm + h * DV + vb);
          float y[16];
#pragma unroll
          for (int i = 0; i < 2; ++i) { const v4u u = gp[i]; const f32x4 n0 = np[2 * i], n1 = np[2 * i + 1];
              y[8 * i] = bflo(u.x) * hv[8 * i] * r * n0.x; y[8 * i + 1] = bfhi(u.x) * hv[8 * i + 1] * r * n0.y; y[8 * i + 2] = bflo(u.y) * hv[8 * i + 2] * r * n0.z; y[8 * i + 3] = bfhi(u.y) * hv[8 * i + 3] * r * n0.w;
              y[8 * i + 4] = bflo(u.z) * hv[8 * i + 4] * r * n1.x; y[8 * i + 5] = bfhi(u.z) * hv[8 * i + 5] * r * n1.y; y[8 * i + 6] = bflo(u.w) * hv[8 * i + 6] * r * n1.z; y[8 * i + 7] = bfhi(u.w) * hv[8 * i + 7] * r * n1.w; }
          v4u* yp = (v4u*)(Y + off);
#pragma unroll
          for (int i = 0; i < 2; ++i) { v4u o; o.x = pk2(y[8 * i], y[8 * i + 1]); o.y = pk2(y[8 * i + 2], y[8 * i + 3]); o.z = pk2(y[8 * i + 4], y[8 * i + 5]); o.w = pk2(y[8 * i + 6], y[8 * i + 7]); yp[i] = o; } }
        LDS_WAIT(); __syncthreads();
    }
}
__device__ __forceinline__ void p_final_norm(Frame& F, const Ptrs& P) {
    const int gw = F.vcu * NWAVES + F.wave, NGW = F.G * NWAVES;
    const f32x4* wn = (const f32x4*)P.final_norm + F.lane;
    for (int m = gw; m < M; m += NGW) {
        GAS f32x4* xr = (GAS f32x4*)(P.out + (size_t)m * D) + F.lane; f32x4 v[4]; float s = 0.f;
#pragma unroll
        for (int j = 0; j < 4; ++j) { v[j] = xr[64 * j]; s += (v[j].x * v[j].x + v[j].y * v[j].y) + (v[j].z * v[j].z + v[j].w * v[j].w); }
        const float r = __builtin_amdgcn_rsqf(wave_sum(s) * (1.0f / D) + RMS_EPS);
#pragma unroll
        for (int j = 0; j < 4; ++j) xr[64 * j] = v[j] * r * wn[64 * j];
    }
}

struct Args { Ptrs p; };
__global__ void __launch_bounds__(NWAVES * 64, 2) mk_fwd(Args args) {
    extern __shared__ __attribute__((aligned(16))) unsigned char lds[];
    const Ptrs& P = args.p;
    Frame F;
    F.lds = (LAS unsigned char*)lds;
    F.MISC = (volatile LAS unsigned*)(F.lds + MISC_OFF);
    F.tid = threadIdx.x; F.lane = F.tid & 63; F.wave = __builtin_amdgcn_readfirstlane(F.tid >> 6);
    F.G = gridDim.x; { const int bx = blockIdx.x; F.vcu = (F.G % 8 == 0) ? (bx % 8) * (F.G / 8) + bx / 8 : bx; }
    unsigned char* ws = P.ws;
    F.ctl = (gu32*)(ws + WS_CTL);
    for (int u = F.tid; u < (LDS_BYTES - LDSCTL_OFF) / 4; u += NWAVES * 64) ((LAS unsigned*)(F.lds + LDSCTL_OFF))[u] = 0u;
    __syncthreads();
    XcdBarrier bar = xcd_barrier_post((unsigned*)(F.ctl + CW_BAR), F.MISC + 8);
#define GRID_BAR() xcd_barrier(bar)
#ifndef PH_MASK
#define PH_MASK 0xFFFFF
#endif
#define PH(k) ((PH_MASK >> (k)) & 1)
    bf16* AB = (bf16*)(ws + WS_AB); bf16* HB1 = (bf16*)(ws + WS_HB1); bf16* ACT = (bf16*)(ws + WS_ACT);
    float* ssq0 = (float*)(ws + WS_SSQ); float* ssq1 = ssq0 + (size_t)M * 16; float* ssq2 = ssq1 + (size_t)M * 16; float* ssq3 = ssq2 + (size_t)M * 16;

    if (PH(0)) p0_prologue(F, P); GRID_BAR();
    if (PH(1)) { pg8::Gemm g{AB, (const bf16*)(ws + WS_WQKV), M, 3 * D, D}; pg8::StaticOrder S; S.init(M, 3 * D, F.G, (int)blockIdx.x);
      pg8::EpiQKV E{(bf16*)(ws + WS_Q), (size_t)(WS_K - WS_Q) / 2, ssq0, (const float*)(ws + WS_ROPE), (float*)(ws + WS_KMEAN)};
      pg8::gemm_phase<pg8::EpiQKV, pg8::StaticOrder, PG8_ALIGN, PG8_SP2>(F.lds + RING_OFF, g, S, E); GRID_BAR(); }
    if (PH(2)) p2_gating(F, P); GRID_BAR();
    if (PH(3)) p3_attention_naive(F, P); GRID_BAR();
    if (PH(4)) { pg8::Gemm g{AB, (const bf16*)(ws + WS_WO), M, D, D}; pg8::StaticOrder S; S.init(M, D, F.G, (int)blockIdx.x);
      pg8::EpiRes<true> E{P.x, P.out, HB1, ssq1};
      pg8::gemm_phase<pg8::EpiRes<true>, pg8::StaticOrder, PG8_ALIGN, PG8_SP2>(F.lds + RING_OFF, g, S, E); GRID_BAR(); }
    if (PH(5)) { pg8::Gemm g{HB1, (const bf16*)(ws + WS_WGU), M, NGU, D}; pg8::StaticOrder S; S.init(M, NGU, F.G, (int)blockIdx.x);
      pg8::EpiSwiGLU E{ACT, ssq1};
      pg8::gemm_phase<pg8::EpiSwiGLU, pg8::StaticOrder, PG8_ALIGN, PG8_SP2>(F.lds + RING_OFF, g, S, E); GRID_BAR(); }
    if (PH(6)) { pg8::Gemm g{ACT, (const bf16*)(ws + WS_WD), M, D, DFF}; pg8::StaticOrder S; S.init(M, D, F.G, (int)blockIdx.x);
      pg8::EpiRes<true> E{P.out, P.out, AB, ssq2};
      pg8::gemm_phase<pg8::EpiRes<true>, pg8::StaticOrder, PG8_ALIGN, PG8_SP2>(F.lds + RING_OFF, g, S, E); GRID_BAR(); }
    if (PH(7)) { pg8::Gemm g{AB, (const bf16*)(ws + WS_WIN), M, NIN, D}; pg8::StaticOrder S; S.init(M, NIN, F.G, (int)blockIdx.x);
      pg8::EpiMlstmIn E{(bf16*)(ws + WS_MQ), (bf16*)(ws + WS_MK), (bf16*)(ws + WS_MV), (bf16*)(ws + WS_OG), ssq2};
      pg8::gemm_phase<pg8::EpiMlstmIn, pg8::StaticOrder, PG8_ALIGN, PG8_SP2>(F.lds + RING_OFF, g, S, E); GRID_BAR(); }
    if (PH(8)) pa_mlstm_local(F, P); GRID_BAR();
    if (PH(9)) pb_mlstm_scan(F, P); GRID_BAR();
    if (PH(10)) pc_mlstm_out(F, P); GRID_BAR();
    if (PH(11)) { pg8::Gemm g{AB, (const bf16*)(ws + WS_WOUT), M, D, D}; pg8::StaticOrder S; S.init(M, D, F.G, (int)blockIdx.x);
      pg8::EpiRes<true> E{P.out, P.out, HB1, ssq3};
      pg8::gemm_phase<pg8::EpiRes<true>, pg8::StaticOrder, PG8_ALIGN, PG8_SP2>(F.lds + RING_OFF, g, S, E); GRID_BAR(); }
    if (PH(12)) { pg8::Gemm g{HB1, (const bf16*)(ws + WS_WGU) + (size_t)NGU * D, M, NGU, D}; pg8::StaticOrder S; S.init(M, NGU, F.G, (int)blockIdx.x);
      pg8::EpiSwiGLU E{ACT, ssq3};
      pg8::gemm_phase<pg8::EpiSwiGLU, pg8::StaticOrder, PG8_ALIGN, PG8_SP2>(F.lds + RING_OFF, g, S, E); GRID_BAR(); }
    if (PH(13)) { pg8::Gemm g{ACT, (const bf16*)(ws + WS_WD) + (size_t)D * DFF, M, D, DFF}; pg8::StaticOrder S; S.init(M, D, F.G, (int)blockIdx.x);
      pg8::EpiRes<false> E{P.out, P.out, nullptr, nullptr};
      pg8::gemm_phase<pg8::EpiRes<false>, pg8::StaticOrder, PG8_ALIGN, PG8_SP2>(F.lds + RING_OFF, g, S, E); GRID_BAR(); }
    if (PH(14)) p_final_norm(F, P);
}

extern "C" void kernel_launch(void* const* d_in, const int* in_sizes, int n_in, void* d_out, int out_size, void* d_ws, size_t ws_size, hipStream_t stream) {
    static int grid = 0;
    if (grid == 0) {
        if (n_in != 13 || in_sizes[0] != M * D || out_size != M * D || ws_size < WS_END) { fprintf(stderr, "kernel_launch: unexpected shapes (n_in %d, in0 %d, out %d, ws %zu); nothing launched\n", n_in, n_in > 0 ? in_sizes[0] : -1, out_size, ws_size); grid = -1; return; }
        int dev = 0, cus = 0, per_cu = 0;
        if (hipGetDevice(&dev) != hipSuccess || hipDeviceGetAttribute(&cus, hipDeviceAttributeMultiprocessorCount, dev) != hipSuccess) { grid = -1; return; }
        if (hipFuncSetAttribute((const void*)mk_fwd, hipFuncAttributeMaxDynamicSharedMemorySize, LDS_BYTES) != hipSuccess) { fprintf(stderr, "kernel_launch: hipFuncSetAttribute failed\n"); grid = -1; return; }
        if (hipOccupancyMaxActiveBlocksPerMultiprocessor(&per_cu, (const void*)mk_fwd, NWAVES * 64, LDS_BYTES) != hipSuccess || per_cu < 1) { fprintf(stderr, "kernel_launch: occupancy query reports %d blocks per CU\n", per_cu); }
        (void)hipGetLastError();
        grid = cus;
    }
    if (grid < 0) return;
    if (hipMemsetAsync((char*)d_ws + WS_CTL, 0, CTL_ZERO_BYTES, stream) != hipSuccess) { fprintf(stderr, "kernel_launch: hipMemsetAsync failed\n"); return; }
    Args a{};
    a.p.x = (const float*)d_in[0]; a.p.attn_norm = (const float*)d_in[1]; a.p.w_qkv = (const float*)d_in[2]; a.p.w_o = (const float*)d_in[3];
    a.p.mlstm_norm = (const float*)d_in[4]; a.p.w_in = (const float*)d_in[5]; a.p.b_gates = (const float*)d_in[6]; a.p.head_norm = (const float*)d_in[7]; a.p.w_out = (const float*)d_in[8];
    a.p.ffn_norm = (const float*)d_in[9]; a.p.w_gu = (const float*)d_in[10]; a.p.w_down = (const float*)d_in[11]; a.p.final_norm = (const float*)d_in[12];
    a.p.out = (float*)d_out; a.p.ws = (unsigned char*)d_ws;
    hipLaunchKernelGGL(mk_fwd, dim3(grid), dim3(NWAVES * 64), LDS_BYTES, stream, a);
    const hipError_t le = hipPeekAtLastError();
    if (le != hipSuccess) fprintf(stderr, "kernel_launch: launch failed: %s\n", hipGetErrorName(le));
}
```

```cpp
#include <hip/hip_runtime.h>
#include <cstdio>
#include <cstdint>
namespace pg8 {
#define PG8_LAS __attribute__((address_space(3)))
typedef unsigned short bf16_t;
typedef short bf16x8 __attribute__((ext_vector_type(8)));
typedef float f32x4 __attribute__((ext_vector_type(4)));
typedef unsigned u32x4 __attribute__((ext_vector_type(4)));
constexpr int BM = 256, BK = 64, HALF = 128, HTB = HALF * BK * 2  , STAGE_BYTES = 8 * HTB, NXCD = 8, WGM = 8;

__host__ __device__ __forceinline__ int lds_byte(int r, int c) { const int st = (r >> 4) * 2 + (c >> 5), rr = r & 15, cc = c & 31, ob = rr * 64 + cc * 2; return st * 1024 + (ob ^ (((ob >> 9) & 1) << 5)); }
__host__ __device__ __forceinline__ void stage_rc(int b, int& R, int& C) { const int st = b / 1024, sb = b % 1024, swz = sb ^ (((sb >> 9) & 1) << 5); R = (st >> 1) * 16 + swz / 64; C = (st & 1) * 32 + (swz % 64) / 2; }
__host__ __device__ __forceinline__ int perm32(int rho) { const int n = rho >> 4, i = rho & 15; return 8 * (i >> 2) + 4 * n + (i & 3); }

struct Unit { int pm, pn; };
struct Gemm { const bf16_t* A; const bf16_t* Bt; int M, N, K; };

struct StaticOrder {
    int nM, nN, nwg, G, c;
    __host__ __device__ void init(int M, int N, int G_, int c_) { nM = M / BM; nN = N / BM; nwg = nM * nN; G = G_; c = c_; }
    __host__ __device__ bool next(int i, Unit& u) const {
        const long L = (long)i * G + c; if (L >= nwg) return false;
        int wgid = (int)L; { const int q = nwg / NXCD, r = nwg % NXCD, xcd = wgid % NXCD, off = wgid / NXCD; wgid = (xcd < r ? xcd * (q + 1) : r * (q + 1) + (xcd - r) * q) + off; }
        const int nig = WGM * nN, gid = wgid / nig, fm = gid * WGM, gsz = (nM - fm) < WGM ? (nM - fm) : WGM;
        u.pm = fm + ((wgid % nig) % gsz); u.pn = (wgid % nig) / gsz; return true;
    }
    __device__ __forceinline__ void a_ready(const Unit&) const {}
    __device__ __forceinline__ void done(const Unit&) const {}
};
__device__ __forceinline__ unsigned cvt_pk_bf16(float lo, float hi) { unsigned r; asm volatile("v_cvt_pk_bf16_f32 %0, %1, %2" : "=v"(r) : "v"(lo), "v"(hi)); return r; }
typedef float f32x2 __attribute__((ext_vector_type(2)));
constexpr float RMS_EPS_F = 1e-6f;
constexpr float QSCALE_LOG2 = 0.18033688011112042f;
__device__ __forceinline__ float row_rstd(const float* ssq, int row) {
    const f32x4* p = (const f32x4*)(ssq + (size_t)row * 16);
    const f32x4 a = p[0], b = p[1], c = p[2], d = p[3];
    const float s = (((a[0] + a[1]) + (a[2] + a[3])) + ((b[0] + b[1]) + (b[2] + b[3]))) + (((c[0] + c[1]) + (c[2] + c[3])) + ((d[0] + d[1]) + (d[2] + d[3])));
    return __builtin_amdgcn_rsqf(s * (1.0f / 1024.0f) + RMS_EPS_F);
}
__device__ __forceinline__ u32x4 pack8(const f32x4& v0, const f32x4& v1) { u32x4 w; w.x = cvt_pk_bf16(v0[0], v0[1]); w.y = cvt_pk_bf16(v0[2], v0[3]); w.z = cvt_pk_bf16(v1[0], v1[1]); w.w = cvt_pk_bf16(v1[2], v1[3]); return w; }

struct EpiQKV {
    static constexpr bool PERM = true, AFTER_DRAIN = false;
    bf16_t* QKV; size_t tstride; const float* ssq; const float* rope; float* kmean;
    __device__ __forceinline__ void operator()(const f32x4 (&acc)[2][2][4][2], const Unit& u, int wr, int wc, int fr, int fq) const {
        const int t = u.pn >> 2;
        bf16_t* base = QKV + (size_t)t * tstride;
        const int col0 = (u.pn & 3) * BM + wc * 32 + 8 * fq;
        const bool rot = (t < 2) && ((wc & 1) == 0) && (fq < 2);
        const float sc = (t == 0) ? QSCALE_LOG2 : 1.0f;
        const int lane = fq * 16 + fr;
        float rv[2];
#pragma unroll
        for (int ai = 0; ai < 2; ++ai) rv[ai] = row_rstd(ssq, u.pm * BM + ai * HALF + wr * 64 + lane);
#pragma unroll
        for (int bj = 0; bj < 2; ++bj) {
            f32x4 ks0 = (f32x4){0.f, 0.f, 0.f, 0.f}, ks1 = ks0;
#pragma unroll
            for (int ai = 0; ai < 2; ++ai)
#pragma unroll
                for (int m = 0; m < 4; ++m) {
                    const int row = u.pm * BM + ai * HALF + wr * 64 + m * 16 + fr;
                    const float rs = __shfl(rv[ai], m * 16 + fr);
                    f32x4 v0 = acc[ai][bj][m][0] * rs, v1 = acc[ai][bj][m][1] * rs;
                    if (rot) { const f32x4* rp = (const f32x4*)(rope + (size_t)(row & 8191) * 16 + 8 * fq); const f32x4 cs0 = rp[0], cs1 = rp[1];
                        const f32x4 c = (f32x4){cs0[0], cs0[2], cs1[0], cs1[2]}, s = (f32x4){cs0[1], cs0[3], cs1[1], cs1[3]};
                        const f32x4 x1 = v0, x2 = v1; v0 = x1 * c - x2 * s; v1 = x2 * c + x1 * s; }
                    if (t == 1) { ks0 += v0; ks1 += v1; }
                    v0 = v0 * sc; v1 = v1 * sc;
                    *(u32x4*)(base + (size_t)row * 1024 + col0 + bj * HALF) = pack8(v0, v1);
                    if (m & 1) asm volatile("" ::: "memory");
                }
            if (t == 1) {
                float* km = kmean + (size_t)u.pm * 1024 + col0 + bj * HALF;
#pragma unroll
                for (int j = 0; j < 4; ++j) {
                    float r0 = ks0[j]; r0 += __shfl_xor(r0, 1); r0 += __shfl_xor(r0, 2); r0 += __shfl_xor(r0, 4); r0 += __shfl_xor(r0, 8);
                    float r1 = ks1[j]; r1 += __shfl_xor(r1, 1); r1 += __shfl_xor(r1, 2); r1 += __shfl_xor(r1, 4); r1 += __shfl_xor(r1, 8);
                    if (fr == 0) { atomicAdd(km + j, r0 * (1.0f / 256.0f)); atomicAdd(km + 4 + j, r1 * (1.0f / 256.0f)); }
                }
            }
        }
    }
};

template <bool WRITE_HB> struct EpiRes {
    static constexpr bool PERM = true, AFTER_DRAIN = false;
    const float* base; float* out; bf16_t* hb; float* ssq_out;
    __device__ __forceinline__ void operator()(const f32x4 (&acc)[2][2][4][2], const Unit& u, int wr, int wc, int fr, int fq) const {
        const int col0 = u.pn * BM + wc * 32 + 8 * fq;
#pragma unroll
        for (int ai = 0; ai < 2; ++ai)
#pragma unroll
            for (int m = 0; m < 4; ++m) {
                const int row = u.pm * BM + ai * HALF + wr * 64 + m * 16 + fr;
                float ss = 0.f;
#pragma unroll
                for (int bj = 0; bj < 2; ++bj) {
                    const size_t off = (size_t)row * 1024 + col0 + bj * HALF;
                    const f32x4 b0 = *(const f32x4*)(base + off), b1 = *(const f32x4*)(base + off + 4);
                    const f32x4 v0 = acc[ai][bj][m][0] + b0, v1 = acc[ai][bj][m][1] + b1;
                    *(f32x4*)(out + off) = v0; *(f32x4*)(out + off + 4) = v1;
                    ss += ((v0[0] * v0[0] + v0[1] * v0[1]) + (v0[2] * v0[2] + v0[3] * v0[3])) + ((v1[0] * v1[0] + v1[1] * v1[1]) + (v1[2] * v1[2] + v1[3] * v1[3]));
                    if (WRITE_HB) *(u32x4*)(hb + off) = pack8(v0, v1);
                }
                if (WRITE_HB) { ss += __shfl_xor(ss, 16); ss += __shfl_xor(ss, 32); if (fq == 0) ssq_out[(size_t)row * 16 + u.pn * 4 + wc] = ss; }
            }
    }
};

struct EpiSwiGLU {
    static constexpr bool PERM = true, AFTER_DRAIN = false;
    bf16_t* act; const float* ssq;
    __device__ __forceinline__ void operator()(const f32x4 (&acc)[2][2][4][2], const Unit& u, int wr, int wc, int fr, int fq) const {
        const int col0 = u.pn * HALF + wc * 32 + 8 * fq;
#pragma unroll
        for (int ai = 0; ai < 2; ++ai)
#pragma unroll
            for (int m = 0; m < 4; ++m) {
                const int row = u.pm * BM + ai * HALF + wr * 64 + m * 16 + fr;
                const float rs = row_rstd(ssq, row);
                f32x4 o[2];
#pragma unroll
                for (int n = 0; n < 2; ++n) {
                    const f32x4 g = acc[ai][0][m][n] * rs, up = acc[ai][1][m][n] * rs;
#pragma unroll
                    for (int j = 0; j < 4; ++j) { const float e = __builtin_amdgcn_exp2f(g[j] * -1.4426950408889634f); o[n][j] = g[j] * up[j] * __builtin_amdgcn_rcpf(1.0f + e); }
                }
                *(u32x4*)(act + (size_t)row * 2816 + col0) = pack8(o[0], o[1]);
            }
    }
};

struct EpiMlstmIn {
    static constexpr bool PERM = true, AFTER_DRAIN = false;
    bf16_t* MQ; bf16_t* MK; bf16_t* MV; bf16_t* OG; const float* ssq;
    __device__ __forceinline__ void operator()(const f32x4 (&acc)[2][2][4][2], const Unit& u, int wr, int wc, int fr, int fq) const {
        bf16_t* base; int ld, colt; float sc = 1.0f; bool sig = false;
        if (u.pn < 2) { base = MQ; ld = 512; colt = u.pn * BM; sc = 0.125f; }
        else if (u.pn < 4) { base = MK; ld = 512; colt = (u.pn - 2) * BM; }
        else if (u.pn < 8) { base = MV; ld = 1024; colt = (u.pn - 4) * BM; }
        else { base = OG; ld = 1024; colt = (u.pn - 8) * BM; sig = true; }
        const int col0 = colt + wc * 32 + 8 * fq;
#pragma unroll
        for (int ai = 0; ai < 2; ++ai)
#pragma unroll
            for (int m = 0; m < 4; ++m) {
                const int row = u.pm * BM + ai * HALF + wr * 64 + m * 16 + fr;
                const float rs = row_rstd(ssq, row) * sc;
#pragma unroll
                for (int bj = 0; bj < 2; ++bj) {
                    f32x4 v0 = acc[ai][bj][m][0] * rs, v1 = acc[ai][bj][m][1] * rs;
                    if (sig) {
#pragma unroll
                        for (int j = 0; j < 4; ++j) { v0[j] = __builtin_amdgcn_rcpf(1.0f + __builtin_amdgcn_exp2f(v0[j] * -1.4426950408889634f)); v1[j] = __builtin_amdgcn_rcpf(1.0f + __builtin_amdgcn_exp2f(v1[j] * -1.4426950408889634f)); }
                    }
                    *(u32x4*)(base + (size_t)row * ld + col0 + bj * HALF) = pack8(v0, v1);
                }
            }
    }
};
template <class Epi, class Sched, bool ALIGN_EPI = false, bool SP2 = false>
__device__ __forceinline__ void gemm_phase(PG8_LAS unsigned char* lds, const Gemm g, const Sched& S, const Epi& E) {
    int tid_ = threadIdx.x; asm volatile("" : "+v"(tid_));
    const int tid = tid_, wid = __builtin_amdgcn_readfirstlane(tid >> 6), lane = tid & 63, wr = wid >> 2, wc = wid & 3, fr = lane & 15, fq = lane >> 4;
    const int K = g.K, nt = K / BK;
    unsigned voffA[2], voffB[2];
#pragma unroll
    for (int i = 0; i < 2; ++i) { int R, C; stage_rc(tid * 16 + i * 8192, R, C); const int Rb = Epi::PERM ? ((R & ~31) + perm32(R & 31)) : R;
        voffA[i] = (unsigned)(R * K + C) * 2u; voffB[i] = (unsigned)(Rb * K + C) * 2u; }
    const size_t kstep = (size_t)(BK * 2);
    const size_t hstep = (size_t)HALF * K * 2;
    const size_t tstep = 2 * hstep;
    const unsigned ldsw = (unsigned)wid * 1024u;
    const int aoff = lds_byte(wr * 64 + fr, fq * 8), boff = lds_byte(wc * 32 + fr, fq * 8);
#define PG8_SA(b, h) (((b) * 2 + (h)) * HTB)
#define PG8_SB(b, h) ((4 + (b) * 2 + (h)) * HTB)
#define PG8_STAGE(bufoff, gbase, voff) do { _Pragma("unroll") for (int _i = 0; _i < 2; ++_i) \
        __builtin_amdgcn_global_load_lds((const unsigned*)((const char*)(gbase) + (voff)[_i]), (PG8_LAS unsigned*)(lds + (bufoff) + ldsw + _i * 8192), 16, 0, 0); } while (0)
#define PG8_LDA(dst, b, h) do { _Pragma("unroll") for (int m = 0; m < 4; ++m) _Pragma("unroll") for (int k = 0; k < 2; ++k) dst[m][k] = *(const PG8_LAS bf16x8*)(lds + PG8_SA(b, h) + aoff + m * 2048 + k * 1024); } while (0)
#define PG8_LDB(dst, b, h) do { _Pragma("unroll") for (int n = 0; n < 2; ++n) _Pragma("unroll") for (int k = 0; k < 2; ++k) dst[n][k] = *(const PG8_LAS bf16x8*)(lds + PG8_SB(b, h) + boff + n * 2048 + k * 1024); } while (0)
#define PG8_MMA(ai, bj, At, Bt) do { __builtin_amdgcn_s_setprio(1); _Pragma("unroll") for (int m = 0; m < 4; ++m) _Pragma("unroll") for (int n = 0; n < 2; ++n) _Pragma("unroll") for (int k = 0; k < 2; ++k) \
        acc[ai][bj][m][n] = __builtin_amdgcn_mfma_f32_16x16x32_bf16(Bt[n][k], At[m][k], acc[ai][bj][m][n], 0, 0, 0); __builtin_amdgcn_s_setprio(0); } while (0)
#define PG8_WAIT_V(n) asm volatile("s_waitcnt vmcnt(" #n ")" ::: "memory")
#define PG8_WAIT_L(n) asm volatile("s_waitcnt lgkmcnt(" #n ")" ::: "memory")
#define PG8_BAR __builtin_amdgcn_s_barrier()
#define PG8_SCHED __builtin_amdgcn_sched_barrier(0)
    Unit cur, nxt; int ui = 0;
    if (!S.next(0, cur)) return;
    f32x4 acc[2][2][4][2];
#pragma unroll
    for (int a = 0; a < 2; ++a)
#pragma unroll
        for (int b = 0; b < 2; ++b)
#pragma unroll
            for (int m = 0; m < 4; ++m)
#pragma unroll
                for (int n = 0; n < 2; ++n) acc[a][b][m][n] = (f32x4){0.f, 0.f, 0.f, 0.f};
    bf16x8 At[4][2], B0[2][2], B1[2][2];
    const char* cA = (const char*)g.A + (size_t)cur.pm * tstep; const char* cB = (const char*)g.Bt + (size_t)cur.pn * tstep;
    S.a_ready(cur);
    if constexpr (SP2) {
        PG8_STAGE(PG8_SB(0, 0), cB, voffB); PG8_STAGE(PG8_SB(0, 1), cB + hstep, voffB); PG8_STAGE(PG8_SA(0, 0), cA, voffA); PG8_STAGE(PG8_SA(0, 1), cA + hstep, voffA);
        if (wr == 1) PG8_BAR;
        PG8_WAIT_V(2); PG8_BAR;
        PG8_STAGE(PG8_SB(1, 0), cB + kstep, voffB); PG8_STAGE(PG8_SA(1, 0), cA + kstep, voffA); PG8_STAGE(PG8_SB(1, 1), cB + hstep + kstep, voffB);
        PG8_WAIT_V(6); PG8_BAR;
    } else {
        PG8_STAGE(PG8_SB(0, 0), cB, voffB); PG8_STAGE(PG8_SA(0, 0), cA, voffA); PG8_STAGE(PG8_SB(0, 1), cB + hstep, voffB); PG8_STAGE(PG8_SA(0, 1), cA + hstep, voffA);
        if (wr == 1) PG8_BAR;
        PG8_WAIT_V(4); PG8_BAR;
        PG8_STAGE(PG8_SB(1, 0), cB + kstep, voffB); PG8_STAGE(PG8_SA(1, 0), cA + kstep, voffA); PG8_STAGE(PG8_SB(1, 1), cB + hstep + kstep, voffB);
        PG8_WAIT_V(6); PG8_BAR;
    }
    for (;;) {
        const bool has_next = S.next(ui + 1, nxt);
        const char* nA = has_next ? (const char*)g.A + (size_t)nxt.pm * tstep : cA; const char* nB = has_next ? (const char*)g.Bt + (size_t)nxt.pn * tstep : cB;
        for (int t = 0; t < nt; t += 2) {
            const bool last = (t == nt - 2);
            const char* a1 = cA + (size_t)(t + 1) * kstep;
            const char* a2 = last ? nA : cA + (size_t)(t + 2) * kstep; const char* b2 = last ? nB : cB + (size_t)(t + 2) * kstep;
            const char* a3 = a2 + kstep; const char* b3 = b2 + kstep;
            if (last && has_next) S.a_ready(nxt);
            if constexpr (SP2) {
            PG8_LDB(B0, 0, 0); PG8_LDB(B1, 0, 1); PG8_SCHED; PG8_LDA(At, 0, 0); PG8_STAGE(PG8_SA(1, 1), a1 + hstep, voffA);
            PG8_WAIT_V(8); PG8_WAIT_L(0); PG8_BAR; PG8_MMA(0, 0, At, B0); PG8_MMA(0, 1, At, B1); PG8_BAR; PG8_SCHED;
            PG8_LDA(At, 0, 1); PG8_STAGE(PG8_SB(0, 0), b2, voffB); PG8_STAGE(PG8_SB(0, 1), b2 + hstep, voffB); PG8_STAGE(PG8_SA(0, 0), a2, voffA);
            PG8_WAIT_V(8); PG8_WAIT_L(0); PG8_BAR; PG8_MMA(1, 0, At, B0); PG8_MMA(1, 1, At, B1); PG8_BAR; PG8_SCHED;
            PG8_LDB(B0, 1, 0); PG8_LDB(B1, 1, 1); PG8_SCHED; PG8_LDA(At, 1, 0); PG8_STAGE(PG8_SA(0, 1), a2 + hstep, voffA);
            PG8_WAIT_V(8); PG8_WAIT_L(0); PG8_BAR; PG8_MMA(0, 0, At, B0); PG8_MMA(0, 1, At, B1); PG8_BAR; PG8_SCHED;
            PG8_LDA(At, 1, 1); PG8_STAGE(PG8_SB(1, 0), b3, voffB); PG8_STAGE(PG8_SB(1, 1), b3 + hstep, voffB); PG8_STAGE(PG8_SA(1, 0), a3, voffA);
            PG8_WAIT_V(8); PG8_WAIT_L(0); PG8_BAR; PG8_MMA(1, 0, At, B0); PG8_MMA(1, 1, At, B1); PG8_BAR; PG8_SCHED;
            } else {
            PG8_LDB(B0, 0, 0); PG8_SCHED; PG8_LDA(At, 0, 0); PG8_STAGE(PG8_SA(1, 1), a1 + hstep, voffA);
            PG8_WAIT_L(8); PG8_BAR; PG8_WAIT_L(0); PG8_MMA(0, 0, At, B0); PG8_BAR; PG8_SCHED;
            PG8_LDB(B1, 0, 1); PG8_STAGE(PG8_SB(0, 0), b2, voffB);
            PG8_BAR; PG8_WAIT_L(0); PG8_MMA(0, 1, At, B1); PG8_BAR;
            PG8_LDA(At, 0, 1); PG8_STAGE(PG8_SA(0, 0), a2, voffA);
            PG8_BAR; PG8_WAIT_L(0); PG8_MMA(1, 0, At, B0); PG8_BAR; PG8_SCHED;
            PG8_STAGE(PG8_SB(0, 1), b2 + hstep, voffB);
            PG8_WAIT_V(6); PG8_BAR; PG8_MMA(1, 1, At, B1); PG8_BAR;
            PG8_LDB(B0, 1, 0); PG8_SCHED; PG8_LDA(At, 1, 0); PG8_STAGE(PG8_SA(0, 1), a2 + hstep, voffA);
            PG8_WAIT_L(8); PG8_BAR; PG8_WAIT_L(0); PG8_MMA(0, 0, At, B0); PG8_BAR; PG8_SCHED;
            PG8_LDB(B1, 1, 1); PG8_STAGE(PG8_SB(1, 0), b3, voffB);
            PG8_BAR; PG8_WAIT_L(0); PG8_MMA(0, 1, At, B1); PG8_BAR;
            PG8_LDA(At, 1, 1); PG8_STAGE(PG8_SA(1, 0), a3, voffA);
            PG8_BAR; PG8_WAIT_L(0); PG8_MMA(1, 0, At, B0); PG8_BAR; PG8_SCHED;
            PG8_STAGE(PG8_SB(1, 1), b3 + hstep, voffB);
            PG8_WAIT_V(6); PG8_BAR; PG8_MMA(1, 1, At, B1); PG8_BAR;
            }
        }
        if constexpr (ALIGN_EPI) { if (wr == 0) PG8_BAR; }
        if constexpr (!Epi::AFTER_DRAIN) { E(acc, cur, wr, wc, fr, fq); S.done(cur); }
        if (!has_next) break;
#pragma unroll
        for (int a = 0; a < 2; ++a)
#pragma unroll
            for (int b = 0; b < 2; ++b)
#pragma unroll
                for (int m = 0; m < 4; ++m)
#pragma unroll
                    for (int n = 0; n < 2; ++n) acc[a][b][m][n] = (f32x4){0.f, 0.f, 0.f, 0.f};
        cur = nxt; cA = nA; cB = nB; ++ui;
        if constexpr (ALIGN_EPI) { if (wr == 1) PG8_BAR; }
    }
    PG8_WAIT_V(0);
    if constexpr (!ALIGN_EPI) { if (wr == 0) PG8_BAR; }
    PG8_BAR;
    if constexpr (Epi::AFTER_DRAIN) { E.fused(acc, cur, wr, wc, fr, fq, lds, wid, lane); S.done(cur); }
#undef PG8_SA
#undef PG8_SB
#undef PG8_STAGE
#undef PG8_LDA
#undef PG8_LDB
#undef PG8_MMA
#undef PG8_WAIT_V
#undef PG8_WAIT_L
#undef PG8_BAR
#undef PG8_SCHED
}
}

#ifndef PG8_SP2
#define PG8_SP2 true
#endif
#ifndef PG8_ALIGN
#define PG8_ALIGN true
#endif
#define GAS __attribute__((address_space(1)))
#define LAS __attribute__((address_space(3)))
typedef unsigned short bf16;
typedef unsigned v4u __attribute__((ext_vector_type(4)));
typedef float f32x4 __attribute__((ext_vector_type(4)));
typedef short bf16x8 __attribute__((ext_vector_type(8)));
typedef GAS unsigned gu32;
typedef GAS unsigned long long gu64;
#define RLX_AGENT __ATOMIC_RELAXED, __HIP_MEMORY_SCOPE_AGENT
#define LDS_WAIT() asm volatile("s_waitcnt lgkmcnt(0)" ::: "memory")
#define VM_WAIT() asm volatile("s_waitcnt vmcnt(0)" ::: "memory")
__device__ __forceinline__ unsigned long long rt() { return __builtin_amdgcn_s_memrealtime(); }
__device__ __forceinline__ unsigned f2bf(float f) { unsigned u = __builtin_bit_cast(unsigned, f); return (u + 0x7fffu + ((u >> 16) & 1u)) >> 16; }
__device__ __forceinline__ unsigned pk2(float lo, float hi) { return f2bf(lo) | (f2bf(hi) << 16); }

#define XB_TMO      128
#define XB_XCNT(j)  (256  + 64 * (j))
#define XB_XSUB(j)  (1280 + 64 * (j))
#define XB_XGEN(j)  (2304 + 64 * (j))
#define XB_TOP      3328
#define XB_TOPGEN   3392
#define XCD_BAR_WORDS 3456
#define XB_SPIN_CAP (1u << 18)

__device__ __forceinline__ unsigned xb_ld(unsigned* p)              { return __hip_atomic_load(p, __ATOMIC_RELAXED, __HIP_MEMORY_SCOPE_AGENT); }
__device__ __forceinline__ unsigned xb_add(unsigned* p, unsigned v) { return __hip_atomic_fetch_add(p, v, __ATOMIC_RELAXED, __HIP_MEMORY_SCOPE_AGENT); }
__device__ __forceinline__ unsigned xb_xcc_id() { return (unsigned)__builtin_amdgcn_s_getreg((3 << 11) | 20) & 0xFu; }
#define XB_SPIN(cond, bar) do { unsigned _sp = 0; while (cond) { __builtin_amdgcn_s_sleep(1); \
    if ((++_sp & 255u) == 0u) { if (xb_ld(&(bar)[XB_TMO])) break; if (_sp > XB_SPIN_CAP) { atomicAdd(&(bar)[XB_TMO], 1u); break; } } } } while (0)

struct XcdBarrier {
    unsigned* bar; unsigned x;
    volatile LAS unsigned* st;
};

__device__ __forceinline__ XcdBarrier xcd_barrier_post(unsigned* bar, volatile LAS unsigned* st) {
    XcdBarrier b; b.bar = bar; b.x = xb_xcc_id(); b.st = st;
    if (threadIdx.x == 0) (void)xb_add(&bar[XB_XCNT(b.x)], 1u);
    return b;
}
__device__ __forceinline__ void xcd_barrier_complete(unsigned* bar, unsigned x, unsigned& nloc, unsigned& nx) {
    const unsigned G = gridDim.x * gridDim.y * gridDim.z;
    unsigned sum, cnt, mine, sp = 0u;
    for (;;) {
        sum = 0u; cnt = 0u; mine = 0u;
#pragma unroll
        for (unsigned j = 0; j < 16; ++j) { const unsigned c = xb_ld(&bar[XB_XCNT(j)]); sum += c; cnt += (c > 0u) ? 1u : 0u; mine = (j == x) ? c : mine; }
        if (sum == G) break;
        __builtin_amdgcn_s_sleep(1);
        if ((++sp & 255u) == 0u) { if (xb_ld(&bar[XB_TMO])) break; if (sp > XB_SPIN_CAP) { atomicAdd(&bar[XB_TMO], 1u); break; } }
    }
    nloc = mine > 0u ? mine : 1u; nx = cnt > 0u ? cnt : 1u;
}

__device__ __forceinline__ void xcd_barrier(const XcdBarrier& b) {
    asm volatile("s_waitcnt vmcnt(0)" ::: "memory");
    __syncthreads();
    if (threadIdx.x == 0) {
        unsigned* bar = b.bar;
        __builtin_amdgcn_s_waitcnt(0);
        unsigned nloc = b.st[0], nx = b.st[1];
        if (nloc == 0u) { xcd_barrier_complete(bar, b.x, nloc, nx); b.st[0] = nloc; b.st[1] = nx; }
        const unsigned old = xb_add(&bar[XB_XSUB(b.x)], 1u);
        const unsigned gen = old / nloc;
        if (old + 1u == (gen + 1u) * nloc) {
            __builtin_amdgcn_fence(__ATOMIC_RELEASE, "agent");
            asm volatile("s_waitcnt vmcnt(0)" ::: "memory");
            const unsigned og = xb_add(&bar[XB_TOP], 1u);
            const unsigned tg = og / nx;
            if (og + 1u == (tg + 1u) * nx) xb_add(&bar[XB_TOPGEN], 1u);
            else XB_SPIN(xb_ld(&bar[XB_TOPGEN]) == tg, bar);
            __builtin_amdgcn_fence(__ATOMIC_ACQUIRE, "agent");
            xb_add(&bar[XB_XGEN(b.x)], 1u);
            asm volatile("s_waitcnt vmcnt(0)" ::: "memory");
        } else {
            XB_SPIN(xb_ld(&bar[XB_XGEN(b.x)]) == gen, bar);
            __builtin_amdgcn_fence(__ATOMIC_ACQUIRE, "agent");
            asm volatile("s_waitcnt vmcnt(0)" ::: "memory");
        }
    }
    __syncthreads();
}
constexpr int NWAVES = 8;
constexpr int BATCH = 2, SEQ = 8192, D = 1024, M = BATCH * SEQ, NH = 16, HD = 64, MB = 256, NBLK = SEQ / MB;
constexpr int DFF = 2816, NGU = 2 * DFF;
constexpr int MH = 8, DK = 64, DV = 128, LCH = 64, NCH = SEQ / LCH, NUNIT = BATCH * MH * NCH;
constexpr int NIN = 3072, NINW = 3088;
constexpr float RMS_EPS = 1e-6f, SOFTCAP = 15.0f, LOG2E = 1.4426950408889634f;

constexpr size_t MiB = 1u << 20;
constexpr size_t WS_CTL = 0, CTL_ZERO_BYTES = 1 * MiB;
constexpr size_t WS_KMEAN = 512 * 1024;
constexpr size_t WS_SSQ = 1 * MiB;
constexpr size_t WS_BIG = 5 * MiB;
constexpr size_t WS_SEL = 6 * MiB;
constexpr size_t WS_ROPE = 7 * MiB;
constexpr size_t WS_WG = 7 * MiB + 512 * 1024;
constexpr size_t WS_WQKV = 8 * MiB, WS_WO = 14 * MiB, WS_WIN = 16 * MiB, WS_WOUT = 22 * MiB, WS_WGU = 24 * MiB  , WS_WD = 46 * MiB  ;
constexpr size_t WS_NLOC = 57 * MiB;
constexpr size_t WS_SCAL = 57 * MiB + 512 * 1024;
constexpr size_t WS_AB = 64 * MiB;
constexpr size_t WS_Q = 96 * MiB, WS_K = 128 * MiB, WS_V = 160 * MiB;
constexpr size_t WS_HB1 = 96 * MiB;
constexpr size_t WS_ACT = 128 * MiB;
constexpr size_t WS_MQ = 96 * MiB, WS_MK = 112 * MiB, WS_MV = 128 * MiB, WS_OG = 160 * MiB, WS_CLOC = 192 * MiB;
constexpr size_t WS_END = 256 * MiB;
constexpr int CW_BAR = 4096;

constexpr int RING_OFF = 0, RING_BYTES = 131072;
constexpr int LDSCTL_OFF = RING_BYTES, MISC_OFF = LDSCTL_OFF + 320;
constexpr int LDS_BYTES = 147456;
static_assert(MISC_OFF + 128 <= LDS_BYTES, "LDS map");

__device__ __forceinline__ float bf2f(unsigned short h) { return __builtin_bit_cast(float, (unsigned)h << 16); }
__device__ __forceinline__ float bflo(unsigned w) { return __builtin_bit_cast(float, w << 16); }
__device__ __forceinline__ float bfhi(unsigned w) { return __builtin_bit_cast(float, w & 0xffff0000u); }
__device__ __forceinline__ float wave_sum(float v) {
#pragma unroll
    for (int o = 1; o < 64; o <<= 1) v += __shfl_xor(v, o);
    return v;
}
__device__ __forceinline__ float wave_max(float v) {
#pragma unroll
    for (int o = 1; o < 64; o <<= 1) v = fmaxf(v, __shfl_xor(v, o));
    return v;
}
__device__ __forceinline__ float fexp(float x) { return __builtin_amdgcn_exp2f(x * LOG2E); }

struct Frame {
    LAS unsigned char* lds;
    volatile LAS unsigned* MISC;
    gu32* ctl;
    int wave, vcu, G;
};

template <int MODE> __device__ __forceinline__ int src_col(int n) {
    if (MODE == 1) {
        if (n >= 2048) return n;
        const int s = n & 63; int d = s;
        if (s < 16) d = (s & 3) | ((s & 4) << 1) | ((s & 8) >> 1);
        return (n & ~63) | d;
    }
    if (MODE == 2) { const int pn = n >> 8, r = n & 255; return (r < 128) ? pn * 128 + r : DFF + pn * 128 + (r - 128); }
    return n;
}
template <int MODE> __device__ __forceinline__ void p0_transpose_item(const float* W, int K, int Nsrc, int Nout, const float* kscale, bf16* WT, LAS float* scr, int item, int lane) {
    const int nblk = Nout / 32, kb = item / nblk, nb = item % nblk, k0 = 64 * kb, n0 = 32 * nb;
    const int sc = src_col<MODE>(n0 + (lane & 31));
#pragma unroll 8
    for (int i = 0; i < 32; ++i) { const int kk = 2 * i + (lane >> 5); float w = W[(size_t)(k0 + kk) * Nsrc + sc]; if (kscale) w *= kscale[k0 + kk]; scr[kk * 33 + (lane & 31)] = w; }
    LDS_WAIT(); asm volatile("" ::: "memory");
    const int c = lane & 7;
#pragma unroll
    for (int j = 0; j < 4; ++j) { const int n = (lane >> 3) + 8 * j; const LAS float* s = scr + (8 * c) * 33 + n;
        v4u o; o.x = pk2(s[0 * 33], s[1 * 33]); o.y = pk2(s[2 * 33], s[3 * 33]); o.z = pk2(s[4 * 33], s[5 * 33]); o.w = pk2(s[6 * 33], s[7 * 33]);
        *(GAS v4u*)(WT + (size_t)(n0 + n) * K + k0 + 8 * c) = o; }
    LDS_WAIT(); asm volatile("" ::: "memory");
}

struct Ptrs {
    const float *x, *attn_norm, *w_qkv, *w_o, *mlstm_norm, *w_in, *b_gates, *head_norm, *w_out, *ffn_norm, *w_gu, *w_down, *final_norm;
    float* out; unsigned char* ws;
};

__device__ __forceinline__ void p0_prologue(Frame& F, const Ptrs& P) {
    LAS float* scr = (LAS float*)(F.lds + RING_OFF + F.wave * 16384);
    unsigned char* ws = P.ws;
    const int gw = F.vcu * NWAVES + F.wave, NGW = F.G * NWAVES;
    constexpr int I_QKV = (D / 64) * (3 * D / 32), I_O = (D / 64) * (D / 32), I_IN = (D / 64) * (NIN / 32), I_GU = (D / 64) * (NGU / 32), I_DN = (DFF / 64) * (D / 32);
    constexpr int NITEMS = I_QKV + I_O + I_IN + I_O + 2 * I_GU + 2 * I_DN;
    for (int it = gw; it < NITEMS; it += NGW) {
        int r = it;
        if (r < I_QKV) { p0_transpose_item<1>(P.w_qkv, D, 3 * D, 3 * D, P.attn_norm, (bf16*)(ws + WS_WQKV), scr, r, ((int)(threadIdx.x & 63u))); continue; } r -= I_QKV;
        if (r < I_O) { p0_transpose_item<0>(P.w_o, D, D, D, nullptr, (bf16*)(ws + WS_WO), scr, r, ((int)(threadIdx.x & 63u))); continue; } r -= I_O;
        if (r < I_IN) { p0_transpose_item<0>(P.w_in, D, NINW, NIN, P.mlstm_norm, (bf16*)(ws + WS_WIN), scr, r, ((int)(threadIdx.x & 63u))); continue; } r -= I_IN;
        if (r < I_O) { p0_transpose_item<0>(P.w_out, D, D, D, nullptr, (bf16*)(ws + WS_WOUT), scr, r, ((int)(threadIdx.x & 63u))); continue; } r -= I_O;
        if (r < 2 * I_GU) { const int l = r / I_GU; p0_transpose_item<2>(P.w_gu + (size_t)l * D * NGU, D, NGU, NGU, P.ffn_norm + l * D, (bf16*)(ws + WS_WGU) + (size_t)l * NGU * D, scr, r % I_GU, ((int)(threadIdx.x & 63u))); continue; } r -= 2 * I_GU;
        { const int l = r / I_DN; p0_transpose_item<0>(P.w_down + (size_t)l * DFF * D, DFF, D, D, nullptr, (bf16*)(ws + WS_WD) + (size_t)l * D * DFF, scr, r % I_DN, ((int)(threadIdx.x & 63u))); }
    }
    const int gt = F.vcu * (NWAVES * 64) + ((int)threadIdx.x), NGT = F.G * NWAVES * 64;
    { float* WG = (float*)(ws + WS_WG); for (int i = gt; i < 16 * D; i += NGT) { const int j = i >> 10, k = i & 1023; WG[i] = P.mlstm_norm[k] * P.w_in[(size_t)k * NINW + NIN + j]; } }
    { float* rope = (float*)(ws + WS_ROPE);
      for (int i = gt; i < SEQ * 8; i += NGT) { const int pos = i >> 3, j = i & 7;
          const float invf = j == 0 ? 1.0f : j == 1 ? 0.1939227432012558f : j == 2 ? 0.03760603070259094f : j == 3 ? 0.007292664609849453f : j == 4 ? 0.0014142135623842478f : j == 5 ? 0.00027424818836152554f : j == 6 ? 5.3182957344688475e-05f : 1.0313385246263351e-05f;
          const float ang = __fmul_rn((float)pos, invf);
          const double rev = (double)ang * 0.15915494309189533577; const float fr = (float)(rev - __builtin_rint(rev));
          rope[2 * i] = __builtin_amdgcn_cosf(fr); rope[2 * i + 1] = __builtin_amdgcn_sinf(fr); } }
    { bf16* xb = (bf16*)(ws + WS_AB); float* ssq0 = (float*)(ws + WS_SSQ);
      for (int m = gw; m < M; m += NGW) {
          const GAS f32x4* xr = (const GAS f32x4*)(P.x + (size_t)m * D) + ((int)(threadIdx.x & 63u)); f32x4 v[4]; float s = 0.f;
#pragma unroll
          for (int j = 0; j < 4; ++j) { v[j] = xr[64 * j]; s += (v[j].x * v[j].x + v[j].y * v[j].y) + (v[j].z * v[j].z + v[j].w * v[j].w); }
          s = wave_sum(s);
          GAS unsigned long long* o8 = (GAS unsigned long long*)(xb + (size_t)m * D) + ((int)(threadIdx.x & 63u));
#pragma unroll
          for (int j = 0; j < 4; ++j) o8[64 * j] = (unsigned long long)pk2(v[j].x, v[j].y) | ((unsigned long long)pk2(v[j].z, v[j].w) << 32);
          if (((int)(threadIdx.x & 63u)) < 16) ssq0[(size_t)m * 16 + ((int)(threadIdx.x & 63u))] = (((int)(threadIdx.x & 63u)) == 0) ? s : 0.f;
      } }
}

namespace moba {
typedef short bf16x8 __attribute__((ext_vector_type(8)));
typedef short s16x4 __attribute__((ext_vector_type(4)));
typedef float f32x16 __attribute__((ext_vector_type(16)));
typedef unsigned u32x4 __attribute__((ext_vector_type(4)));
typedef LAS const char* lds_cptr;
typedef short v4i16_t __attribute__((ext_vector_type(4)));
typedef float f32x2_t __attribute__((ext_vector_type(2))); typedef __bf16 bf16x2_t __attribute__((ext_vector_type(2)));
constexpr int THRL = 8;
constexpr int L_K = 0, L_V = 32768, L_WS = 65536  , L_STG = 73728  , L_QL = 106496  , L_MISC = 122880;
constexpr size_t WS_SEGCNT = 58 * MiB;
constexpr size_t WS_P2 = 192 * MiB;
constexpr size_t WS_PLSE = 224 * MiB;
constexpr size_t WS_SEGLIST = 232 * MiB;
constexpr int CW_Q3 = 8192;
constexpr size_t PART_STRIDE = (size_t)M * D * 2;

__device__ __forceinline__ int crow(int r, int hi) { return (r & 3) + 8 * (r >> 2) + 4 * hi; }
__device__ __forceinline__ void glds16(const void* gsrc, unsigned lds_dst) { unsigned keep;
    asm volatile("s_mov_b32 %0, m0\n\ts_mov_b32 m0, %2\n\ts_nop 0\n\tglobal_load_lds_dwordx4 %1, off\n\ts_mov_b32 m0, %0" : "=&s"(keep) : "v"(gsrc), "s"(lds_dst) : "memory"); }
__device__ __forceinline__ unsigned cvtpk_s(float lo, float hi) { f32x2_t v = {lo, hi}; bf16x2_t b = __builtin_convertvector(v, bf16x2_t); return __builtin_bit_cast(unsigned, b); }
__device__ __forceinline__ s16x4 vtr(lds_cptr p) { return __builtin_bit_cast(s16x4, __builtin_amdgcn_ds_read_tr16_b64_v4i16((LAS v4i16_t*)p)); }
#define MOBA_MX3(a, b, c) __builtin_fmaxf(__builtin_fmaxf((a), (b)), (c))
__device__ __forceinline__ float rowmax(const f32x16& p0, const f32x16& p1) {
    float a = MOBA_MX3(p0[0], p0[1], p1[0]), b = MOBA_MX3(p0[2], p0[3], p1[1]); a = MOBA_MX3(a, p1[2], p1[3]);
#pragma unroll
    for (int r = 4; r < 16; r += 4) { a = MOBA_MX3(a, p0[r], p0[r + 1]); b = MOBA_MX3(b, p0[r + 2], p0[r + 3]); a = MOBA_MX3(a, p1[r], p1[r + 1]); b = MOBA_MX3(b, p1[r + 2], p1[r + 3]); }
    float m = __builtin_fmaxf(a, b); auto rr = __builtin_amdgcn_permlane32_swap(__float_as_uint(m), __float_as_uint(m), false, false);
    return __builtin_fmaxf(__uint_as_float(rr[0]), __uint_as_float(rr[1])); }
__device__ __forceinline__ float halves_sum(float v) { auto rr = __builtin_amdgcn_permlane32_swap(__float_as_uint(v), __float_as_uint(v), false, false); return __uint_as_float(rr[0]) + __uint_as_float(rr[1]); }
#define MOBA_MFMA(a, b, c) __builtin_amdgcn_mfma_f32_32x32x16_bf16(a, b, c, 0, 0, 0)

__device__ __forceinline__ void stage_kv(const bf16* K, const bf16* V, int b, int h, int j, LAS unsigned char* lds, int wid, int lane) {
    const size_t row0 = (size_t)b * SEQ + (size_t)j * MB;
    const bf16* ksrc = K + (row0 + lane) * D + h * HD + wid * 8;
    const bf16* vsrc = V + (row0 + 16 * (wid & 3) + (lane >> 2)) * D + h * HD + (wid >> 2) * 32 + (lane & 3) * 8;
    const unsigned kdst = (unsigned)(uintptr_t)(lds + L_K) + wid * 1024, vdst = (unsigned)(uintptr_t)(lds + L_V) + wid * 1024;
#pragma unroll
    for (int t = 0; t < 4; ++t) { glds16(ksrc + (size_t)t * 64 * D, (unsigned)__builtin_amdgcn_readfirstlane(kdst + t * 8192)); glds16(vsrc + (size_t)t * 64 * D, (unsigned)__builtin_amdgcn_readfirstlane(vdst + t * 8192)); }
    asm volatile("s_waitcnt vmcnt(0) lgkmcnt(0)\n\ts_barrier" ::: "memory");
}

template <bool CAUSAL> __device__ __forceinline__ void wave_block(const bf16x8 (&qr)[4], lds_cptr kbase, lds_cptr vbase, int ntiles, int qrel, LAS float* wsf, int lane, f32x16& o0, f32x16& o1, float& mhat, float& lsum) {
    const int r32 = lane & 31, hi = lane >> 5;
    const lds_cptr kp0 = kbase + hi * 1024 + r32 * 16;
    const lds_cptr vp0 = vbase + ((lane >> 4) & 1) * 32 + (lane & 3) * 8 + (4 * hi + ((lane & 15) >> 2)) * 64;
    o0 = f32x16{}; o1 = f32x16{}; mhat = 0.f; lsum = 0.f;
    int kt0 = 0; asm volatile("" : "+s"(kt0));
#pragma nounroll
    for (int kt = kt0; kt < ntiles; ++kt) {
        const lds_cptr kp = kp0 + kt * 8192, vp = vp0 + kt * 8192;
        bf16x8 kf[8];
#pragma unroll
        for (int d0 = 0; d0 < 4; ++d0) { kf[2 * d0] = *(const LAS bf16x8*)(kp + d0 * 2048); kf[2 * d0 + 1] = *(const LAS bf16x8*)(kp + d0 * 2048 + 512); }
        f32x16 negm;
#pragma unroll
        for (int r = 0; r < 16; ++r) negm[r] = 0.f - mhat;
        f32x16 c0 = MOBA_MFMA(kf[0], qr[0], negm), c1 = MOBA_MFMA(kf[1], qr[0], negm);
        c0 = MOBA_MFMA(kf[2], qr[1], c0); c1 = MOBA_MFMA(kf[3], qr[1], c1);
        c0 = MOBA_MFMA(kf[4], qr[2], c0); c1 = MOBA_MFMA(kf[5], qr[2], c1);
        c0 = MOBA_MFMA(kf[6], qr[3], c0); c1 = MOBA_MFMA(kf[7], qr[3], c1);
        if (CAUSAL && kt == ntiles - 1) { int rel = qrel - 64 * kt - 4 * hi; asm volatile("" : "+v"(rel));
#pragma unroll
            for (int r = 0; r < 16; ++r) { const int kv = (r & 3) + 8 * (r >> 2); if (kv > rel) c0[r] = -INFINITY; if (kv + 32 > rel) c1[r] = -INFINITY; } }
        const float rm = rowmax(c0, c1);
        bool resc = false; float dl = 0.f;
        if (kt == 0) { dl = rm; mhat = rm; }
        else if (__any(rm > (float)THRL)) { dl = __builtin_fmaxf(rm, 0.f); mhat += dl; const float f = __builtin_amdgcn_exp2f(-dl); lsum *= f; if (hi == 0) wsf[r32] = f; resc = true; }
        float sacc = 0.f;
#pragma unroll
        for (int r = 0; r < 16; ++r) { c0[r] = __builtin_amdgcn_exp2f(c0[r] - dl); c1[r] = __builtin_amdgcn_exp2f(c1[r] - dl); sacc += c0[r] + c1[r]; }
        lsum += sacc;
        if (resc) { asm volatile("s_waitcnt lgkmcnt(0)" ::: "memory");
#pragma unroll
            for (int r = 0; r < 16; ++r) { const float f = wsf[crow(r, hi)]; o0[r] *= f; o1[r] *= f; } }
        u32x4 pw0, pw1, pw2, pw3;
        pw0 = (u32x4){cvtpk_s(c0[0], c0[1]), cvtpk_s(c0[2], c0[3]), cvtpk_s(c0[4], c0[5]), cvtpk_s(c0[6], c0[7])}; pw1 = (u32x4){cvtpk_s(c0[8], c0[9]), cvtpk_s(c0[10], c0[11]), cvtpk_s(c0[12], c0[13]), cvtpk_s(c0[14], c0[15])};
        pw2 = (u32x4){cvtpk_s(c1[0], c1[1]), cvtpk_s(c1[2], c1[3]), cvtpk_s(c1[4], c1[5]), cvtpk_s(c1[6], c1[7])}; pw3 = (u32x4){cvtpk_s(c1[8], c1[9]), cvtpk_s(c1[10], c1[11]), cvtpk_s(c1[12], c1[13]), cvtpk_s(c1[14], c1[15])};
        s16x4 vlo[8], vhi[8];
#pragma unroll
        for (int i = 0; i < 8; ++i) { vlo[i] = vtr(vp + ((i >> 2) * 4096 + (i & 3) * 1024)); vhi[i] = vtr(vp + ((i >> 2) * 4096 + (i & 3) * 1024 + 512)); }
#define MOBA_PAF(k) __builtin_bit_cast(bf16x8, pw##k)
#define MOBA_VFR(i) (bf16x8){vlo[i][0], vlo[i][1], vlo[i][2], vlo[i][3], vhi[i][0], vhi[i][1], vhi[i][2], vhi[i][3]}
        o0 = MOBA_MFMA(MOBA_PAF(0), MOBA_VFR(0), o0); o1 = MOBA_MFMA(MOBA_PAF(0), MOBA_VFR(4), o1); o0 = MOBA_MFMA(MOBA_PAF(1), MOBA_VFR(1), o0); o1 = MOBA_MFMA(MOBA_PAF(1), MOBA_VFR(5), o1);
        o0 = MOBA_MFMA(MOBA_PAF(2), MOBA_VFR(2), o0); o1 = MOBA_MFMA(MOBA_PAF(2), MOBA_VFR(6), o1); o0 = MOBA_MFMA(MOBA_PAF(3), MOBA_VFR(3), o0); o1 = MOBA_MFMA(MOBA_PAF(3), MOBA_VFR(7), o1);
#undef MOBA_PAF
#undef MOBA_VFR
    }
    lsum = halves_sum(lsum);
}
__device__ __forceinline__ void stage_o(const f32x16& o0, const f32x16& o1, float lsum, LAS float* wsf, LAS unsigned short* stg, int lane) {
    const int r32 = lane & 31, hi = lane >> 5;
    if (hi == 0) wsf[32 + r32] = __builtin_amdgcn_rcpf(lsum);
    asm volatile("s_waitcnt lgkmcnt(0)" ::: "memory");
#pragma unroll
    for (int r = 0; r < 16; ++r) { const int orow = crow(r, hi); const float rl = wsf[32 + orow];
        stg[orow * 64 + r32] = (unsigned short)f2bf(o0[r] * rl); stg[orow * 64 + 32 + r32] = (unsigned short)f2bf(o1[r] * rl); }
    asm volatile("s_waitcnt lgkmcnt(0)" ::: "memory");
}

__device__ __forceinline__ bool better(float g, int n, float gk, int ik) { return g > gk || (g == gk && n < ik); }
__device__ __forceinline__ void ins3(float g, int n, float& g1, int& i1, float& g2, int& i2, float& g3, int& i3) {
    const bool b1 = better(g, n, g1, i1), b2 = better(g, n, g2, i2), b3 = better(g, n, g3, i3);
    const float n3 = b2 ? g2 : (b3 ? g : g3); const int m3 = b2 ? i2 : (b3 ? n : i3);
    const float n2 = b1 ? g1 : (b2 ? g : g2); const int m2 = b1 ? i1 : (b2 ? n : i2);
    g1 = b1 ? g : g1; i1 = b1 ? n : i1; g2 = n2; i2 = m2; g3 = n3; i3 = m3;
}
}

__device__ __forceinline__ void p2_gating(Frame& F, const Ptrs& P) {
    using namespace moba;
    const bf16* Q = (const bf16*)(P.ws + WS_Q); const float* kmean = (const float*)(P.ws + WS_KMEAN);
    unsigned* segcnt = (unsigned*)(P.ws + WS_SEGCNT); unsigned short* seglist = (unsigned short*)(P.ws + WS_SEGLIST);
    LAS float* kmf = (LAS float*)(F.lds + RING_OFF); LAS float* cg = kmf + 32 * 64; LAS int* ci = (LAS int*)(cg + 256 * 3); LAS unsigned* cntL = (LAS unsigned*)(ci + 256 * 3);
    const int tid = ((int)threadIdx.x);
    for (int unit = F.vcu; unit < BATCH * NH * NBLK; unit += F.G) {
        const int bh = unit >> 5, cur = unit & 31, b = bh >> 4, h = bh & 15;
        if (cur == 0) continue;
        for (int i = tid; i < cur * 64; i += NWAVES * 64) kmf[i] = kmean[(size_t)(b * NBLK + (i >> 6)) * D + h * HD + (i & 63)];
        if (tid < 32) cntL[tid] = 0u;
        LDS_WAIT(); __syncthreads();
        const int tq = tid & 255, half = tid >> 8, tl = cur * MB + tq;
        float q[64];
        { const v4u* qp = (const v4u*)(Q + (size_t)(b * SEQ + tl) * D + h * HD);
#pragma unroll
          for (int i = 0; i < 8; ++i) { const v4u w = qp[i]; q[8 * i] = bflo(w.x); q[8 * i + 1] = bfhi(w.x); q[8 * i + 2] = bflo(w.y); q[8 * i + 3] = bfhi(w.y); q[8 * i + 4] = bflo(w.z); q[8 * i + 5] = bfhi(w.z); q[8 * i + 6] = bflo(w.w); q[8 * i + 7] = bfhi(w.w); } }
        float g1 = -INFINITY, g2 = -INFINITY, g3 = -INFINITY; int i1 = 255, i2 = 255, i3 = 255;
        for (int n = half; n < cur; n += 2) {
            const LAS float* kp = kmf + n * 64; float g = 0.f;
#pragma unroll
            for (int i = 0; i < 64; i += 4) g += (q[i] * kp[i] + q[i + 1] * kp[i + 1]) + (q[i + 2] * kp[i + 2] + q[i + 3] * kp[i + 3]);
            ins3(g, n, g1, i1, g2, i2, g3, i3);
        }
        if (half == 1) { cg[tq * 3] = g1; cg[tq * 3 + 1] = g2; cg[tq * 3 + 2] = g3; ci[tq * 3] = i1; ci[tq * 3 + 1] = i2; ci[tq * 3 + 2] = i3; }
        LDS_WAIT(); __syncthreads();
        if (half == 0) {
#pragma unroll
            for (int r = 0; r < 3; ++r) { const float g = cg[tq * 3 + r]; const int n = ci[tq * 3 + r]; if (n != 255) ins3(g, n, g1, i1, g2, i2, g3, i3); }
#define P2_EMIT(j, r) do { if ((j) != 255) { const unsigned pos = __hip_atomic_fetch_add(cntL + (j), 1u, __ATOMIC_RELAXED, __HIP_MEMORY_SCOPE_WORKGROUP); \
                    seglist[((size_t)(bh * 32 + (j)) * 32 + cur) * 256 + pos] = (unsigned short)(tl | ((r) << 13)); } } while (0)
            P2_EMIT(i1, 0); P2_EMIT(i2, 1); P2_EMIT(i3, 2);
#undef P2_EMIT
        }
        LDS_WAIT(); __syncthreads();
        if (tid < cur) segcnt[(bh * 32 + tid) * 32 + cur] = cntL[tid];
        LDS_WAIT(); __syncthreads();
    }
}

__device__ __forceinline__ void p3_gathered(Frame& F, const Ptrs& P) {
    using namespace moba;
    unsigned char* ws = P.ws;
    const bf16* Q = (const bf16*)(ws + WS_Q); const bf16* K = (const bf16*)(ws + WS_K); const bf16* V = (const bf16*)(ws + WS_V);
    const unsigned* segcnt = (const unsigned*)(ws + WS_SEGCNT); const unsigned short* seglist = (const unsigned short*)(ws + WS_SEGLIST);
    float* plse = (float*)(ws + WS_PLSE);
    LAS unsigned short* ql = (LAS unsigned short*)(F.lds + L_QL); LAS unsigned* misc = (LAS unsigned*)(F.lds + L_MISC);
    LAS float* wsf = (LAS float*)(F.lds + L_WS) + F.wave * 256; LAS unsigned short* stg = (LAS unsigned short*)(F.lds + L_STG) + F.wave * 2048;
    const int tid = ((int)threadIdx.x), lane = ((int)(threadIdx.x & 63u)), wid = F.wave, r32 = lane & 31, hi = lane >> 5;
    for (;;) {
        if (tid == 0) misc[0] = __hip_atomic_fetch_add(F.ctl + CW_Q3, 1u, RLX_AGENT);
        LDS_WAIT(); __syncthreads();
        const int item = (int)misc[0];
        if (item >= 31 * 32) break;
        const int j = item >> 5, bh = item & 31, b = bh >> 4, h = bh & 15;
        if (tid < 32) {
            const unsigned c = (tid > j) ? segcnt[(bh * 32 + j) * 32 + tid] : 0u; unsigned s = c;
#pragma unroll
            for (int o = 1; o < 32; o <<= 1) { const unsigned t = __shfl_up(s, o, 32); if (tid >= o) s += t; }
            misc[32 + tid] = s - c; misc[64 + tid] = c; if (tid == 31) misc[1] = s;
        }
        LDS_WAIT(); __syncthreads();
        const int n = (int)misc[1];
        for (int cur = j + 1; cur < 32; ++cur) { const int c = (int)misc[64 + cur], off = (int)misc[32 + cur]; const unsigned short* sp = seglist + ((size_t)(bh * 32 + j) * 32 + cur) * 256;
            for (int i = tid; i < c; i += NWAVES * 64) ql[off + i] = sp[i]; }
        stage_kv(K, V, b, h, j, F.lds, wid, lane);
        const int ngroups = (n + 31) >> 5;
        for (int g = wid; g < ngroups; g += NWAVES) {
            const int idx = g * 32 + r32; const unsigned e = ql[idx < n ? idx : n - 1]; const int tl = (int)(e & 8191u);
            const bf16* qp = Q + (size_t)(b * SEQ + tl) * D + h * HD + hi * 8;
            bf16x8 qr[4];
#pragma unroll
            for (int d0 = 0; d0 < 4; ++d0) qr[d0] = *(const bf16x8*)(qp + d0 * 16);
            f32x16 o0, o1; float mhat, lsum;
            wave_block<false>(qr, (lds_cptr)(F.lds + L_K), (lds_cptr)(F.lds + L_V), 4, 0, wsf, lane, o0, o1, mhat, lsum);
            stage_o(o0, o1, lsum, wsf, stg, lane);
            if (hi == 0 && idx < n) plse[((size_t)(e >> 13) * M + (size_t)(b * SEQ + tl)) * 16 + h] = mhat + __builtin_amdgcn_logf(lsum);
#pragma unroll
            for (int i = 0; i < 4; ++i) { const int row = i * 8 + (lane >> 3), ch = lane & 7, ix = g * 32 + row;
                if (ix < n) { const unsigned e2 = ql[ix]; const unsigned rk = e2 >> 13; const size_t t2 = (size_t)(b * SEQ) + (e2 & 8191u);
                    unsigned char* pb = (rk == 2u) ? (ws + WS_P2) : ((unsigned char*)P.out + (size_t)rk * PART_STRIDE);
                    *(u32x4*)(pb + (t2 * D + h * HD + ch * 8) * 2) = *(const LAS u32x4*)(stg + row * 64 + ch * 8); } }
            LDS_WAIT();
        }
        LDS_WAIT(); __syncthreads();
    }
}

__device__ __forceinline__ void p4_own_combine(Frame& F, const Ptrs& P) {
    using namespace moba;
    unsigned char* ws = P.ws; asm volatile("" : "+v"(ws));
    unsigned char* outp = (unsigned char*)P.out; asm volatile("" : "+v"(outp));
    const bf16* Q = (const bf16*)(ws + WS_Q); const bf16* K = (const bf16*)(ws + WS_K); const bf16* V = (const bf16*)(ws + WS_V); bf16* O = (bf16*)(ws + WS_AB);
    const float* plse = (const float*)(ws + WS_PLSE);
    const int lane = ((int)(threadIdx.x & 63u)), wid = F.wave, r32 = lane & 31, hi = lane >> 5, widv = ((int)threadIdx.x) >> 6;
    LAS float* wsf = (LAS float*)(F.lds + L_WS) + widv * 256; LAS unsigned short* stg = (LAS unsigned short*)(F.lds + L_STG) + widv * 2048;
    for (int unit = F.vcu; unit < BATCH * NH * NBLK; unit += F.G) {
        const int bh = unit >> 5, cur = unit & 31, b = bh >> 4, h = bh & 15;
        stage_kv(K, V, b, h, cur, F.lds, wid, lane);
        const size_t t0 = (size_t)b * SEQ + (size_t)cur * MB + widv * 32;
        const bf16* qp = Q + (t0 + r32) * D + h * HD + hi * 8;
        bf16x8 qr[4];
#pragma unroll
        for (int d0 = 0; d0 < 4; ++d0) qr[d0] = *(const bf16x8*)(qp + d0 * 16);
        f32x16 o0, o1; float mhat, lsum;
        wave_block<true>(qr, (lds_cptr)(F.lds + L_K), (lds_cptr)(F.lds + L_V), (wid >> 1) + 1, widv * 32 + r32, wsf, lane, o0, o1, mhat, lsum);
        stage_o(o0, o1, lsum, wsf, stg, lane);
        const int nv = cur < 3 ? cur : 3;
        { const float l0 = mhat + __builtin_amdgcn_logf(lsum); float lr[3]; float mx = l0;
#pragma unroll
          for (int r = 0; r < 3; ++r) { lr[r] = (r < nv) ? plse[((size_t)r * M + t0 + r32) * 16 + h] : -INFINITY; mx = __builtin_fmaxf(mx, lr[r]); }
          const float w0 = __builtin_amdgcn_exp2f(l0 - mx); float wr[3]; float ws_ = w0;
#pragma unroll
          for (int r = 0; r < 3; ++r) { wr[r] = __builtin_amdgcn_exp2f(lr[r] - mx); ws_ += wr[r]; }
          const float inv = 1.0f / ws_;
          if (hi == 0) { wsf[64 + r32 * 4] = w0 * inv; wsf[64 + r32 * 4 + 1] = wr[0] * inv; wsf[64 + r32 * 4 + 2] = wr[1] * inv; wsf[64 + r32 * 4 + 3] = wr[2] * inv; } }
        LDS_WAIT();
#pragma unroll
        for (int i = 0; i < 4; ++i) { const int row = i * 8 + (lane >> 3), ch = lane & 7; const size_t off = (t0 + row) * D + h * HD + ch * 8;
            const u32x4 ow = *(const LAS u32x4*)(stg + row * 64 + ch * 8); const float w0 = wsf[64 + row * 4];
            float a[8] = {w0 * bflo(ow.x), w0 * bfhi(ow.x), w0 * bflo(ow.y), w0 * bfhi(ow.y), w0 * bflo(ow.z), w0 * bfhi(ow.z), w0 * bflo(ow.w), w0 * bfhi(ow.w)};
#pragma unroll
            for (int r = 0; r < 3; ++r) if (r < nv) { const unsigned char* pb = (r == 2) ? (ws + WS_P2) : (outp + (size_t)r * PART_STRIDE);
                const u32x4 pw = *(const u32x4*)(pb + off * 2); const float w = wsf[64 + row * 4 + 1 + r];
                a[0] += w * bflo(pw.x); a[1] += w * bfhi(pw.x); a[2] += w * bflo(pw.y); a[3] += w * bfhi(pw.y); a[4] += w * bflo(pw.z); a[5] += w * bfhi(pw.z); a[6] += w * bflo(pw.w); a[7] += w * bfhi(pw.w); }
            v4u w; w.x = pk2(a[0], a[1]); w.y = pk2(a[2], a[3]); w.z = pk2(a[4], a[5]); w.w = pk2(a[6], a[7]); *(v4u*)(O + off) = w; }
        LDS_WAIT(); __syncthreads();
    }
}

__device__ __forceinline__ float softcap_f(float g) { const float x = g * (1.0f / SOFTCAP); const float e = fexp(2.0f * x); return SOFTCAP * (e - 1.0f) / (e + 1.0f); }
__device__ __forceinline__ float logsigmoid_f(float f) { return fminf(f, 0.f) - __builtin_amdgcn_logf(1.0f + fexp(-fabsf(f))) * 0.6931471805599453f; }

__device__ __forceinline__ void pa_mlstm_local(Frame& F, const Ptrs& P) {
    unsigned char* ws = P.ws;
    const bf16* HB = (const bf16*)(ws + WS_AB); const bf16* MK = (const bf16*)(ws + WS_MK); const bf16* MV = (const bf16*)(ws + WS_MV);
    const float* WG = (const float*)(ws + WS_WG); const float* ssq = (const float*)(ws + WS_SSQ) + (size_t)2 * M * 16;
    float* cloc = (float*)(ws + WS_CLOC); float* nloc = (float*)(ws + WS_NLOC); float* scal = (float*)(ws + WS_SCAL); float* BIG = (float*)(ws + WS_BIG);
    LAS float* kf = (LAS float*)(F.lds + RING_OFF); LAS float* vf = kf + 64 * 64; LAS float* lf = vf + 64 * 128; LAS float* ig = lf + 64; LAS float* bb = ig + 64; LAS float* wv = bb + 64;
    const int tid = ((int)threadIdx.x);
    for (int unit = F.vcu; unit < NUNIT; unit += F.G) {
        const int bh = unit >> 7, c = unit & 127, b = bh >> 3, h = bh & 7, t0 = b * SEQ + c * LCH;
        { const int row = tid >> 3, c8 = (tid & 7) * 8; const v4u w = *(const v4u*)(MK + (size_t)(t0 + row) * 512 + h * DK + c8); LAS float* d = kf + row * 64 + c8;
          d[0] = bflo(w.x); d[1] = bfhi(w.x); d[2] = bflo(w.y); d[3] = bfhi(w.y); d[4] = bflo(w.z); d[5] = bfhi(w.z); d[6] = bflo(w.w); d[7] = bfhi(w.w);
          const int c16 = (tid & 7) * 16; const v4u* vp = (const v4u*)(MV + (size_t)(t0 + row) * 1024 + h * DV + c16); LAS float* e = vf + row * 128 + c16;
#pragma unroll
          for (int i = 0; i < 2; ++i) { const v4u u = vp[i]; e[8 * i] = bflo(u.x); e[8 * i + 1] = bfhi(u.x); e[8 * i + 2] = bflo(u.y); e[8 * i + 3] = bfhi(u.y); e[8 * i + 4] = bflo(u.z); e[8 * i + 5] = bfhi(u.z); e[8 * i + 6] = bflo(u.w); e[8 * i + 7] = bfhi(u.w); } }
        { const int dp = tid >> 2, part = tid & 3, row = dp >> 1, g = dp & 1, col = g * 8 + h;
          const v4u* hp = (const v4u*)(HB + (size_t)(t0 + row) * D + part * 256); const f32x4* wp = (const f32x4*)(WG + (size_t)col * D + part * 256);
          float a = 0.f;
          for (int i = 0; i < 32; ++i) { const v4u w = hp[i]; const f32x4 w0 = wp[2 * i], w1 = wp[2 * i + 1];
              a += (bflo(w.x) * w0.x + bfhi(w.x) * w0.y) + (bflo(w.y) * w0.z + bfhi(w.y) * w0.w) + (bflo(w.z) * w1.x + bfhi(w.z) * w1.y) + (bflo(w.w) * w1.z + bfhi(w.w) * w1.w); }
          a += __shfl_xor(a, 1); a += __shfl_xor(a, 2);
          if (part == 0) { const float val = softcap_f(a * pg8::row_rstd(ssq, t0 + row) + P.b_gates[col]); if (g == 0) ig[row] = val; else lf[row] = logsigmoid_f(val); } }
        LDS_WAIT(); __syncthreads();
        if (tid < 64) { float s = 0.f; for (int j = 0; j <= tid; ++j) s += lf[j]; bb[tid] = s; }
        LDS_WAIT(); __syncthreads();
        if (tid < 64) { const float bL = bb[63], a = bL - bb[tid] + ig[tid], ml = wave_max(a); wv[tid] = fexp(a - ml);
            BIG[(size_t)unit * 128 + tid] = bb[tid]; BIG[(size_t)unit * 128 + 64 + tid] = ig[tid];
            if (tid == 0) { scal[unit] = ml; scal[NUNIT + unit] = bL; } }
        LDS_WAIT(); __syncthreads();
        { const int v = tid >> 2, kb = (tid & 3) * 16; float acc[16];
#pragma unroll
          for (int j = 0; j < 16; ++j) acc[j] = 0.f;
          for (int s = 0; s < 64; ++s) { const float wvv = wv[s] * vf[s * 128 + v];
#pragma unroll
              for (int j = 0; j < 16; ++j) acc[j] += wvv * kf[s * 64 + kb + j]; }
          f32x4* cp = (f32x4*)(cloc + (size_t)unit * 8192 + v * 64 + kb);
#pragma unroll
          for (int j = 0; j < 4; ++j) cp[j] = (f32x4){acc[4 * j], acc[4 * j + 1], acc[4 * j + 2], acc[4 * j + 3]};
          if (tid < 64) { float n = 0.f; for (int s = 0; s < 64; ++s) n += wv[s] * kf[s * 64 + tid]; nloc[(size_t)unit * 64 + tid] = n; } }
        LDS_WAIT(); __syncthreads();
    }
}
__device__ __forceinline__ void pb_mlstm_scan(Frame& F, const Ptrs& P) {
    unsigned char* ws = P.ws;
    float* cloc = (float*)(ws + WS_CLOC); float* nloc = (float*)(ws + WS_NLOC); float* scal = (float*)(ws + WS_SCAL);
    const int gt = F.vcu * (NWAVES * 64) + ((int)threadIdx.x), NGT = F.G * NWAVES * 64;
    for (int idx = gt; idx < BATCH * MH * 8256; idx += NGT) {
        const int bh = idx / 8256, e = idx - bh * 8256;
        float st = 0.f, mp = 0.f;
        for (int c = 0; c < NCH; ++c) {
            const int unit = bh * NCH + c; const float ml = scal[unit], bl = scal[NUNIT + unit];
            const float mn = fmaxf(bl + mp, ml), decay = fexp(bl + mp - mn), sc = fexp(ml - mn);
            float* p = (e < 8192) ? cloc + (size_t)unit * 8192 + e : nloc + (size_t)unit * 64 + (e - 8192);
            const float x = *p; *p = st;
            if (e == 0) scal[2 * NUNIT + unit] = mp;
            st = decay * st + sc * x; mp = mn;
        }
    }
}
__device__ __forceinline__ void pc_mlstm_out(Frame& F, const Ptrs& P) {
    unsigned char* ws = P.ws;
    const bf16* MQ = (const bf16*)(ws + WS_MQ); const bf16* MK = (const bf16*)(ws + WS_MK); const bf16* MV = (const bf16*)(ws + WS_MV); const bf16* OG = (const bf16*)(ws + WS_OG);
    const float* cin = (const float*)(ws + WS_CLOC); const float* nin = (const float*)(ws + WS_NLOC); const float* scal = (const float*)(ws + WS_SCAL); const float* BIG = (const float*)(ws + WS_BIG);
    bf16* Y = (bf16*)(ws + WS_AB);
    LAS float* qf = (LAS float*)(F.lds + RING_OFF); LAS float* kf = qf + 64 * 64; LAS float* vf = kf + 64 * 64; LAS float* cf = vf + 64 * 128; LAS float* sq = cf + 128 * 65; LAS float* bb = sq + 64 * 65;
    LAS float* ig = bb + 64; LAS float* mt = ig + 64; LAS float* itr = mt + 64; LAS float* qn = itr + 64; LAS float* dd = qn + 64; LAS float* nn = dd + 64;
    const int tid = ((int)threadIdx.x);
    for (int unit = F.vcu; unit < NUNIT; unit += F.G) {
        const int bh = unit >> 7, c = unit & 127, b = bh >> 3, h = bh & 7, t0 = b * SEQ + c * LCH;
        const float m_in = scal[2 * NUNIT + unit];
        { const int row = tid >> 3, c8 = (tid & 7) * 8;
          { const v4u w = *(const v4u*)(MQ + (size_t)(t0 + row) * 512 + h * DK + c8); LAS float* d = qf + row * 64 + c8;
            d[0] = bflo(w.x); d[1] = bfhi(w.x); d[2] = bflo(w.y); d[3] = bfhi(w.y); d[4] = bflo(w.z); d[5] = bfhi(w.z); d[6] = bflo(w.w); d[7] = bfhi(w.w); }
          { const v4u w = *(const v4u*)(MK + (size_t)(t0 + row) * 512 + h * DK + c8); LAS float* d = kf + row * 64 + c8;
            d[0] = bflo(w.x); d[1] = bfhi(w.x); d[2] = bflo(w.y); d[3] = bfhi(w.y); d[4] = bflo(w.z); d[5] = bfhi(w.z); d[6] = bflo(w.w); d[7] = bfhi(w.w); }
          const int c16 = (tid & 7) * 16; const v4u* vp = (const v4u*)(MV + (size_t)(t0 + row) * 1024 + h * DV + c16); LAS float* e = vf + row * 128 + c16;
#pragma unroll
          for (int i = 0; i < 2; ++i) { const v4u u = vp[i]; e[8 * i] = bflo(u.x); e[8 * i + 1] = bfhi(u.x); e[8 * i + 2] = bflo(u.y); e[8 * i + 3] = bfhi(u.y); e[8 * i + 4] = bflo(u.z); e[8 * i + 5] = bfhi(u.z); e[8 * i + 6] = bflo(u.w); e[8 * i + 7] = bfhi(u.w); }
          const int v = tid >> 2, kb = (tid & 3) * 16; const f32x4* cp = (const f32x4*)(cin + (size_t)unit * 8192 + v * 64 + kb);
#pragma unroll
          for (int j = 0; j < 4; ++j) { const f32x4 x = cp[j]; cf[v * 65 + kb + 4 * j] = x.x; cf[v * 65 + kb + 4 * j + 1] = x.y; cf[v * 65 + kb + 4 * j + 2] = x.z; cf[v * 65 + kb + 4 * j + 3] = x.w; }
          if (tid < 64) { nn[tid] = nin[(size_t)unit * 64 + tid]; bb[tid] = BIG[(size_t)unit * 128 + tid]; ig[tid] = BIG[(size_t)unit * 128 + 64 + tid]; } }
        LDS_WAIT(); __syncthreads();
        if (tid < 64) { float mi = -INFINITY; for (int s = 0; s <= tid; ++s) mi = fmaxf(mi, bb[tid] - bb[s] + ig[s]);
            const float bi = bb[tid] + m_in, m = fmaxf(bi, mi); mt[tid] = m; itr[tid] = fexp(bi - m);
            float a = 0.f; for (int d = 0; d < 64; ++d) a += qf[tid * 64 + d] * nn[d]; qn[tid] = a; }
        LDS_WAIT(); __syncthreads();
#pragma unroll 1
        for (int i = 0; i < 8; ++i) { const int e = tid + 512 * i, l = e >> 6, s = e & 63; float val = 0.f;
            if (s <= l) { float a = 0.f; for (int d = 0; d < 64; ++d) a += qf[l * 64 + d] * kf[s * 64 + d]; val = a * fexp(bb[l] - bb[s] + ig[s] - mt[l]); }
            sq[l * 65 + s] = val; }
        LDS_WAIT(); __syncthreads();
        if (tid < 64) { float den = itr[tid] * qn[tid]; for (int s = 0; s < 64; ++s) den += sq[tid * 65 + s]; dd[tid] = fmaxf(fabsf(den), fexp(-mt[tid])); }
        LDS_WAIT(); __syncthreads();
        { const int l = tid >> 3, vb = (tid & 7) * 16; float hv[16], a[16]; const float it = itr[l], rd = 1.0f / dd[l]; float ss = 0.f;
#pragma unroll
          for (int j = 0; j < 16; ++j) { hv[j] = 0.f; a[j] = 0.f; }
#pragma unroll 2
          for (int d = 0; d < 64; ++d) { const float qd = qf[l * 64 + d];
#pragma unroll
              for (int j = 0; j < 16; ++j) a[j] += qd * cf[(vb + j) * 65 + d]; }
#pragma unroll 2
          for (int s = 0; s <= l; ++s) { const float sv = sq[l * 65 + s];
#pragma unroll
              for (int j = 0; j < 16; ++j) hv[j] += sv * vf[s * 128 + vb + j]; }
#pragma unroll
          for (int j = 0; j < 16; ++j) { hv[j] = (it * a[j] + hv[j]) * rd; ss += hv[j] * hv[j]; }
          ss += __shfl_xor(ss, 1); ss += __shfl_xor(ss, 2); ss += __shfl_xor(ss, 4);
          const float r = __builtin_amdgcn_rsqf(ss * (1.0f / 128.0f) + RMS_EPS);
          const size_t off = (size_t)(t0 + l) * D + h * DV + vb; const v4u* gp = (const v4u*)(OG + off); const f32x4* np = (const f32x4*)(P.head_norm + h * DV + vb);
          float y[16];
#pragma unroll
          for (int i = 0; i < 2; ++i) { const v4u u = gp[i]; const f32x4 n0 = np[2 * i], n1 = np[2 * i + 1];
              y[8 * i] = bflo(u.x) * hv[8 * i] * r * n0.x; y[8 * i + 1] = bfhi(u.x) * hv[8 * i + 1] * r * n0.y; y[8 * i + 2] = bflo(u.y) * hv[8 * i + 2] * r * n0.z; y[8 * i + 3] = bfhi(u.y) * hv[8 * i + 3] * r * n0.w;
              y[8 * i + 4] = bflo(u.z) * hv[8 * i + 4] * r * n1.x; y[8 * i + 5] = bfhi(u.z) * hv[8 * i + 5] * r * n1.y; y[8 * i + 6] = bflo(u.w) * hv[8 * i + 6] * r * n1.z; y[8 * i + 7] = bfhi(u.w) * hv[8 * i + 7] * r * n1.w; }
          v4u* yp = (v4u*)(Y + off);
#pragma unroll
          for (int i = 0; i < 2; ++i) { v4u o; o.x = pk2(y[8 * i], y[8 * i + 1]); o.y = pk2(y[8 * i + 2], y[8 * i + 3]); o.z = pk2(y[8 * i + 4], y[8 * i + 5]); o.w = pk2(y[8 * i + 6], y[8 * i + 7]); yp[i] = o; } }
        LDS_WAIT(); __syncthreads();
    }
}
__device__ __forceinline__ void p_final_norm(Frame& F, const Ptrs& P) {
    const int gw = F.vcu * NWAVES + F.wave, NGW = F.G * NWAVES;
    const f32x4* wn = (const f32x4*)P.final_norm + ((int)(threadIdx.x & 63u));
    for (int m = gw; m < M; m += NGW) {
        GAS f32x4* xr = (GAS f32x4*)(P.out + (size_t)m * D) + ((int)(threadIdx.x & 63u)); f32x4 v[4]; float s = 0.f;
#pragma unroll
        for (int j = 0; j < 4; ++j) { v[j] = xr[64 * j]; s += (v[j].x * v[j].x + v[j].y * v[j].y) + (v[j].z * v[j].z + v[j].w * v[j].w); }
        const float r = __builtin_amdgcn_rsqf(wave_sum(s) * (1.0f / D) + RMS_EPS);
#pragma unroll
        for (int j = 0; j < 4; ++j) xr[64 * j] = v[j] * r * wn[64 * j];
    }
}

struct Args { Ptrs p; };
__device__ __forceinline__ Ptrs load_ptrs() {
#if defined(__HIP_DEVICE_COMPILE__)
    typedef __attribute__((address_space(4))) const unsigned long long* kptr_t;
    kptr_t kp = (kptr_t)__builtin_amdgcn_kernarg_segment_ptr();
    asm volatile("" : "+s"(kp));
    Ptrs p;
    p.x = (const float*)kp[0]; p.attn_norm = (const float*)kp[1]; p.w_qkv = (const float*)kp[2]; p.w_o = (const float*)kp[3]; p.mlstm_norm = (const float*)kp[4]; p.w_in = (const float*)kp[5];
    p.b_gates = (const float*)kp[6]; p.head_norm = (const float*)kp[7]; p.w_out = (const float*)kp[8]; p.ffn_norm = (const float*)kp[9]; p.w_gu = (const float*)kp[10]; p.w_down = (const float*)kp[11];
    p.final_norm = (const float*)kp[12]; p.out = (float*)kp[13]; p.ws = (unsigned char*)kp[14];
    return p;
#else
    return Ptrs{};
#endif
}
__global__ void __launch_bounds__(NWAVES * 64, 2) mk_fwd(Args args) {
    extern __shared__ __attribute__((aligned(16))) unsigned char lds[];
    Frame F;
    F.lds = (LAS unsigned char*)lds;
    F.MISC = (volatile LAS unsigned*)(F.lds + MISC_OFF);
    F.wave = __builtin_amdgcn_readfirstlane((int)threadIdx.x >> 6);
    F.G = gridDim.x; { const int bx = blockIdx.x; F.vcu = (F.G % 8 == 0) ? (bx % 8) * (F.G / 8) + bx / 8 : bx; }
    F.ctl = (gu32*)(args.p.ws + WS_CTL);
    for (int u = ((int)threadIdx.x); u < (LDS_BYTES - LDSCTL_OFF) / 4; u += NWAVES * 64) ((LAS unsigned*)(F.lds + LDSCTL_OFF))[u] = 0u;
    __syncthreads();
    XcdBarrier bar = xcd_barrier_post((unsigned*)(F.ctl + CW_BAR), F.MISC + 8);
#define GRID_BAR() xcd_barrier(bar)
#ifndef PH_MASK
#define PH_MASK 0xFFFFF
#endif
#define PH(k) ((PH_MASK >> (k)) & 1)
#define PHASE_PTRS() const Ptrs P = load_ptrs(); unsigned char* const ws = P.ws; (void)ws
#define SSQ(i) ((float*)(ws + WS_SSQ) + (size_t)(i) * M * 16)

    if (PH(0)) { PHASE_PTRS(); p0_prologue(F, P); } GRID_BAR();
    if (PH(1)) { PHASE_PTRS(); pg8::Gemm g{(const bf16*)(ws + WS_AB), (const bf16*)(ws + WS_WQKV), M, 3 * D, D}; pg8::StaticOrder S; S.init(M, 3 * D, F.G, (int)blockIdx.x);
      pg8::EpiQKV E{(bf16*)(ws + WS_Q), (size_t)(WS_K - WS_Q) / 2, SSQ(0), (const float*)(ws + WS_ROPE), (float*)(ws + WS_KMEAN)};
      pg8::gemm_phase<pg8::EpiQKV, pg8::StaticOrder, PG8_ALIGN, PG8_SP2>(F.lds + RING_OFF, g, S, E); } GRID_BAR();
    if (PH(2)) { PHASE_PTRS(); p2_gating(F, P); } GRID_BAR();
    if (PH(3)) { PHASE_PTRS(); p3_gathered(F, P); } GRID_BAR();
    if (PH(15)) { PHASE_PTRS(); p4_own_combine(F, P); } GRID_BAR();
    if (PH(4)) { PHASE_PTRS(); pg8::Gemm g{(const bf16*)(ws + WS_AB), (const bf16*)(ws + WS_WO), M, D, D}; pg8::StaticOrder S; S.init(M, D, F.G, (int)blockIdx.x);
      pg8::EpiRes<true> E{P.x, P.out, (bf16*)(ws + WS_HB1), SSQ(1)};
      pg8::gemm_phase<pg8::EpiRes<true>, pg8::StaticOrder, PG8_ALIGN, PG8_SP2>(F.lds + RING_OFF, g, S, E); } GRID_BAR();
    if (PH(5)) { PHASE_PTRS(); pg8::Gemm g{(const bf16*)(ws + WS_HB1), (const bf16*)(ws + WS_WGU), M, NGU, D}; pg8::StaticOrder S; S.init(M, NGU, F.G, (int)blockIdx.x);
      pg8::EpiSwiGLU E{(bf16*)(ws + WS_ACT), SSQ(1)};
      pg8::gemm_phase<pg8::EpiSwiGLU, pg8::StaticOrder, PG8_ALIGN, PG8_SP2>(F.lds + RING_OFF, g, S, E); } GRID_BAR();
    if (PH(6)) { PHASE_PTRS(); pg8::Gemm g{(const bf16*)(ws + WS_ACT), (const bf16*)(ws + WS_WD), M, D, DFF}; pg8::StaticOrder S; S.init(M, D, F.G, (int)blockIdx.x);
      pg8::EpiRes<true> E{P.out, P.out, (bf16*)(ws + WS_AB), SSQ(2)};
      pg8::gemm_phase<pg8::EpiRes<true>, pg8::StaticOrder, PG8_ALIGN, PG8_SP2>(F.lds + RING_OFF, g, S, E); } GRID_BAR();
    if (PH(7)) { PHASE_PTRS(); pg8::Gemm g{(const bf16*)(ws + WS_AB), (const bf16*)(ws + WS_WIN), M, NIN, D}; pg8::StaticOrder S; S.init(M, NIN, F.G, (int)blockIdx.x);
      pg8::EpiMlstmIn E{(bf16*)(ws + WS_MQ), (bf16*)(ws + WS_MK), (bf16*)(ws + WS_MV), (bf16*)(ws + WS_OG), SSQ(2)};
      pg8::gemm_phase<pg8::EpiMlstmIn, pg8::StaticOrder, PG8_ALIGN, PG8_SP2>(F.lds + RING_OFF, g, S, E); } GRID_BAR();
    if (PH(8)) { PHASE_PTRS(); pa_mlstm_local(F, P); } GRID_BAR();
    if (PH(9)) { PHASE_PTRS(); pb_mlstm_scan(F, P); } GRID_BAR();
    if (PH(10)) { PHASE_PTRS(); pc_mlstm_out(F, P); } GRID_BAR();
    if (PH(11)) { PHASE_PTRS(); pg8::Gemm g{(const bf16*)(ws + WS_AB), (const bf16*)(ws + WS_WOUT), M, D, D}; pg8::StaticOrder S; S.init(M, D, F.G, (int)blockIdx.x);
      pg8::EpiRes<true> E{P.out, P.out, (bf16*)(ws + WS_HB1), SSQ(3)};
      pg8::gemm_phase<pg8::EpiRes<true>, pg8::StaticOrder, PG8_ALIGN, PG8_SP2>(F.lds + RING_OFF, g, S, E); } GRID_BAR();
    if (PH(12)) { PHASE_PTRS(); pg8::Gemm g{(const bf16*)(ws + WS_HB1), (const bf16*)(ws + WS_WGU) + (size_t)NGU * D, M, NGU, D}; pg8::StaticOrder S; S.init(M, NGU, F.G, (int)blockIdx.x);
      pg8::EpiSwiGLU E{(bf16*)(ws + WS_ACT), SSQ(3)};
      pg8::gemm_phase<pg8::EpiSwiGLU, pg8::StaticOrder, PG8_ALIGN, PG8_SP2>(F.lds + RING_OFF, g, S, E); } GRID_BAR();
    if (PH(13)) { PHASE_PTRS(); pg8::Gemm g{(const bf16*)(ws + WS_ACT), (const bf16*)(ws + WS_WD) + (size_t)D * DFF, M, D, DFF}; pg8::StaticOrder S; S.init(M, D, F.G, (int)blockIdx.x);
      pg8::EpiRes<false> E{P.out, P.out, nullptr, nullptr};
      pg8::gemm_phase<pg8::EpiRes<false>, pg8::StaticOrder, PG8_ALIGN, PG8_SP2>(F.lds + RING_OFF, g, S, E); } GRID_BAR();
    if (PH(14)) { PHASE_PTRS(); p_final_norm(F, P); }
}

extern "C" void kernel_launch(void* const* d_in, const int* in_sizes, int n_in, void* d_out, int out_size, void* d_ws, size_t ws_size, hipStream_t stream) {
    static int grid = 0;
    if (grid == 0) {
        if (n_in != 13 || in_sizes[0] != M * D || out_size != M * D || ws_size < WS_END) { fprintf(stderr, "kernel_launch: unexpected shapes (n_in %d, in0 %d, out %d, ws %zu); nothing launched\n", n_in, n_in > 0 ? in_sizes[0] : -1, out_size, ws_size); grid = -1; return; }
        int dev = 0, cus = 0, per_cu = 0;
        if (hipGetDevice(&dev) != hipSuccess || hipDeviceGetAttribute(&cus, hipDeviceAttributeMultiprocessorCount, dev) != hipSuccess) { grid = -1; return; }
        if (hipFuncSetAttribute((const void*)mk_fwd, hipFuncAttributeMaxDynamicSharedMemorySize, LDS_BYTES) != hipSuccess) { fprintf(stderr, "kernel_launch: hipFuncSetAttribute failed\n"); grid = -1; return; }
        if (hipOccupancyMaxActiveBlocksPerMultiprocessor(&per_cu, (const void*)mk_fwd, NWAVES * 64, LDS_BYTES) != hipSuccess || per_cu < 1) { fprintf(stderr, "kernel_launch: occupancy query reports %d blocks per CU\n", per_cu); }
        (void)hipGetLastError();
        grid = cus;
    }
    if (grid < 0) return;
    if (hipMemsetAsync((char*)d_ws + WS_CTL, 0, CTL_ZERO_BYTES, stream) != hipSuccess) { fprintf(stderr, "kernel_launch: hipMemsetAsync failed\n"); return; }
    Args a{};
    a.p.x = (const float*)d_in[0]; a.p.attn_norm = (const float*)d_in[1]; a.p.w_qkv = (const float*)d_in[2]; a.p.w_o = (const float*)d_in[3];
    a.p.mlstm_norm = (const float*)d_in[4]; a.p.w_in = (const float*)d_in[5]; a.p.b_gates = (const float*)d_in[6]; a.p.head_norm = (const float*)d_in[7]; a.p.w_out = (const float*)d_in[8];
    a.p.ffn_norm = (const float*)d_in[9]; a.p.w_gu = (const float*)d_in[10]; a.p.w_down = (const float*)d_in[11]; a.p.final_norm = (const float*)d_in[12];
    a.p.out = (float*)d_out; a.p.ws = (unsigned char*)d_ws;
    hipLaunchKernelGGL(mk_fwd, dim3(grid), dim3(NWAVES * 64), LDS_BYTES, stream, a);
    const hipError_t le = hipPeekAtLastError();
    if (le != hipSuccess) fprintf(stderr, "kernel_launch: launch failed: %s\n", hipGetErrorName(le));
}
```

```cpp
#include <hip/hip_runtime.h>
#include <cstdio>
#include <cstdint>
namespace pg8 {
#define PG8_LAS __attribute__((address_space(3)))
typedef unsigned short bf16_t;
typedef short bf16x8 __attribute__((ext_vector_type(8)));
typedef float f32x4 __attribute__((ext_vector_type(4)));
typedef unsigned u32x4 __attribute__((ext_vector_type(4)));
constexpr int BM = 256, BK = 64, HALF = 128, HTB = HALF * BK * 2  , STAGE_BYTES = 8 * HTB, NXCD = 8, WGM = 8;

__host__ __device__ __forceinline__ int lds_byte(int r, int c) { const int st = (r >> 4) * 2 + (c >> 5), rr = r & 15, cc = c & 31, ob = rr * 64 + cc * 2; return st * 1024 + (ob ^ (((ob >> 9) & 1) << 5)); }
__host__ __device__ __forceinline__ void stage_rc(int b, int& R, int& C) { const int st = b / 1024, sb = b % 1024, swz = sb ^ (((sb >> 9) & 1) << 5); R = (st >> 1) * 16 + swz / 64; C = (st & 1) * 32 + (swz % 64) / 2; }
__host__ __device__ __forceinline__ int perm32(int rho) { const int n = rho >> 4, i = rho & 15; return 8 * (i >> 2) + 4 * n + (i & 3); }

struct Unit { int pm, pn; };
struct Gemm { const bf16_t* A; const bf16_t* Bt; int M, N, K; };

struct StaticOrder {
    int nM, nN, nwg, G, c;
    __host__ __device__ void init(int M, int N, int G_, int c_) { nM = M / BM; nN = N / BM; nwg = nM * nN; G = G_; c = c_; }
    __host__ __device__ bool next(int i, Unit& u) const {
        const long L = (long)i * G + c; if (L >= nwg) return false;
        int wgid = (int)L; { const int q = nwg / NXCD, r = nwg % NXCD, xcd = wgid % NXCD, off = wgid / NXCD; wgid = (xcd < r ? xcd * (q + 1) : r * (q + 1) + (xcd - r) * q) + off; }
        const int nig = WGM * nN, gid = wgid / nig, fm = gid * WGM, gsz = (nM - fm) < WGM ? (nM - fm) : WGM;
        u.pm = fm + ((wgid % nig) % gsz); u.pn = (wgid % nig) / gsz; return true;
    }
    __device__ __forceinline__ void a_ready(const Unit&) const {}
    __device__ __forceinline__ void done(const Unit&) const {}
};
__device__ __forceinline__ unsigned cvt_pk_bf16(float lo, float hi) { unsigned r; asm volatile("v_cvt_pk_bf16_f32 %0, %1, %2" : "=v"(r) : "v"(lo), "v"(hi)); return r; }
typedef float f32x2 __attribute__((ext_vector_type(2)));
constexpr float RMS_EPS_F = 1e-6f;
constexpr float QSCALE_LOG2 = 0.18033688011112042f;
__device__ __forceinline__ float row_rstd(const float* ssq, int row) {
    const f32x4* p = (const f32x4*)(ssq + (size_t)row * 16);
    const f32x4 a = p[0], b = p[1], c = p[2], d = p[3];
    const float s = (((a[0] + a[1]) + (a[2] + a[3])) + ((b[0] + b[1]) + (b[2] + b[3]))) + (((c[0] + c[1]) + (c[2] + c[3])) + ((d[0] + d[1]) + (d[2] + d[3])));
    return __builtin_amdgcn_rsqf(s * (1.0f / 1024.0f) + RMS_EPS_F);
}
__device__ __forceinline__ u32x4 pack8(const f32x4& v0, const f32x4& v1) { u32x4 w; w.x = cvt_pk_bf16(v0[0], v0[1]); w.y = cvt_pk_bf16(v0[2], v0[3]); w.z = cvt_pk_bf16(v1[0], v1[1]); w.w = cvt_pk_bf16(v1[2], v1[3]); return w; }

struct EpiQKV {
    static constexpr bool PERM = true, AFTER_DRAIN = false;
    bf16_t* QKV; size_t tstride; const float* ssq; const float* rope; float* kmean;
    __device__ __forceinline__ void operator()(const f32x4 (&acc)[2][2][4][2], const Unit& u, int wr, int wc, int fr, int fq) const {
        const int t = u.pn >> 2;
        bf16_t* base = QKV + (size_t)t * tstride;
        const int col0 = (u.pn & 3) * BM + wc * 32 + 8 * fq;
        const bool rot = (t < 2) && ((wc & 1) == 0) && (fq < 2);
        const float sc = (t == 0) ? QSCALE_LOG2 : 1.0f;
        const int lane = fq * 16 + fr;
        float rv[2];
#pragma unroll
        for (int ai = 0; ai < 2; ++ai) rv[ai] = row_rstd(ssq, u.pm * BM + ai * HALF + wr * 64 + lane);
#pragma unroll
        for (int bj = 0; bj < 2; ++bj) {
            f32x4 ks0 = (f32x4){0.f, 0.f, 0.f, 0.f}, ks1 = ks0;
#pragma unroll
            for (int ai = 0; ai < 2; ++ai)
#pragma unroll
                for (int m = 0; m < 4; ++m) {
                    const int row = u.pm * BM + ai * HALF + wr * 64 + m * 16 + fr;
                    const float rs = __shfl(rv[ai], m * 16 + fr);
                    f32x4 v0 = acc[ai][bj][m][0] * rs, v1 = acc[ai][bj][m][1] * rs;
                    if (rot) { const f32x4* rp = (const f32x4*)(rope + (size_t)(row & 8191) * 16 + 8 * fq); const f32x4 cs0 = rp[0], cs1 = rp[1];
                        const f32x4 c = (f32x4){cs0[0], cs0[2], cs1[0], cs1[2]}, s = (f32x4){cs0[1], cs0[3], cs1[1], cs1[3]};
                        const f32x4 x1 = v0, x2 = v1; v0 = x1 * c - x2 * s; v1 = x2 * c + x1 * s; }
                    if (t == 1) { ks0 += v0; ks1 += v1; }
                    v0 = v0 * sc; v1 = v1 * sc;
                    *(u32x4*)(base + (size_t)row * 1024 + col0 + bj * HALF) = pack8(v0, v1);
                    if (m & 1) asm volatile("" ::: "memory");
                }
            if (t == 1) {
                float* km = kmean + (size_t)u.pm * 1024 + col0 + bj * HALF;
#pragma unroll
                for (int j = 0; j < 4; ++j) {
                    float r0 = ks0[j]; r0 += __shfl_xor(r0, 1); r0 += __shfl_xor(r0, 2); r0 += __shfl_xor(r0, 4); r0 += __shfl_xor(r0, 8);
                    float r1 = ks1[j]; r1 += __shfl_xor(r1, 1); r1 += __shfl_xor(r1, 2); r1 += __shfl_xor(r1, 4); r1 += __shfl_xor(r1, 8);
                    if (fr == 0) { atomicAdd(km + j, r0 * (1.0f / 256.0f)); atomicAdd(km + 4 + j, r1 * (1.0f / 256.0f)); }
                }
            }
        }
    }
};

template <bool WRITE_HB> struct EpiRes {
    static constexpr bool PERM = true, AFTER_DRAIN = false;
    const float* base; float* out; bf16_t* hb; float* ssq_out;
    __device__ __forceinline__ void operator()(const f32x4 (&acc)[2][2][4][2], const Unit& u, int wr, int wc, int fr, int fq) const {
        const int col0 = u.pn * BM + wc * 32 + 8 * fq;
#pragma unroll
        for (int ai = 0; ai < 2; ++ai)
#pragma unroll
            for (int m = 0; m < 4; ++m) {
                const int row = u.pm * BM + ai * HALF + wr * 64 + m * 16 + fr;
                float ss = 0.f;
#pragma unroll
                for (int bj = 0; bj < 2; ++bj) {
                    const size_t off = (size_t)row * 1024 + col0 + bj * HALF;
                    const f32x4 b0 = *(const f32x4*)(base + off), b1 = *(const f32x4*)(base + off + 4);
                    const f32x4 v0 = acc[ai][bj][m][0] + b0, v1 = acc[ai][bj][m][1] + b1;
                    *(f32x4*)(out + off) = v0; *(f32x4*)(out + off + 4) = v1;
                    ss += ((v0[0] * v0[0] + v0[1] * v0[1]) + (v0[2] * v0[2] + v0[3] * v0[3])) + ((v1[0] * v1[0] + v1[1] * v1[1]) + (v1[2] * v1[2] + v1[3] * v1[3]));
                    if (WRITE_HB) *(u32x4*)(hb + off) = pack8(v0, v1);
                }
                if (WRITE_HB) { ss += __shfl_xor(ss, 16); ss += __shfl_xor(ss, 32); if (fq == 0) ssq_out[(size_t)row * 16 + u.pn * 4 + wc] = ss; }
            }
    }
};

struct EpiSwiGLU {
    static constexpr bool PERM = true, AFTER_DRAIN = false;
    bf16_t* act; const float* ssq;
    __device__ __forceinline__ void operator()(const f32x4 (&acc)[2][2][4][2], const Unit& u, int wr, int wc, int fr, int fq) const {
        const int col0 = u.pn * HALF + wc * 32 + 8 * fq;
#pragma unroll
        for (int ai = 0; ai < 2; ++ai)
#pragma unroll
            for (int m = 0; m < 4; ++m) {
                const int row = u.pm * BM + ai * HALF + wr * 64 + m * 16 + fr;
                const float rs = row_rstd(ssq, row);
                f32x4 o[2];
#pragma unroll
                for (int n = 0; n < 2; ++n) {
                    const f32x4 g = acc[ai][0][m][n] * rs, up = acc[ai][1][m][n] * rs;
#pragma unroll
                    for (int j = 0; j < 4; ++j) { const float e = __builtin_amdgcn_exp2f(g[j] * -1.4426950408889634f); o[n][j] = g[j] * up[j] * __builtin_amdgcn_rcpf(1.0f + e); }
                }
                *(u32x4*)(act + (size_t)row * 2816 + col0) = pack8(o[0], o[1]);
            }
    }
};

struct EpiMlstmIn {
    static constexpr bool PERM = true, AFTER_DRAIN = false;
    bf16_t* MQ; bf16_t* MK; bf16_t* MV; bf16_t* OG; const float* ssq;
    __device__ __forceinline__ void operator()(const f32x4 (&acc)[2][2][4][2], const Unit& u, int wr, int wc, int fr, int fq) const {
        bf16_t* base; int ld, colt; float sc = 1.0f; bool sig = false;
        if (u.pn < 2) { base = MQ; ld = 512; colt = u.pn * BM; sc = 0.125f; }
        else if (u.pn < 4) { base = MK; ld = 512; colt = (u.pn - 2) * BM; }
        else if (u.pn < 8) { base = MV; ld = 1024; colt = (u.pn - 4) * BM; }
        else { base = OG; ld = 1024; colt = (u.pn - 8) * BM; sig = true; }
        const int col0 = colt + wc * 32 + 8 * fq;
#pragma unroll
        for (int ai = 0; ai < 2; ++ai)
#pragma unroll
            for (int m = 0; m < 4; ++m) {
                const int row = u.pm * BM + ai * HALF + wr * 64 + m * 16 + fr;
                const float rs = row_rstd(ssq, row) * sc;
#pragma unroll
                for (int bj = 0; bj < 2; ++bj) {
                    f32x4 v0 = acc[ai][bj][m][0] * rs, v1 = acc[ai][bj][m][1] * rs;
                    if (sig) {
#pragma unroll
                        for (int j = 0; j < 4; ++j) { v0[j] = __builtin_amdgcn_rcpf(1.0f + __builtin_amdgcn_exp2f(v0[j] * -1.4426950408889634f)); v1[j] = __builtin_amdgcn_rcpf(1.0f + __builtin_amdgcn_exp2f(v1[j] * -1.4426950408889634f)); }
                    }
                    *(u32x4*)(base + (size_t)row * ld + col0 + bj * HALF) = pack8(v0, v1);
                }
            }
    }
};
template <class Epi, class Sched, bool ALIGN_EPI = false, bool SP2 = false>
__device__ __forceinline__ void gemm_phase(PG8_LAS unsigned char* lds, const Gemm g, const Sched& S, const Epi& E) {
    int tid_ = threadIdx.x; asm volatile("" : "+v"(tid_));
    const int tid = tid_, wid = __builtin_amdgcn_readfirstlane(tid >> 6), lane = tid & 63, wr = wid >> 2, wc = wid & 3, fr = lane & 15, fq = lane >> 4;
    const int K = g.K, nt = K / BK;
    unsigned voffA[2], voffB[2];
#pragma unroll
    for (int i = 0; i < 2; ++i) { int R, C; stage_rc(tid * 16 + i * 8192, R, C); const int Rb = Epi::PERM ? ((R & ~31) + perm32(R & 31)) : R;
        voffA[i] = (unsigned)(R * K + C) * 2u; voffB[i] = (unsigned)(Rb * K + C) * 2u; }
    const size_t kstep = (size_t)(BK * 2);
    const size_t hstep = (size_t)HALF * K * 2;
    const size_t tstep = 2 * hstep;
    const unsigned ldsw = (unsigned)wid * 1024u;
    const int aoff = lds_byte(wr * 64 + fr, fq * 8), boff = lds_byte(wc * 32 + fr, fq * 8);
#define PG8_SA(b, h) (((b) * 2 + (h)) * HTB)
#define PG8_SB(b, h) ((4 + (b) * 2 + (h)) * HTB)
#define PG8_STAGE(bufoff, gbase, voff) do { _Pragma("unroll") for (int _i = 0; _i < 2; ++_i) \
        __builtin_amdgcn_global_load_lds((const unsigned*)((const char*)(gbase) + (voff)[_i]), (PG8_LAS unsigned*)(lds + (bufoff) + ldsw + _i * 8192), 16, 0, 0); } while (0)
#define PG8_LDA(dst, b, h) do { _Pragma("unroll") for (int m = 0; m < 4; ++m) _Pragma("unroll") for (int k = 0; k < 2; ++k) dst[m][k] = *(const PG8_LAS bf16x8*)(lds + PG8_SA(b, h) + aoff + m * 2048 + k * 1024); } while (0)
#define PG8_LDB(dst, b, h) do { _Pragma("unroll") for (int n = 0; n < 2; ++n) _Pragma("unroll") for (int k = 0; k < 2; ++k) dst[n][k] = *(const PG8_LAS bf16x8*)(lds + PG8_SB(b, h) + boff + n * 2048 + k * 1024); } while (0)
#define PG8_MMA(ai, bj, At, Bt) do { __builtin_amdgcn_s_setprio(1); _Pragma("unroll") for (int m = 0; m < 4; ++m) _Pragma("unroll") for (int n = 0; n < 2; ++n) _Pragma("unroll") for (int k = 0; k < 2; ++k) \
        acc[ai][bj][m][n] = __builtin_amdgcn_mfma_f32_16x16x32_bf16(Bt[n][k], At[m][k], acc[ai][bj][m][n], 0, 0, 0); __builtin_amdgcn_s_setprio(0); } while (0)
#define PG8_WAIT_V(n) asm volatile("s_waitcnt vmcnt(" #n ")" ::: "memory")
#define PG8_WAIT_L(n) asm volatile("s_waitcnt lgkmcnt(" #n ")" ::: "memory")
#define PG8_BAR __builtin_amdgcn_s_barrier()
#define PG8_SCHED __builtin_amdgcn_sched_barrier(0)
    Unit cur, nxt; int ui = 0;
    if (!S.next(0, cur)) return;
    f32x4 acc[2][2][4][2];
#pragma unroll
    for (int a = 0; a < 2; ++a)
#pragma unroll
        for (int b = 0; b < 2; ++b)
#pragma unroll
            for (int m = 0; m < 4; ++m)
#pragma unroll
                for (int n = 0; n < 2; ++n) acc[a][b][m][n] = (f32x4){0.f, 0.f, 0.f, 0.f};
    bf16x8 At[4][2], B0[2][2], B1[2][2];
    const char* cA = (const char*)g.A + (size_t)cur.pm * tstep; const char* cB = (const char*)g.Bt + (size_t)cur.pn * tstep;
    S.a_ready(cur);
    if constexpr (SP2) {
        PG8_STAGE(PG8_SB(0, 0), cB, voffB); PG8_STAGE(PG8_SB(0, 1), cB + hstep, voffB); PG8_STAGE(PG8_SA(0, 0), cA, voffA); PG8_STAGE(PG8_SA(0, 1), cA + hstep, voffA);
        if (wr == 1) PG8_BAR;
        PG8_WAIT_V(2); PG8_BAR;
        PG8_STAGE(PG8_SB(1, 0), cB + kstep, voffB); PG8_STAGE(PG8_SA(1, 0), cA + kstep, voffA); PG8_STAGE(PG8_SB(1, 1), cB + hstep + kstep, voffB);
        PG8_WAIT_V(6); PG8_BAR;
    } else {
        PG8_STAGE(PG8_SB(0, 0), cB, voffB); PG8_STAGE(PG8_SA(0, 0), cA, voffA); PG8_STAGE(PG8_SB(0, 1), cB + hstep, voffB); PG8_STAGE(PG8_SA(0, 1), cA + hstep, voffA);
        if (wr == 1) PG8_BAR;
        PG8_WAIT_V(4); PG8_BAR;
        PG8_STAGE(PG8_SB(1, 0), cB + kstep, voffB); PG8_STAGE(PG8_SA(1, 0), cA + kstep, voffA); PG8_STAGE(PG8_SB(1, 1), cB + hstep + kstep, voffB);
        PG8_WAIT_V(6); PG8_BAR;
    }
    for (;;) {
        const bool has_next = S.next(ui + 1, nxt);
        const char* nA = has_next ? (const char*)g.A + (size_t)nxt.pm * tstep : cA; const char* nB = has_next ? (const char*)g.Bt + (size_t)nxt.pn * tstep : cB;
        for (int t = 0; t < nt; t += 2) {
            const bool last = (t == nt - 2);
            const char* a1 = cA + (size_t)(t + 1) * kstep;
            const char* a2 = last ? nA : cA + (size_t)(t + 2) * kstep; const char* b2 = last ? nB : cB + (size_t)(t + 2) * kstep;
            const char* a3 = a2 + kstep; const char* b3 = b2 + kstep;
            if (last && has_next) S.a_ready(nxt);
            if constexpr (SP2) {
            PG8_LDB(B0, 0, 0); PG8_LDB(B1, 0, 1); PG8_SCHED; PG8_LDA(At, 0, 0); PG8_STAGE(PG8_SA(1, 1), a1 + hstep, voffA);
            PG8_WAIT_V(8); PG8_WAIT_L(0); PG8_BAR; PG8_MMA(0, 0, At, B0); PG8_MMA(0, 1, At, B1); PG8_BAR; PG8_SCHED;
            PG8_LDA(At, 0, 1); PG8_STAGE(PG8_SB(0, 0), b2, voffB); PG8_STAGE(PG8_SB(0, 1), b2 + hstep, voffB); PG8_STAGE(PG8_SA(0, 0), a2, voffA);
            PG8_WAIT_V(8); PG8_WAIT_L(0); PG8_BAR; PG8_MMA(1, 0, At, B0); PG8_MMA(1, 1, At, B1); PG8_BAR; PG8_SCHED;
            PG8_LDB(B0, 1, 0); PG8_LDB(B1, 1, 1); PG8_SCHED; PG8_LDA(At, 1, 0); PG8_STAGE(PG8_SA(0, 1), a2 + hstep, voffA);
            PG8_WAIT_V(8); PG8_WAIT_L(0); PG8_BAR; PG8_MMA(0, 0, At, B0); PG8_MMA(0, 1, At, B1); PG8_BAR; PG8_SCHED;
            PG8_LDA(At, 1, 1); PG8_STAGE(PG8_SB(1, 0), b3, voffB); PG8_STAGE(PG8_SB(1, 1), b3 + hstep, voffB); PG8_STAGE(PG8_SA(1, 0), a3, voffA);
            PG8_WAIT_V(8); PG8_WAIT_L(0); PG8_BAR; PG8_MMA(1, 0, At, B0); PG8_MMA(1, 1, At, B1); PG8_BAR; PG8_SCHED;
            } else {
            PG8_LDB(B0, 0, 0); PG8_SCHED; PG8_LDA(At, 0, 0); PG8_STAGE(PG8_SA(1, 1), a1 + hstep, voffA);
            PG8_WAIT_L(8); PG8_BAR; PG8_WAIT_L(0); PG8_MMA(0, 0, At, B0); PG8_BAR; PG8_SCHED;
            PG8_LDB(B1, 0, 1); PG8_STAGE(PG8_SB(0, 0), b2, voffB);
            PG8_BAR; PG8_WAIT_L(0); PG8_MMA(0, 1, At, B1); PG8_BAR;
            PG8_LDA(At, 0, 1); PG8_STAGE(PG8_SA(0, 0), a2, voffA);
            PG8_BAR; PG8_WAIT_L(0); PG8_MMA(1, 0, At, B0); PG8_BAR; PG8_SCHED;
            PG8_STAGE(PG8_SB(0, 1), b2 + hstep, voffB);
            PG8_WAIT_V(6); PG8_BAR; PG8_MMA(1, 1, At, B1); PG8_BAR;
            PG8_LDB(B0, 1, 0); PG8_SCHED; PG8_LDA(At, 1, 0); PG8_STAGE(PG8_SA(0, 1), a2 + hstep, voffA);
            PG8_WAIT_L(8); PG8_BAR; PG8_WAIT_L(0); PG8_MMA(0, 0, At, B0); PG8_BAR; PG8_SCHED;
            PG8_LDB(B1, 1, 1); PG8_STAGE(PG8_SB(1, 0), b3, voffB);
            PG8_BAR; PG8_WAIT_L(0); PG8_MMA(0, 1, At, B1); PG8_BAR;
            PG8_LDA(At, 1, 1); PG8_STAGE(PG8_SA(1, 0), a3, voffA);
            PG8_BAR; PG8_WAIT_L(0); PG8_MMA(1, 0, At, B0); PG8_BAR; PG8_SCHED;
            PG8_STAGE(PG8_SB(1, 1), b3 + hstep, voffB);
            PG8_WAIT_V(6); PG8_BAR; PG8_MMA(1, 1, At, B1); PG8_BAR;
            }
        }
        if constexpr (ALIGN_EPI) { if (wr == 0) PG8_BAR; }
        if constexpr (!Epi::AFTER_DRAIN) { E(acc, cur, wr, wc, fr, fq); S.done(cur); }
        if (!has_next) break;
#pragma unroll
        for (int a = 0; a < 2; ++a)
#pragma unroll
            for (int b = 0; b < 2; ++b)
#pragma unroll
                for (int m = 0; m < 4; ++m)
#pragma unroll
                    for (int n = 0; n < 2; ++n) acc[a][b][m][n] = (f32x4){0.f, 0.f, 0.f, 0.f};
        cur = nxt; cA = nA; cB = nB; ++ui;
        if constexpr (ALIGN_EPI) { if (wr == 1) PG8_BAR; }
    }
    PG8_WAIT_V(0);
    if constexpr (!ALIGN_EPI) { if (wr == 0) PG8_BAR; }
    PG8_BAR;
    if constexpr (Epi::AFTER_DRAIN) { E.fused(acc, cur, wr, wc, fr, fq, lds, wid, lane); S.done(cur); }
#undef PG8_SA
#undef PG8_SB
#undef PG8_STAGE
#undef PG8_LDA
#undef PG8_LDB
#undef PG8_MMA
#undef PG8_WAIT_V
#undef PG8_WAIT_L
#undef PG8_BAR
#undef PG8_SCHED
}
}

#ifndef PG8_SP2
#define PG8_SP2 true
#endif
#ifndef PG8_ALIGN
#define PG8_ALIGN true
#endif
#define GAS __attribute__((address_space(1)))
#define LAS __attribute__((address_space(3)))
typedef unsigned short bf16;
typedef unsigned v4u __attribute__((ext_vector_type(4)));
typedef float f32x4 __attribute__((ext_vector_type(4)));
typedef short bf16x8 __attribute__((ext_vector_type(8)));
typedef GAS unsigned gu32;
typedef GAS unsigned long long gu64;
#define RLX_AGENT __ATOMIC_RELAXED, __HIP_MEMORY_SCOPE_AGENT
#define LDS_WAIT() asm volatile("s_waitcnt lgkmcnt(0)" ::: "memory")
#define VM_WAIT() asm volatile("s_waitcnt vmcnt(0)" ::: "memory")
__device__ __forceinline__ unsigned long long rt() { return __builtin_amdgcn_s_memrealtime(); }
__device__ __forceinline__ unsigned f2bf(float f) { unsigned u = __builtin_bit_cast(unsigned, f); return (u + 0x7fffu + ((u >> 16) & 1u)) >> 16; }
__device__ __forceinline__ unsigned pk2(float lo, float hi) { return f2bf(lo) | (f2bf(hi) << 16); }

#define XB_TMO      128
#define XB_XCNT(j)  (256  + 64 * (j))
#define XB_XSUB(j)  (1280 + 64 * (j))
#define XB_XGEN(j)  (2304 + 64 * (j))
#define XB_TOP      3328
#define XB_TOPGEN   3392
#define XCD_BAR_WORDS 3456
#define XB_SPIN_CAP (1u << 18)

__device__ __forceinline__ unsigned xb_ld(unsigned* p)              { return __hip_atomic_load(p, __ATOMIC_RELAXED, __HIP_MEMORY_SCOPE_AGENT); }
__device__ __forceinline__ unsigned xb_add(unsigned* p, unsigned v) { return __hip_atomic_fetch_add(p, v, __ATOMIC_RELAXED, __HIP_MEMORY_SCOPE_AGENT); }
__device__ __forceinline__ unsigned xb_xcc_id() { return (unsigned)__builtin_amdgcn_s_getreg((3 << 11) | 20) & 0xFu; }
#define XB_SPIN(cond, bar) do { unsigned _sp = 0; while (cond) { __builtin_amdgcn_s_sleep(1); \
    if ((++_sp & 255u) == 0u) { if (xb_ld(&(bar)[XB_TMO])) break; if (_sp > XB_SPIN_CAP) { atomicAdd(&(bar)[XB_TMO], 1u); break; } } } } while (0)

struct XcdBarrier {
    unsigned* bar; unsigned x;
    volatile LAS unsigned* st;
};

__device__ __forceinline__ XcdBarrier xcd_barrier_post(unsigned* bar, volatile LAS unsigned* st) {
    XcdBarrier b; b.bar = bar; b.x = xb_xcc_id(); b.st = st;
    if (threadIdx.x == 0) (void)xb_add(&bar[XB_XCNT(b.x)], 1u);
    return b;
}
__device__ __forceinline__ void xcd_barrier_complete(unsigned* bar, unsigned x, unsigned& nloc, unsigned& nx) {
    const unsigned G = gridDim.x * gridDim.y * gridDim.z;
    unsigned sum, cnt, mine, sp = 0u;
    for (;;) {
        sum = 0u; cnt = 0u; mine = 0u;
#pragma unroll
        for (unsigned j = 0; j < 16; ++j) { const unsigned c = xb_ld(&bar[XB_XCNT(j)]); sum += c; cnt += (c > 0u) ? 1u : 0u; mine = (j == x) ? c : mine; }
        if (sum == G) break;
        __builtin_amdgcn_s_sleep(1);
        if ((++sp & 255u) == 0u) { if (xb_ld(&bar[XB_TMO])) break; if (sp > XB_SPIN_CAP) { atomicAdd(&bar[XB_TMO], 1u); break; } }
    }
    nloc = mine > 0u ? mine : 1u; nx = cnt > 0u ? cnt : 1u;
}

__device__ __forceinline__ void xcd_barrier(const XcdBarrier& b) {
    asm volatile("s_waitcnt vmcnt(0)" ::: "memory");
    __syncthreads();
    if (threadIdx.x == 0) {
        unsigned* bar = b.bar;
        __builtin_amdgcn_s_waitcnt(0);
        unsigned nloc = b.st[0], nx = b.st[1];
        if (nloc == 0u) { xcd_barrier_complete(bar, b.x, nloc, nx); b.st[0] = nloc; b.st[1] = nx; }
        const unsigned old = xb_add(&bar[XB_XSUB(b.x)], 1u);
        const unsigned gen = old / nloc;
        if (old + 1u == (gen + 1u) * nloc) {
            __builtin_amdgcn_fence(__ATOMIC_RELEASE, "agent");
            asm volatile("s_waitcnt vmcnt(0)" ::: "memory");
            const unsigned og = xb_add(&bar[XB_TOP], 1u);
            const unsigned tg = og / nx;
            if (og + 1u == (tg + 1u) * nx) xb_add(&bar[XB_TOPGEN], 1u);
            else XB_SPIN(xb_ld(&bar[XB_TOPGEN]) == tg, bar);
            __builtin_amdgcn_fence(__ATOMIC_ACQUIRE, "agent");
            xb_add(&bar[XB_XGEN(b.x)], 1u);
            asm volatile("s_waitcnt vmcnt(0)" ::: "memory");
        } else {
            XB_SPIN(xb_ld(&bar[XB_XGEN(b.x)]) == gen, bar);
            __builtin_amdgcn_fence(__ATOMIC_ACQUIRE, "agent");
            asm volatile("s_waitcnt vmcnt(0)" ::: "memory");
        }
    }
    __syncthreads();
}
constexpr int NWAVES = 8;
constexpr int BATCH = 2, SEQ = 8192, D = 1024, M = BATCH * SEQ, NH = 16, HD = 64, MB = 256, NBLK = SEQ / MB;
constexpr int DFF = 2816, NGU = 2 * DFF;
constexpr int MH = 8, DK = 64, DV = 128, LCH = 64, NCH = SEQ / LCH, NUNIT = BATCH * MH * NCH;
constexpr int NIN = 3072, NINW = 3088;
constexpr float RMS_EPS = 1e-6f, SOFTCAP = 15.0f, LOG2E = 1.4426950408889634f;

constexpr size_t MiB = 1u << 20;
constexpr size_t WS_CTL = 0, CTL_ZERO_BYTES = 1 * MiB;
constexpr size_t WS_KMEAN = 512 * 1024;
constexpr size_t WS_SSQ = 1 * MiB;
constexpr size_t WS_BIG = 5 * MiB;
constexpr size_t WS_SEL = 6 * MiB;
constexpr size_t WS_ROPE = 7 * MiB;
constexpr size_t WS_WG = 7 * MiB + 512 * 1024;
constexpr size_t WS_WQKV = 8 * MiB, WS_WO = 14 * MiB, WS_WIN = 16 * MiB, WS_WOUT = 22 * MiB, WS_WGU = 24 * MiB  , WS_WD = 46 * MiB  ;
constexpr size_t WS_NLOC = 57 * MiB;
constexpr size_t WS_SCAL = 57 * MiB + 512 * 1024;
constexpr size_t WS_AB = 64 * MiB;
constexpr size_t WS_Q = 96 * MiB, WS_K = 128 * MiB, WS_V = 160 * MiB;
constexpr size_t WS_HB1 = 96 * MiB;
constexpr size_t WS_ACT = 128 * MiB;
constexpr size_t WS_MQ = 96 * MiB, WS_MK = 112 * MiB, WS_MV = 128 * MiB, WS_OG = 160 * MiB, WS_CLOC = 192 * MiB;
constexpr size_t WS_END = 256 * MiB;
constexpr int CW_BAR = 4096;

constexpr int RING_OFF = 0, RING_BYTES = 131072;
constexpr int LDSCTL_OFF = RING_BYTES, MISC_OFF = LDSCTL_OFF + 320;
constexpr int LDS_BYTES = 163840;
static_assert(MISC_OFF + 128 <= LDS_BYTES, "LDS map");

__device__ __forceinline__ float bf2f(unsigned short h) { return __builtin_bit_cast(float, (unsigned)h << 16); }
__device__ __forceinline__ float bflo(unsigned w) { return __builtin_bit_cast(float, w << 16); }
__device__ __forceinline__ float bfhi(unsigned w) { return __builtin_bit_cast(float, w & 0xffff0000u); }
__device__ __forceinline__ float wave_sum(float v) {
#pragma unroll
    for (int o = 1; o < 64; o <<= 1) v += __shfl_xor(v, o);
    return v;
}
__device__ __forceinline__ float wave_max(float v) {
#pragma unroll
    for (int o = 1; o < 64; o <<= 1) v = fmaxf(v, __shfl_xor(v, o));
    return v;
}
__device__ __forceinline__ float fexp(float x) { return __builtin_amdgcn_exp2f(x * LOG2E); }

struct Frame {
    LAS unsigned char* lds;
    volatile LAS unsigned* MISC;
    gu32* ctl;
    int wave, vcu, G;
};

template <int MODE> __device__ __forceinline__ int src_col(int n) {
    if (MODE == 1) {
        if (n >= 2048) return n;
        const int s = n & 63; int d = s;
        if (s < 16) d = (s & 3) | ((s & 4) << 1) | ((s & 8) >> 1);
        return (n & ~63) | d;
    }
    if (MODE == 2) { const int pn = n >> 8, r = n & 255; return (r < 128) ? pn * 128 + r : DFF + pn * 128 + (r - 128); }
    return n;
}
template <int MODE> __device__ __forceinline__ void p0_transpose_item(const float* W, int K, int Nsrc, int Nout, const float* kscale, bf16* WT, LAS float* scr, int item, int lane) {
    const int nblk = Nout / 32, kb = item / nblk, nb = item % nblk, k0 = 64 * kb, n0 = 32 * nb;
    const int sc = src_col<MODE>(n0 + (lane & 31));
#pragma unroll 8
    for (int i = 0; i < 32; ++i) { const int kk = 2 * i + (lane >> 5); float w = W[(size_t)(k0 + kk) * Nsrc + sc]; if (kscale) w *= kscale[k0 + kk]; scr[kk * 33 + (lane & 31)] = w; }
    LDS_WAIT(); asm volatile("" ::: "memory");
    const int c = lane & 7;
#pragma unroll
    for (int j = 0; j < 4; ++j) { const int n = (lane >> 3) + 8 * j; const LAS float* s = scr + (8 * c) * 33 + n;
        v4u o; o.x = pk2(s[0 * 33], s[1 * 33]); o.y = pk2(s[2 * 33], s[3 * 33]); o.z = pk2(s[4 * 33], s[5 * 33]); o.w = pk2(s[6 * 33], s[7 * 33]);
        *(GAS v4u*)(WT + (size_t)(n0 + n) * K + k0 + 8 * c) = o; }
    LDS_WAIT(); asm volatile("" ::: "memory");
}

struct Ptrs {
    const float *x, *attn_norm, *w_qkv, *w_o, *mlstm_norm, *w_in, *b_gates, *head_norm, *w_out, *ffn_norm, *w_gu, *w_down, *final_norm;
    float* out; unsigned char* ws;
};

__device__ __forceinline__ void p0_prologue(Frame& F, const Ptrs& P) {
    LAS float* scr = (LAS float*)(F.lds + RING_OFF + F.wave * 16384);
    unsigned char* ws = P.ws;
    const int gw = F.vcu * NWAVES + F.wave, NGW = F.G * NWAVES;
    constexpr int I_QKV = (D / 64) * (3 * D / 32), I_O = (D / 64) * (D / 32), I_IN = (D / 64) * (NIN / 32), I_GU = (D / 64) * (NGU / 32), I_DN = (DFF / 64) * (D / 32);
    constexpr int NITEMS = I_QKV + I_O + I_IN + I_O + 2 * I_GU + 2 * I_DN;
    for (int it = gw; it < NITEMS; it += NGW) {
        int r = it;
        if (r < I_QKV) { p0_transpose_item<1>(P.w_qkv, D, 3 * D, 3 * D, P.attn_norm, (bf16*)(ws + WS_WQKV), scr, r, ((int)(threadIdx.x & 63u))); continue; } r -= I_QKV;
        if (r < I_O) { p0_transpose_item<0>(P.w_o, D, D, D, nullptr, (bf16*)(ws + WS_WO), scr, r, ((int)(threadIdx.x & 63u))); continue; } r -= I_O;
        if (r < I_IN) { p0_transpose_item<0>(P.w_in, D, NINW, NIN, P.mlstm_norm, (bf16*)(ws + WS_WIN), scr, r, ((int)(threadIdx.x & 63u))); continue; } r -= I_IN;
        if (r < I_O) { p0_transpose_item<0>(P.w_out, D, D, D, nullptr, (bf16*)(ws + WS_WOUT), scr, r, ((int)(threadIdx.x & 63u))); continue; } r -= I_O;
        if (r < 2 * I_GU) { const int l = r / I_GU; p0_transpose_item<2>(P.w_gu + (size_t)l * D * NGU, D, NGU, NGU, P.ffn_norm + l * D, (bf16*)(ws + WS_WGU) + (size_t)l * NGU * D, scr, r % I_GU, ((int)(threadIdx.x & 63u))); continue; } r -= 2 * I_GU;
        { const int l = r / I_DN; p0_transpose_item<0>(P.w_down + (size_t)l * DFF * D, DFF, D, D, nullptr, (bf16*)(ws + WS_WD) + (size_t)l * D * DFF, scr, r % I_DN, ((int)(threadIdx.x & 63u))); }
    }
    const int gt = F.vcu * (NWAVES * 64) + ((int)threadIdx.x), NGT = F.G * NWAVES * 64;
    { bf16* WG = (bf16*)(ws + WS_WG); for (int i = gt; i < 16 * D; i += NGT) { const int j = i >> 10, k = i & 1023; WG[i] = (bf16)f2bf(P.mlstm_norm[k] * P.w_in[(size_t)k * NINW + NIN + j]); } }
    { float* rope = (float*)(ws + WS_ROPE);
      for (int i = gt; i < SEQ * 8; i += NGT) { const int pos = i >> 3, j = i & 7;
          const float invf = j == 0 ? 1.0f : j == 1 ? 0.1939227432012558f : j == 2 ? 0.03760603070259094f : j == 3 ? 0.007292664609849453f : j == 4 ? 0.0014142135623842478f : j == 5 ? 0.00027424818836152554f : j == 6 ? 5.3182957344688475e-05f : 1.0313385246263351e-05f;
          const float ang = __fmul_rn((float)pos, invf);
          const double rev = (double)ang * 0.15915494309189533577; const float fr = (float)(rev - __builtin_rint(rev));
          rope[2 * i] = __builtin_amdgcn_cosf(fr); rope[2 * i + 1] = __builtin_amdgcn_sinf(fr); } }
    { bf16* xb = (bf16*)(ws + WS_AB); float* ssq0 = (float*)(ws + WS_SSQ);
      for (int m = gw; m < M; m += NGW) {
          const GAS f32x4* xr = (const GAS f32x4*)(P.x + (size_t)m * D) + ((int)(threadIdx.x & 63u)); f32x4 v[4]; float s = 0.f;
#pragma unroll
          for (int j = 0; j < 4; ++j) { v[j] = xr[64 * j]; s += (v[j].x * v[j].x + v[j].y * v[j].y) + (v[j].z * v[j].z + v[j].w * v[j].w); }
          s = wave_sum(s);
          GAS unsigned long long* o8 = (GAS unsigned long long*)(xb + (size_t)m * D) + ((int)(threadIdx.x & 63u));
#pragma unroll
          for (int j = 0; j < 4; ++j) o8[64 * j] = (unsigned long long)pk2(v[j].x, v[j].y) | ((unsigned long long)pk2(v[j].z, v[j].w) << 32);
          if (((int)(threadIdx.x & 63u)) < 16) ssq0[(size_t)m * 16 + ((int)(threadIdx.x & 63u))] = (((int)(threadIdx.x & 63u)) == 0) ? s : 0.f;
      } }
}

namespace moba {
typedef short bf16x8 __attribute__((ext_vector_type(8)));
typedef short s16x4 __attribute__((ext_vector_type(4)));
typedef float f32x16 __attribute__((ext_vector_type(16)));
typedef unsigned u32x4 __attribute__((ext_vector_type(4)));
typedef LAS const char* lds_cptr;
typedef short v4i16_t __attribute__((ext_vector_type(4)));
typedef float f32x2_t __attribute__((ext_vector_type(2))); typedef __bf16 bf16x2_t __attribute__((ext_vector_type(2)));
constexpr int THRL = 8;
constexpr int L_K = 0, L_V = 32768, L_WS = 65536  , L_STG = 73728  , L_QL = 106496  , L_MISC = 122880;
constexpr size_t WS_SEGCNT = 58 * MiB;
constexpr size_t WS_P2 = 192 * MiB;
constexpr size_t WS_PLSE = 224 * MiB;
constexpr size_t WS_SEGLIST = 232 * MiB;
constexpr int CW_Q3 = 8192;
constexpr size_t PART_STRIDE = (size_t)M * D * 2;

__device__ __forceinline__ int crow(int r, int hi) { return (r & 3) + 8 * (r >> 2) + 4 * hi; }
__device__ __forceinline__ void glds16(const void* gsrc, unsigned lds_dst) { unsigned keep;
    asm volatile("s_mov_b32 %0, m0\n\ts_mov_b32 m0, %2\n\ts_nop 0\n\tglobal_load_lds_dwordx4 %1, off\n\ts_mov_b32 m0, %0" : "=&s"(keep) : "v"(gsrc), "s"(lds_dst) : "memory"); }
__device__ __forceinline__ unsigned cvtpk_s(float lo, float hi) { f32x2_t v = {lo, hi}; bf16x2_t b = __builtin_convertvector(v, bf16x2_t); return __builtin_bit_cast(unsigned, b); }
__device__ __forceinline__ s16x4 vtr(lds_cptr p) { return __builtin_bit_cast(s16x4, __builtin_amdgcn_ds_read_tr16_b64_v4i16((LAS v4i16_t*)p)); }
#define MOBA_MX3(a, b, c) __builtin_fmaxf(__builtin_fmaxf((a), (b)), (c))
__device__ __forceinline__ float rowmax(const f32x16& p0, const f32x16& p1) {
    float a = MOBA_MX3(p0[0], p0[1], p1[0]), b = MOBA_MX3(p0[2], p0[3], p1[1]); a = MOBA_MX3(a, p1[2], p1[3]);
#pragma unroll
    for (int r = 4; r < 16; r += 4) { a = MOBA_MX3(a, p0[r], p0[r + 1]); b = MOBA_MX3(b, p0[r + 2], p0[r + 3]); a = MOBA_MX3(a, p1[r], p1[r + 1]); b = MOBA_MX3(b, p1[r + 2], p1[r + 3]); }
    float m = __builtin_fmaxf(a, b); auto rr = __builtin_amdgcn_permlane32_swap(__float_as_uint(m), __float_as_uint(m), false, false);
    return __builtin_fmaxf(__uint_as_float(rr[0]), __uint_as_float(rr[1])); }
__device__ __forceinline__ float halves_sum(float v) { auto rr = __builtin_amdgcn_permlane32_swap(__float_as_uint(v), __float_as_uint(v), false, false); return __uint_as_float(rr[0]) + __uint_as_float(rr[1]); }
#define MOBA_MFMA(a, b, c) __builtin_amdgcn_mfma_f32_32x32x16_bf16(a, b, c, 0, 0, 0)

__device__ __forceinline__ void stage_kv(const bf16* K, const bf16* V, int b, int h, int j, LAS unsigned char* lds, int wid, int lane) {
    const size_t row0 = (size_t)b * SEQ + (size_t)j * MB;
    const bf16* ksrc = K + (row0 + lane) * D + h * HD + wid * 8;
    const bf16* vsrc = V + (row0 + 16 * (wid & 3) + (lane >> 2)) * D + h * HD + (wid >> 2) * 32 + (lane & 3) * 8;
    const unsigned kdst = (unsigned)(uintptr_t)(lds + L_K) + wid * 1024, vdst = (unsigned)(uintptr_t)(lds + L_V) + wid * 1024;
#pragma unroll
    for (int t = 0; t < 4; ++t) { glds16(ksrc + (size_t)t * 64 * D, (unsigned)__builtin_amdgcn_readfirstlane(kdst + t * 8192)); glds16(vsrc + (size_t)t * 64 * D, (unsigned)__builtin_amdgcn_readfirstlane(vdst + t * 8192)); }
    asm volatile("s_waitcnt vmcnt(0) lgkmcnt(0)\n\ts_barrier" ::: "memory");
}

template <bool CAUSAL> __device__ __forceinline__ void wave_block(const bf16x8 (&qr)[4], lds_cptr kbase, lds_cptr vbase, int ntiles, int qrel, LAS float* wsf, int lane, f32x16& o0, f32x16& o1, float& mhat, float& lsum) {
    const int r32 = lane & 31, hi = lane >> 5;
    const lds_cptr kp0 = kbase + hi * 1024 + r32 * 16;
    const lds_cptr vp0 = vbase + ((lane >> 4) & 1) * 32 + (lane & 3) * 8 + (4 * hi + ((lane & 15) >> 2)) * 64;
    o0 = f32x16{}; o1 = f32x16{}; mhat = 0.f; lsum = 0.f;
    int kt0 = 0; asm volatile("" : "+s"(kt0));
#pragma nounroll
    for (int kt = kt0; kt < ntiles; ++kt) {
        const lds_cptr kp = kp0 + kt * 8192, vp = vp0 + kt * 8192;
        bf16x8 kf[8];
#pragma unroll
        for (int d0 = 0; d0 < 4; ++d0) { kf[2 * d0] = *(const LAS bf16x8*)(kp + d0 * 2048); kf[2 * d0 + 1] = *(const LAS bf16x8*)(kp + d0 * 2048 + 512); }
        f32x16 negm;
#pragma unroll
        for (int r = 0; r < 16; ++r) negm[r] = 0.f - mhat;
        f32x16 c0 = MOBA_MFMA(kf[0], qr[0], negm), c1 = MOBA_MFMA(kf[1], qr[0], negm);
        c0 = MOBA_MFMA(kf[2], qr[1], c0); c1 = MOBA_MFMA(kf[3], qr[1], c1);
        c0 = MOBA_MFMA(kf[4], qr[2], c0); c1 = MOBA_MFMA(kf[5], qr[2], c1);
        c0 = MOBA_MFMA(kf[6], qr[3], c0); c1 = MOBA_MFMA(kf[7], qr[3], c1);
        if (CAUSAL && kt == ntiles - 1) { int rel = qrel - 64 * kt - 4 * hi; asm volatile("" : "+v"(rel));
#pragma unroll
            for (int r = 0; r < 16; ++r) { const int kv = (r & 3) + 8 * (r >> 2); if (kv > rel) c0[r] = -INFINITY; if (kv + 32 > rel) c1[r] = -INFINITY; } }
        const float rm = rowmax(c0, c1);
        bool resc = false; float dl = 0.f;
        if (kt == 0) { dl = rm; mhat = rm; }
        else if (__any(rm > (float)THRL)) { dl = __builtin_fmaxf(rm, 0.f); mhat += dl; const float f = __builtin_amdgcn_exp2f(-dl); lsum *= f; if (hi == 0) wsf[r32] = f; resc = true; }
        float sacc = 0.f;
#pragma unroll
        for (int r = 0; r < 16; ++r) { c0[r] = __builtin_amdgcn_exp2f(c0[r] - dl); c1[r] = __builtin_amdgcn_exp2f(c1[r] - dl); sacc += c0[r] + c1[r]; }
        lsum += sacc;
        if (resc) { asm volatile("s_waitcnt lgkmcnt(0)" ::: "memory");
#pragma unroll
            for (int r = 0; r < 16; ++r) { const float f = wsf[crow(r, hi)]; o0[r] *= f; o1[r] *= f; } }
        u32x4 pw0, pw1, pw2, pw3;
        pw0 = (u32x4){cvtpk_s(c0[0], c0[1]), cvtpk_s(c0[2], c0[3]), cvtpk_s(c0[4], c0[5]), cvtpk_s(c0[6], c0[7])}; pw1 = (u32x4){cvtpk_s(c0[8], c0[9]), cvtpk_s(c0[10], c0[11]), cvtpk_s(c0[12], c0[13]), cvtpk_s(c0[14], c0[15])};
        pw2 = (u32x4){cvtpk_s(c1[0], c1[1]), cvtpk_s(c1[2], c1[3]), cvtpk_s(c1[4], c1[5]), cvtpk_s(c1[6], c1[7])}; pw3 = (u32x4){cvtpk_s(c1[8], c1[9]), cvtpk_s(c1[10], c1[11]), cvtpk_s(c1[12], c1[13]), cvtpk_s(c1[14], c1[15])};
        s16x4 vlo[8], vhi[8];
#pragma unroll
        for (int i = 0; i < 8; ++i) { vlo[i] = vtr(vp + ((i >> 2) * 4096 + (i & 3) * 1024)); vhi[i] = vtr(vp + ((i >> 2) * 4096 + (i & 3) * 1024 + 512)); }
#define MOBA_PAF(k) __builtin_bit_cast(bf16x8, pw##k)
#define MOBA_VFR(i) (bf16x8){vlo[i][0], vlo[i][1], vlo[i][2], vlo[i][3], vhi[i][0], vhi[i][1], vhi[i][2], vhi[i][3]}
        o0 = MOBA_MFMA(MOBA_PAF(0), MOBA_VFR(0), o0); o1 = MOBA_MFMA(MOBA_PAF(0), MOBA_VFR(4), o1); o0 = MOBA_MFMA(MOBA_PAF(1), MOBA_VFR(1), o0); o1 = MOBA_MFMA(MOBA_PAF(1), MOBA_VFR(5), o1);
        o0 = MOBA_MFMA(MOBA_PAF(2), MOBA_VFR(2), o0); o1 = MOBA_MFMA(MOBA_PAF(2), MOBA_VFR(6), o1); o0 = MOBA_MFMA(MOBA_PAF(3), MOBA_VFR(3), o0); o1 = MOBA_MFMA(MOBA_PAF(3), MOBA_VFR(7), o1);
#undef MOBA_PAF
#undef MOBA_VFR
    }
    lsum = halves_sum(lsum);
}
__device__ __forceinline__ void stage_o(const f32x16& o0, const f32x16& o1, float lsum, LAS float* wsf, LAS unsigned short* stg, int lane) {
    const int r32 = lane & 31, hi = lane >> 5;
    if (hi == 0) wsf[32 + r32] = __builtin_amdgcn_rcpf(lsum);
    asm volatile("s_waitcnt lgkmcnt(0)" ::: "memory");
#pragma unroll
    for (int r = 0; r < 16; ++r) { const int orow = crow(r, hi); const float rl = wsf[32 + orow];
        stg[orow * 64 + r32] = (unsigned short)f2bf(o0[r] * rl); stg[orow * 64 + 32 + r32] = (unsigned short)f2bf(o1[r] * rl); }
    asm volatile("s_waitcnt lgkmcnt(0)" ::: "memory");
}

__device__ __forceinline__ bool better(float g, int n, float gk, int ik) { return g > gk || (g == gk && n < ik); }
__device__ __forceinline__ void ins3(float g, int n, float& g1, int& i1, float& g2, int& i2, float& g3, int& i3) {
    const bool b1 = better(g, n, g1, i1), b2 = better(g, n, g2, i2), b3 = better(g, n, g3, i3);
    const float n3 = b2 ? g2 : (b3 ? g : g3); const int m3 = b2 ? i2 : (b3 ? n : i3);
    const float n2 = b1 ? g1 : (b2 ? g : g2); const int m2 = b1 ? i1 : (b2 ? n : i2);
    g1 = b1 ? g : g1; i1 = b1 ? n : i1; g2 = n2; i2 = m2; g3 = n3; i3 = m3;
}
}

__device__ __forceinline__ void p2_gating(Frame& F, const Ptrs& P) {
    using namespace moba;
    const bf16* Q = (const bf16*)(P.ws + WS_Q); const float* kmean = (const float*)(P.ws + WS_KMEAN);
    unsigned* segcnt = (unsigned*)(P.ws + WS_SEGCNT); unsigned short* seglist = (unsigned short*)(P.ws + WS_SEGLIST);
    LAS float* kmf = (LAS float*)(F.lds + RING_OFF); LAS float* cg = kmf + 32 * 64; LAS int* ci = (LAS int*)(cg + 256 * 3); LAS unsigned* cntL = (LAS unsigned*)(ci + 256 * 3);
    const int tid = ((int)threadIdx.x);
    for (int unit = F.vcu; unit < BATCH * NH * NBLK; unit += F.G) {
        const int bh = unit >> 5, cur = unit & 31, b = bh >> 4, h = bh & 15;
        if (cur == 0) continue;
        for (int i = tid; i < cur * 64; i += NWAVES * 64) kmf[i] = kmean[(size_t)(b * NBLK + (i >> 6)) * D + h * HD + (i & 63)];
        if (tid < 32) cntL[tid] = 0u;
        LDS_WAIT(); __syncthreads();
        const int tq = tid & 255, half = tid >> 8, tl = cur * MB + tq;
        float q[64];
        { const v4u* qp = (const v4u*)(Q + (size_t)(b * SEQ + tl) * D + h * HD);
#pragma unroll
          for (int i = 0; i < 8; ++i) { const v4u w = qp[i]; q[8 * i] = bflo(w.x); q[8 * i + 1] = bfhi(w.x); q[8 * i + 2] = bflo(w.y); q[8 * i + 3] = bfhi(w.y); q[8 * i + 4] = bflo(w.z); q[8 * i + 5] = bfhi(w.z); q[8 * i + 6] = bflo(w.w); q[8 * i + 7] = bfhi(w.w); } }
        float g1 = -INFINITY, g2 = -INFINITY, g3 = -INFINITY; int i1 = 255, i2 = 255, i3 = 255;
        for (int n = half; n < cur; n += 2) {
            const LAS float* kp = kmf + n * 64; float g = 0.f;
#pragma unroll
            for (int i = 0; i < 64; i += 4) g += (q[i] * kp[i] + q[i + 1] * kp[i + 1]) + (q[i + 2] * kp[i + 2] + q[i + 3] * kp[i + 3]);
            ins3(g, n, g1, i1, g2, i2, g3, i3);
        }
        if (half == 1) { cg[tq * 3] = g1; cg[tq * 3 + 1] = g2; cg[tq * 3 + 2] = g3; ci[tq * 3] = i1; ci[tq * 3 + 1] = i2; ci[tq * 3 + 2] = i3; }
        LDS_WAIT(); __syncthreads();
        if (half == 0) {
#pragma unroll
            for (int r = 0; r < 3; ++r) { const float g = cg[tq * 3 + r]; const int n = ci[tq * 3 + r]; if (n != 255) ins3(g, n, g1, i1, g2, i2, g3, i3); }
#define P2_EMIT(j, r) do { if ((j) != 255) { const unsigned pos = __hip_atomic_fetch_add(cntL + (j), 1u, __ATOMIC_RELAXED, __HIP_MEMORY_SCOPE_WORKGROUP); \
                    seglist[((size_t)(bh * 32 + (j)) * 32 + cur) * 256 + pos] = (unsigned short)(tl | ((r) << 13)); } } while (0)
            P2_EMIT(i1, 0); P2_EMIT(i2, 1); P2_EMIT(i3, 2);
#undef P2_EMIT
        }
        LDS_WAIT(); __syncthreads();
        if (tid < cur) segcnt[(bh * 32 + tid) * 32 + cur] = cntL[tid];
        LDS_WAIT(); __syncthreads();
    }
}

__device__ __forceinline__ void p3_gathered(Frame& F, const Ptrs& P) {
    using namespace moba;
    unsigned char* ws = P.ws;
    const bf16* Q = (const bf16*)(ws + WS_Q); const bf16* K = (const bf16*)(ws + WS_K); const bf16* V = (const bf16*)(ws + WS_V);
    const unsigned* segcnt = (const unsigned*)(ws + WS_SEGCNT); const unsigned short* seglist = (const unsigned short*)(ws + WS_SEGLIST);
    float* plse = (float*)(ws + WS_PLSE);
    LAS unsigned short* ql = (LAS unsigned short*)(F.lds + L_QL); LAS unsigned* misc = (LAS unsigned*)(F.lds + L_MISC);
    LAS float* wsf = (LAS float*)(F.lds + L_WS) + F.wave * 256; LAS unsigned short* stg = (LAS unsigned short*)(F.lds + L_STG) + F.wave * 2048;
    const int tid = ((int)threadIdx.x), lane = ((int)(threadIdx.x & 63u)), wid = F.wave, r32 = lane & 31, hi = lane >> 5;
    for (;;) {
        if (tid == 0) misc[0] = __hip_atomic_fetch_add(F.ctl + CW_Q3, 1u, RLX_AGENT);
        LDS_WAIT(); __syncthreads();
        const int item = (int)misc[0];
        if (item >= 31 * 32) break;
        const int j = item >> 5, bh = item & 31, b = bh >> 4, h = bh & 15;
        if (tid < 32) {
            const unsigned c = (tid > j) ? segcnt[(bh * 32 + j) * 32 + tid] : 0u; unsigned s = c;
#pragma unroll
            for (int o = 1; o < 32; o <<= 1) { const unsigned t = __shfl_up(s, o, 32); if (tid >= o) s += t; }
            misc[32 + tid] = s - c; misc[64 + tid] = c; if (tid == 31) misc[1] = s;
        }
        LDS_WAIT(); __syncthreads();
        const int n = (int)misc[1];
        for (int cur = j + 1; cur < 32; ++cur) { const int c = (int)misc[64 + cur], off = (int)misc[32 + cur]; const unsigned short* sp = seglist + ((size_t)(bh * 32 + j) * 32 + cur) * 256;
            for (int i = tid; i < c; i += NWAVES * 64) ql[off + i] = sp[i]; }
        stage_kv(K, V, b, h, j, F.lds, wid, lane);
        const int ngroups = (n + 31) >> 5;
        for (int g = wid; g < ngroups; g += NWAVES) {
            const int idx = g * 32 + r32; const unsigned e = ql[idx < n ? idx : n - 1]; const int tl = (int)(e & 8191u);
            const bf16* qp = Q + (size_t)(b * SEQ + tl) * D + h * HD + hi * 8;
            bf16x8 qr[4];
#pragma unroll
            for (int d0 = 0; d0 < 4; ++d0) qr[d0] = *(const bf16x8*)(qp + d0 * 16);
            f32x16 o0, o1; float mhat, lsum;
            wave_block<false>(qr, (lds_cptr)(F.lds + L_K), (lds_cptr)(F.lds + L_V), 4, 0, wsf, lane, o0, o1, mhat, lsum);
            stage_o(o0, o1, lsum, wsf, stg, lane);
            if (hi == 0 && idx < n) plse[((size_t)(e >> 13) * M + (size_t)(b * SEQ + tl)) * 16 + h] = mhat + __builtin_amdgcn_logf(lsum);
#pragma unroll
            for (int i = 0; i < 4; ++i) { const int row = i * 8 + (lane >> 3), ch = lane & 7, ix = g * 32 + row;
                if (ix < n) { const unsigned e2 = ql[ix]; const unsigned rk = e2 >> 13; const size_t t2 = (size_t)(b * SEQ) + (e2 & 8191u);
                    unsigned char* pb = (rk == 2u) ? (ws + WS_P2) : ((unsigned char*)P.out + (size_t)rk * PART_STRIDE);
                    *(u32x4*)(pb + (t2 * D + h * HD + ch * 8) * 2) = *(const LAS u32x4*)(stg + row * 64 + ch * 8); } }
            LDS_WAIT();
        }
        LDS_WAIT(); __syncthreads();
    }
}

__device__ __forceinline__ void p4_own_combine(Frame& F, const Ptrs& P) {
    using namespace moba;
    unsigned char* ws = P.ws; asm volatile("" : "+v"(ws));
    unsigned char* outp = (unsigned char*)P.out; asm volatile("" : "+v"(outp));
    const bf16* Q = (const bf16*)(ws + WS_Q); const bf16* K = (const bf16*)(ws + WS_K); const bf16* V = (const bf16*)(ws + WS_V); bf16* O = (bf16*)(ws + WS_AB);
    const float* plse = (const float*)(ws + WS_PLSE);
    const int lane = ((int)(threadIdx.x & 63u)), wid = F.wave, r32 = lane & 31, hi = lane >> 5, widv = ((int)threadIdx.x) >> 6;
    LAS float* wsf = (LAS float*)(F.lds + L_WS) + widv * 256; LAS unsigned short* stg = (LAS unsigned short*)(F.lds + L_STG) + widv * 2048;
    for (int unit = F.vcu; unit < BATCH * NH * NBLK; unit += F.G) {
        const int bh = unit >> 5, cur = unit & 31, b = bh >> 4, h = bh & 15;
        stage_kv(K, V, b, h, cur, F.lds, wid, lane);
        const size_t t0 = (size_t)b * SEQ + (size_t)cur * MB + widv * 32;
        const bf16* qp = Q + (t0 + r32) * D + h * HD + hi * 8;
        bf16x8 qr[4];
#pragma unroll
        for (int d0 = 0; d0 < 4; ++d0) qr[d0] = *(const bf16x8*)(qp + d0 * 16);
        f32x16 o0, o1; float mhat, lsum;
        wave_block<true>(qr, (lds_cptr)(F.lds + L_K), (lds_cptr)(F.lds + L_V), (wid >> 1) + 1, widv * 32 + r32, wsf, lane, o0, o1, mhat, lsum);
        stage_o(o0, o1, lsum, wsf, stg, lane);
        const int nv = cur < 3 ? cur : 3;
        { const float l0 = mhat + __builtin_amdgcn_logf(lsum); float lr[3]; float mx = l0;
#pragma unroll
          for (int r = 0; r < 3; ++r) { lr[r] = (r < nv) ? plse[((size_t)r * M + t0 + r32) * 16 + h] : -INFINITY; mx = __builtin_fmaxf(mx, lr[r]); }
          const float w0 = __builtin_amdgcn_exp2f(l0 - mx); float wr[3]; float ws_ = w0;
#pragma unroll
          for (int r = 0; r < 3; ++r) { wr[r] = __builtin_amdgcn_exp2f(lr[r] - mx); ws_ += wr[r]; }
          const float inv = 1.0f / ws_;
          if (hi == 0) { wsf[64 + r32 * 4] = w0 * inv; wsf[64 + r32 * 4 + 1] = wr[0] * inv; wsf[64 + r32 * 4 + 2] = wr[1] * inv; wsf[64 + r32 * 4 + 3] = wr[2] * inv; } }
        LDS_WAIT();
#pragma unroll
        for (int i = 0; i < 4; ++i) { const int row = i * 8 + (lane >> 3), ch = lane & 7; const size_t off = (t0 + row) * D + h * HD + ch * 8;
            const u32x4 ow = *(const LAS u32x4*)(stg + row * 64 + ch * 8); const float w0 = wsf[64 + row * 4];
            float a[8] = {w0 * bflo(ow.x), w0 * bfhi(ow.x), w0 * bflo(ow.y), w0 * bfhi(ow.y), w0 * bflo(ow.z), w0 * bfhi(ow.z), w0 * bflo(ow.w), w0 * bfhi(ow.w)};
#pragma unroll
            for (int r = 0; r < 3; ++r) if (r < nv) { const unsigned char* pb = (r == 2) ? (ws + WS_P2) : (outp + (size_t)r * PART_STRIDE);
                const u32x4 pw = *(const u32x4*)(pb + off * 2); const float w = wsf[64 + row * 4 + 1 + r];
                a[0] += w * bflo(pw.x); a[1] += w * bfhi(pw.x); a[2] += w * bflo(pw.y); a[3] += w * bfhi(pw.y); a[4] += w * bflo(pw.z); a[5] += w * bfhi(pw.z); a[6] += w * bflo(pw.w); a[7] += w * bfhi(pw.w); }
            v4u w; w.x = pk2(a[0], a[1]); w.y = pk2(a[2], a[3]); w.z = pk2(a[4], a[5]); w.w = pk2(a[6], a[7]); *(v4u*)(O + off) = w; }
        LDS_WAIT(); __syncthreads();
    }
}

namespace mls {
using namespace moba;
typedef float f32x4v __attribute__((ext_vector_type(4)));
constexpr int XTRA_OFF = LDSCTL_OFF + 512;
__device__ __forceinline__ float softcap_f(float g) { const float x = g * (1.0f / SOFTCAP); const float e = fexp(2.0f * x); return SOFTCAP * (e - 1.0f) / (e + 1.0f); }
__device__ __forceinline__ float logsigmoid_f(float f) { return fminf(f, 0.f) - __builtin_amdgcn_logf(1.0f + fexp(-fabsf(f))) * 0.6931471805599453f; }
__device__ __forceinline__ float scan_add(float v, int lane) {
#pragma unroll
    for (int o = 1; o < 64; o <<= 1) { const float t = __shfl_up(v, o); if (lane >= o) v += t; }
    return v; }
__device__ __forceinline__ float scan_max(float v, int lane) {
#pragma unroll
    for (int o = 1; o < 64; o <<= 1) { const float t = __shfl_up(v, o); if (lane >= o) v = fmaxf(v, t); }
    return v; }
__device__ __forceinline__ bf16x8 trfrag(lds_cptr p, int ks) { const s16x4 lo = vtr(p + ks * 1024), hi = vtr(p + ks * 1024 + 512); return (bf16x8){lo[0], lo[1], lo[2], lo[3], hi[0], hi[1], hi[2], hi[3]}; }
__device__ __forceinline__ v4u scale8(const v4u w, float s) { v4u o; o.x = cvtpk_s(bflo(w.x) * s, bfhi(w.x) * s); o.y = cvtpk_s(bflo(w.y) * s, bfhi(w.y) * s); o.z = cvtpk_s(bflo(w.z) * s, bfhi(w.z) * s); o.w = cvtpk_s(bflo(w.w) * s, bfhi(w.w) * s); return o; }
}

__device__ __forceinline__ void pa_mlstm_local(Frame& F, const Ptrs& P) {
    using namespace mls;
    unsigned char* ws = P.ws;
    const bf16* HB = (const bf16*)(ws + WS_AB); const bf16* MK = (const bf16*)(ws + WS_MK); const bf16* MV = (const bf16*)(ws + WS_MV);
    const bf16* WGb = (const bf16*)(ws + WS_WG); const float* ssq = (const float*)(ws + WS_SSQ) + (size_t)2 * M * 16;
    bf16* cloc = (bf16*)(ws + WS_CLOC); float* nloc = (float*)(ws + WS_NLOC); float* scal = (float*)(ws + WS_SCAL); float* BIG = (float*)(ws + WS_BIG);
    const int tid = (int)threadIdx.x, lane = tid & 63, wid = F.wave, r32 = lane & 31, hi = lane >> 5, fr = lane & 15, fq = lane >> 4;
    LAS float* gpart = (LAS float*)(F.lds + RING_OFF);
    LAS float* igA = (LAS float*)(F.lds + XTRA_OFF); LAS float* lfA = igA + 8 * 64;
    LAS unsigned char* kimg = F.lds + RING_OFF + wid * 16384; LAS unsigned char* vimg = kimg + 8192;
    const lds_cptr ktr = (lds_cptr)kimg + ((lane >> 4) & 1) * 32 + (lane & 3) * 8 + (4 * hi + ((lane & 15) >> 2)) * 64;
    const lds_cptr vtrp = ktr + 8192;
    for (int unit = F.vcu; unit < BATCH * NCH; unit += F.G) {
        const int b = unit >> 7, c = unit & 127; const size_t t0 = (size_t)b * SEQ + (size_t)c * LCH;
        {
            pg8::f32x4 acc[4];
#pragma unroll
            for (int m = 0; m < 4; ++m) acc[m] = (pg8::f32x4){0.f, 0.f, 0.f, 0.f};
#pragma unroll
            for (int ks = 0; ks < 4; ++ks) { const int k0 = wid * 128 + ks * 32 + fq * 8;
                const bf16x8 bw = *(const bf16x8*)(WGb + (size_t)fr * D + k0);
#pragma unroll
                for (int m = 0; m < 4; ++m) { const bf16x8 a = *(const bf16x8*)(HB + (t0 + m * 16 + fr) * D + k0); acc[m] = __builtin_amdgcn_mfma_f32_16x16x32_bf16(a, bw, acc[m], 0, 0, 0); } }
#pragma unroll
            for (int m = 0; m < 4; ++m)
#pragma unroll
                for (int r = 0; r < 4; ++r) gpart[(wid * 64 + m * 16 + 4 * fq + r) * 16 + fr] = acc[m][r];
        }
        LDS_WAIT(); __syncthreads();
#pragma unroll
        for (int e = 0; e < 2; ++e) { const int o = tid * 2 + e, row = o >> 4, col = o & 15; float s = 0.f;
#pragma unroll
            for (int w = 0; w < 8; ++w) s += gpart[(w * 64 + row) * 16 + col];
            const float val = softcap_f(s * pg8::row_rstd(ssq, (int)t0 + row) + P.b_gates[col]);
            if (col < 8) igA[col * 64 + row] = val; else lfA[(col - 8) * 64 + row] = logsigmoid_f(val); }
        LDS_WAIT(); __syncthreads();
        const int h = wid, mu = (b * MH + h) * NCH + c;
        const float ig = igA[h * 64 + lane], bcum = scan_add(lfA[h * 64 + lane], lane), bL = __shfl(bcum, 63);
        const float a = bL - bcum + ig, ml = wave_max(a), wgt = fexp(a - ml);
        BIG[(size_t)mu * 128 + lane] = bcum; BIG[(size_t)mu * 128 + 64 + lane] = ig;
        if (lane == 0) { scal[mu] = ml; scal[NUNIT + mu] = bL; }
        {
            const v4u* kp = (const v4u*)(MK + (t0 + lane) * 512 + h * DK);
#pragma unroll
            for (int ch = 0; ch < 8; ++ch) *(LAS v4u*)(kimg + (ch >> 2) * 4096 + lane * 64 + (ch & 3) * 16) = scale8(kp[ch], wgt);
        }
#pragma unroll 1
        for (int rv = 0; rv < 2; ++rv) {
            { const v4u* vp = (const v4u*)(MV + (t0 + lane) * 1024 + h * DV + rv * 64);
#pragma unroll
              for (int ch = 0; ch < 8; ++ch) *(LAS v4u*)(vimg + (ch >> 2) * 4096 + lane * 64 + (ch & 3) * 16) = vp[ch]; }
            LDS_WAIT();
#pragma unroll
            for (int kt = 0; kt < 2; ++kt) {
                bf16x8 af[4];
#pragma unroll
                for (int ks = 0; ks < 4; ++ks) af[ks] = trfrag(ktr + kt * 4096, ks);
#pragma unroll
                for (int vt = 0; vt < 2; ++vt) {
                    f32x16 d = f32x16{};
#pragma unroll
                    for (int ks = 0; ks < 4; ++ks) d = MOBA_MFMA(af[ks], trfrag(vtrp + vt * 4096, ks), d);
                    bf16* cp = cloc + (size_t)mu * 8192 + (size_t)(rv * 64 + vt * 32 + r32) * 64 + kt * 32 + 4 * hi;
#pragma unroll
                    for (int g = 0; g < 4; ++g) { uint2 w; w.x = cvtpk_s(d[4 * g], d[4 * g + 1]); w.y = cvtpk_s(d[4 * g + 2], d[4 * g + 3]); *(uint2*)(cp + 8 * g) = w; }
                }
                if (rv == 0) {
                    const bf16x8 ones = (bf16x8){0x3F80, 0x3F80, 0x3F80, 0x3F80, 0x3F80, 0x3F80, 0x3F80, 0x3F80};
                    f32x16 d = f32x16{};
#pragma unroll
                    for (int ks = 0; ks < 4; ++ks) d = MOBA_MFMA(af[ks], ones, d);
                    if (r32 == 0) {
#pragma unroll
                        for (int r = 0; r < 16; ++r) nloc[(size_t)mu * 64 + kt * 32 + crow(r, hi)] = d[r]; }
                }
            }
            LDS_WAIT();
        }
        LDS_WAIT(); __syncthreads();
    }
}
__device__ __forceinline__ void pb_mlstm_scan(Frame& F, const Ptrs& P) {
    unsigned char* ws = P.ws;
    bf16* cloc = (bf16*)(ws + WS_CLOC); float* nloc = (float*)(ws + WS_NLOC); float* scal = (float*)(ws + WS_SCAL);
    LAS float* dec = (LAS float*)(F.lds + RING_OFF); LAS float* scl = dec + NCH;
    const int tid = (int)threadIdx.x;
    for (int unit = F.vcu; unit < BATCH * MH * 16; unit += F.G) {
        const int bh = unit >> 4, sl = unit & 15;
        if (tid < 64) {
            float mp = 0.f;
            for (int c = 0; c < NCH; ++c) { const int mu = bh * NCH + c; const float ml = scal[mu], bl = scal[NUNIT + mu];
                const float mn = fmaxf(bl + mp, ml);
                if (tid == 0) { dec[c] = fexp(bl + mp - mn); scl[c] = fexp(ml - mn); if (sl == 0) scal[2 * NUNIT + mu] = mp; }
                mp = mn; }
        }
        LDS_WAIT(); __syncthreads();
        { bf16* p = cloc + (size_t)bh * NCH * 8192 + sl * 512 + tid; float st = 0.f;
#pragma unroll 1
          for (int c0 = 0; c0 < NCH; c0 += 16) { unsigned short x[16];
#pragma unroll
              for (int i = 0; i < 16; ++i) x[i] = p[(size_t)(c0 + i) * 8192];
#pragma unroll
              for (int i = 0; i < 16; ++i) { p[(size_t)(c0 + i) * 8192] = (bf16)f2bf(st); st = dec[c0 + i] * st + scl[c0 + i] * bf2f(x[i]); } } }
        if (sl == 0 && tid < 64) { float* p = nloc + (size_t)bh * NCH * 64 + tid; float st = 0.f;
#pragma unroll 1
            for (int c0 = 0; c0 < NCH; c0 += 16) { float x[16];
#pragma unroll
                for (int i = 0; i < 16; ++i) x[i] = p[(size_t)(c0 + i) * 64];
#pragma unroll
                for (int i = 0; i < 16; ++i) { p[(size_t)(c0 + i) * 64] = st; st = dec[c0 + i] * st + scl[c0 + i] * x[i]; } } }
        LDS_WAIT(); __syncthreads();
    }
}
__device__ __forceinline__ void pc_mlstm_out(Frame& F, const Ptrs& P) {
    using namespace mls;
    unsigned char* ws = P.ws;
    const bf16* MQ = (const bf16*)(ws + WS_MQ); const bf16* MK = (const bf16*)(ws + WS_MK); const bf16* MV = (const bf16*)(ws + WS_MV); const bf16* OG = (const bf16*)(ws + WS_OG);
    const bf16* cin = (const bf16*)(ws + WS_CLOC); const float* nin = (const float*)(ws + WS_NLOC); const float* scal = (const float*)(ws + WS_SCAL); const float* BIG = (const float*)(ws + WS_BIG);
    bf16* Y = (bf16*)(ws + WS_AB);
    const int tid = (int)threadIdx.x, lane = tid & 63, wid = F.wave, r32 = lane & 31, hi = lane >> 5, qg = wid & 1, vt = wid >> 1;
    constexpr int LK = 0, LV = 8192, LH = 24576, HP = 132;
    LAS float* hst = (LAS float*)(F.lds + RING_OFF + LH);
    LAS float* garr = (LAS float*)(F.lds + mls::XTRA_OFF); LAS float* mmarr = garr + 64; LAS float* barr = mmarr + 64; LAS float* nn = barr + 64; LAS float* wsf = nn + 64 + wid * 64;
    const lds_cptr kp0 = (lds_cptr)(F.lds + RING_OFF + LK) + hi * 1024 + r32 * 16;
    const lds_cptr vp0 = (lds_cptr)(F.lds + RING_OFF + LV) + vt * 4096 + ((lane >> 4) & 1) * 32 + (lane & 3) * 8 + (4 * hi + ((lane & 15) >> 2)) * 64;
    for (int unit = F.vcu; unit < NUNIT; unit += F.G) {
        const int bh = unit >> 7, c = unit & 127, b = bh >> 3, h = bh & 7; const size_t t0 = (size_t)b * SEQ + (size_t)c * LCH;
        const float m_in = scal[2 * NUNIT + unit];
        {
            const unsigned lds0 = (unsigned)(uintptr_t)(F.lds + RING_OFF);
            glds16(MK + (t0 + lane) * 512 + h * DK + wid * 8, (unsigned)__builtin_amdgcn_readfirstlane(lds0 + LK + wid * 1024));
#pragma unroll
            for (int i = 0; i < 2; ++i) { const int p = wid + 8 * i;
                glds16(MV + (t0 + 16 * (p & 3) + (lane >> 2)) * 1024 + h * DV + (p >> 2) * 32 + (lane & 3) * 8, (unsigned)__builtin_amdgcn_readfirstlane(lds0 + LV + p * 1024)); }
        }
        if (wid == 0) {
            const float bc = BIG[(size_t)unit * 128 + lane], g = BIG[(size_t)unit * 128 + 64 + lane] - bc;
            garr[lane] = g; mmarr[lane] = fmaxf(m_in, scan_max(g, lane)); barr[lane] = bc; nn[lane] = nin[(size_t)unit * 64 + lane];
        }
        asm volatile("s_waitcnt vmcnt(0) lgkmcnt(0)\n\ts_barrier" ::: "memory");
        {
            const int l = qg * 32 + r32;
            const bf16* qp = MQ + (t0 + l) * 512 + h * DK + hi * 8;
            bf16x8 qr[4], cf[4];
#pragma unroll
            for (int d0 = 0; d0 < 4; ++d0) qr[d0] = *(const bf16x8*)(qp + d0 * 16);
            const bf16* cp = cin + (size_t)unit * 8192 + (size_t)(vt * 32 + r32) * 64 + hi * 8;
#pragma unroll
            for (int d0 = 0; d0 < 4; ++d0) cf[d0] = *(const bf16x8*)(cp + d0 * 16);
            bf16x8 kf[8];
#pragma unroll
            for (int d0 = 0; d0 < 4; ++d0) { kf[2 * d0] = *(const LAS bf16x8*)(kp0 + d0 * 2048); kf[2 * d0 + 1] = *(const LAS bf16x8*)(kp0 + d0 * 2048 + 512); }
            f32x16 c0 = f32x16{}, c1 = f32x16{};
#pragma unroll
            for (int d0 = 0; d0 < 4; ++d0) { c0 = MOBA_MFMA(kf[2 * d0], qr[d0], c0); c1 = MOBA_MFMA(kf[2 * d0 + 1], qr[d0], c1); }
            const float mml = mmarr[l];
            float rsum = 0.f;
#pragma unroll
            for (int r = 0; r < 16; ++r) { const int s0 = crow(r, hi), s1 = s0 + 32;
                const float e0 = __builtin_amdgcn_exp2f((garr[s0] - mml) * LOG2E), e1 = __builtin_amdgcn_exp2f((garr[s1] - mml) * LOG2E);
                c0[r] = (s0 <= l) ? c0[r] * e0 : 0.f; c1[r] = (s1 <= l) ? c1[r] * e1 : 0.f; rsum += c0[r] + c1[r]; }
            rsum = halves_sum(rsum);
            float qn = 0.f;
#pragma unroll
            for (int d0 = 0; d0 < 4; ++d0)
#pragma unroll
                for (int j = 0; j < 8; ++j) qn += bf2f((unsigned short)qr[d0][j]) * nn[d0 * 16 + hi * 8 + j];
            qn = halves_sum(qn);
            const float inter = fexp(m_in - mml), den = inter * qn + rsum, rd = 1.0f / fmaxf(fabsf(den), fexp(-(barr[l] + mml)));
            if (hi == 0) { wsf[r32] = inter; wsf[32 + r32] = rd; }
            f32x16 o = f32x16{};
#pragma unroll
            for (int d0 = 0; d0 < 4; ++d0) o = MOBA_MFMA(qr[d0], cf[d0], o);
            asm volatile("s_waitcnt lgkmcnt(0)" ::: "memory");
#pragma unroll
            for (int r = 0; r < 16; ++r) o[r] *= wsf[crow(r, hi)];
            u32x4 pw0, pw1, pw2, pw3;
            pw0 = (u32x4){cvtpk_s(c0[0], c0[1]), cvtpk_s(c0[2], c0[3]), cvtpk_s(c0[4], c0[5]), cvtpk_s(c0[6], c0[7])}; pw1 = (u32x4){cvtpk_s(c0[8], c0[9]), cvtpk_s(c0[10], c0[11]), cvtpk_s(c0[12], c0[13]), cvtpk_s(c0[14], c0[15])};
            pw2 = (u32x4){cvtpk_s(c1[0], c1[1]), cvtpk_s(c1[2], c1[3]), cvtpk_s(c1[4], c1[5]), cvtpk_s(c1[6], c1[7])}; pw3 = (u32x4){cvtpk_s(c1[8], c1[9]), cvtpk_s(c1[10], c1[11]), cvtpk_s(c1[12], c1[13]), cvtpk_s(c1[14], c1[15])};
            o = MOBA_MFMA(__builtin_bit_cast(bf16x8, pw0), trfrag(vp0, 0), o); o = MOBA_MFMA(__builtin_bit_cast(bf16x8, pw1), trfrag(vp0, 1), o);
            o = MOBA_MFMA(__builtin_bit_cast(bf16x8, pw2), trfrag(vp0, 2), o); o = MOBA_MFMA(__builtin_bit_cast(bf16x8, pw3), trfrag(vp0, 3), o);
#pragma unroll
            for (int r = 0; r < 16; ++r) hst[(qg * 32 + crow(r, hi)) * HP + vt * 32 + r32] = o[r] * wsf[32 + crow(r, hi)];
        }
        LDS_WAIT(); __syncthreads();
        {
            const int l = tid >> 3, vb = (tid & 7) * 16; float hv[16]; float ss = 0.f;
#pragma unroll
            for (int j = 0; j < 4; ++j) { const mls::f32x4v x = *(const LAS mls::f32x4v*)(hst + l * HP + vb + 4 * j); hv[4 * j] = x.x; hv[4 * j + 1] = x.y; hv[4 * j + 2] = x.z; hv[4 * j + 3] = x.w; ss += (x.x * x.x + x.y * x.y) + (x.z * x.z + x.w * x.w); }
            ss += __shfl_xor(ss, 1); ss += __shfl_xor(ss, 2); ss += __shfl_xor(ss, 4);
            const float r = __builtin_amdgcn_rsqf(ss * (1.0f / 128.0f) + RMS_EPS);
            const size_t off = (t0 + l) * D + h * DV + vb; const v4u* gp = (const v4u*)(OG + off); const f32x4* np = (const f32x4*)(P.head_norm + h * DV + vb);
            float y[16];
#pragma unroll
            for (int i = 0; i < 2; ++i) { const v4u u = gp[i]; const f32x4 n0 = np[2 * i], n1 = np[2 * i + 1];
                y[8 * i] = bflo(u.x) * hv[8 * i] * r * n0.x; y[8 * i + 1] = bfhi(u.x) * hv[8 * i + 1] * r * n0.y; y[8 * i + 2] = bflo(u.y) * hv[8 * i + 2] * r * n0.z; y[8 * i + 3] = bfhi(u.y) * hv[8 * i + 3] * r * n0.w;
                y[8 * i + 4] = bflo(u.z) * hv[8 * i + 4] * r * n1.x; y[8 * i + 5] = bfhi(u.z) * hv[8 * i + 5] * r * n1.y; y[8 * i + 6] = bflo(u.w) * hv[8 * i + 6] * r * n1.z; y[8 * i + 7] = bfhi(u.w) * hv[8 * i + 7] * r * n1.w; }
            v4u* yp = (v4u*)(Y + off);
#pragma unroll
            for (int i = 0; i < 2; ++i) { v4u o; o.x = pk2(y[8 * i], y[8 * i + 1]); o.y = pk2(y[8 * i + 2], y[8 * i + 3]); o.z = pk2(y[8 * i + 4], y[8 * i + 5]); o.w = pk2(y[8 * i + 6], y[8 * i + 7]); yp[i] = o; }
        }
        LDS_WAIT(); __syncthreads();
    }
}
__device__ __forceinline__ void p_final_norm(Frame& F, const Ptrs& P) {
    const int gw = F.vcu * NWAVES + F.wave, NGW = F.G * NWAVES;
    const f32x4* wn = (const f32x4*)P.final_norm + ((int)(threadIdx.x & 63u));
    for (int m = gw; m < M; m += NGW) {
        GAS f32x4* xr = (GAS f32x4*)(P.out + (size_t)m * D) + ((int)(threadIdx.x & 63u)); f32x4 v[4]; float s = 0.f;
#pragma unroll
        for (int j = 0; j < 4; ++j) { v[j] = xr[64 * j]; s += (v[j].x * v[j].x + v[j].y * v[j].y) + (v[j].z * v[j].z + v[j].w * v[j].w); }
        const float r = __builtin_amdgcn_rsqf(wave_sum(s) * (1.0f / D) + RMS_EPS);
#pragma unroll
        for (int j = 0; j < 4; ++j) xr[64 * j] = v[j] * r * wn[64 * j];
    }
}

struct Args { Ptrs p; };
__device__ __forceinline__ Ptrs load_ptrs() {
#if defined(__HIP_DEVICE_COMPILE__)
    typedef __attribute__((address_space(4))) const unsigned long long* kptr_t;
    kptr_t kp = (kptr_t)__builtin_amdgcn_kernarg_segment_ptr();
    asm volatile("" : "+s"(kp));
    Ptrs p;
    p.x = (const float*)kp[0]; p.attn_norm = (const float*)kp[1]; p.w_qkv = (const float*)kp[2]; p.w_o = (const float*)kp[3]; p.mlstm_norm = (const float*)kp[4]; p.w_in = (const float*)kp[5];
    p.b_gates = (const float*)kp[6]; p.head_norm = (const float*)kp[7]; p.w_out = (const float*)kp[8]; p.ffn_norm = (const float*)kp[9]; p.w_gu = (const float*)kp[10]; p.w_down = (const float*)kp[11];
    p.final_norm = (const float*)kp[12]; p.out = (float*)kp[13]; p.ws = (unsigned char*)kp[14];
    return p;
#else
    return Ptrs{};
#endif
}
__global__ void __launch_bounds__(NWAVES * 64, 2) mk_fwd(Args args) {
    extern __shared__ __attribute__((aligned(16))) unsigned char lds[];
    Frame F;
    F.lds = (LAS unsigned char*)lds;
    F.MISC = (volatile LAS unsigned*)(F.lds + MISC_OFF);
    F.wave = __builtin_amdgcn_readfirstlane((int)threadIdx.x >> 6);
    F.G = gridDim.x; { const int bx = blockIdx.x; F.vcu = (F.G % 8 == 0) ? (bx % 8) * (F.G / 8) + bx / 8 : bx; }
    F.ctl = (gu32*)(args.p.ws + WS_CTL);
    for (int u = ((int)threadIdx.x); u < (LDS_BYTES - LDSCTL_OFF) / 4; u += NWAVES * 64) ((LAS unsigned*)(F.lds + LDSCTL_OFF))[u] = 0u;
    __syncthreads();
    XcdBarrier bar = xcd_barrier_post((unsigned*)(F.ctl + CW_BAR), F.MISC + 8);
#define GRID_BAR() xcd_barrier(bar)
#ifndef PH_MASK
#define PH_MASK 0xFFFFF
#endif
#define PH(k) ((PH_MASK >> (k)) & 1)
#define PHASE_PTRS() const Ptrs P = load_ptrs(); unsigned char* const ws = P.ws; (void)ws
#define SSQ(i) ((float*)(ws + WS_SSQ) + (size_t)(i) * M * 16)

    if (PH(0)) { PHASE_PTRS(); p0_prologue(F, P); } GRID_BAR();
    if (PH(1)) { PHASE_PTRS(); pg8::Gemm g{(const bf16*)(ws + WS_AB), (const bf16*)(ws + WS_WQKV), M, 3 * D, D}; pg8::StaticOrder S; S.init(M, 3 * D, F.G, (int)blockIdx.x);
      pg8::EpiQKV E{(bf16*)(ws + WS_Q), (size_t)(WS_K - WS_Q) / 2, SSQ(0), (const float*)(ws + WS_ROPE), (float*)(ws + WS_KMEAN)};
      pg8::gemm_phase<pg8::EpiQKV, pg8::StaticOrder, PG8_ALIGN, PG8_SP2>(F.lds + RING_OFF, g, S, E); } GRID_BAR();
    if (PH(2)) { PHASE_PTRS(); p2_gating(F, P); } GRID_BAR();
    if (PH(3)) { PHASE_PTRS(); p3_gathered(F, P); } GRID_BAR();
    if (PH(15)) { PHASE_PTRS(); p4_own_combine(F, P); } GRID_BAR();
    if (PH(4)) { PHASE_PTRS(); pg8::Gemm g{(const bf16*)(ws + WS_AB), (const bf16*)(ws + WS_WO), M, D, D}; pg8::StaticOrder S; S.init(M, D, F.G, (int)blockIdx.x);
      pg8::EpiRes<true> E{P.x, P.out, (bf16*)(ws + WS_HB1), SSQ(1)};
      pg8::gemm_phase<pg8::EpiRes<true>, pg8::StaticOrder, PG8_ALIGN, PG8_SP2>(F.lds + RING_OFF, g, S, E); } GRID_BAR();
    if (PH(5)) { PHASE_PTRS(); pg8::Gemm g{(const bf16*)(ws + WS_HB1), (const bf16*)(ws + WS_WGU), M, NGU, D}; pg8::StaticOrder S; S.init(M, NGU, F.G, (int)blockIdx.x);
      pg8::EpiSwiGLU E{(bf16*)(ws + WS_ACT), SSQ(1)};
      pg8::gemm_phase<pg8::EpiSwiGLU, pg8::StaticOrder, PG8_ALIGN, PG8_SP2>(F.lds + RING_OFF, g, S, E); } GRID_BAR();
    if (PH(6)) { PHASE_PTRS(); pg8::Gemm g{(const bf16*)(ws + WS_ACT), (const bf16*)(ws + WS_WD), M, D, DFF}; pg8::StaticOrder S; S.init(M, D, F.G, (int)blockIdx.x);
      pg8::EpiRes<true> E{P.out, P.out, (bf16*)(ws + WS_AB), SSQ(2)};
      pg8::gemm_phase<pg8::EpiRes<true>, pg8::StaticOrder, PG8_ALIGN, PG8_SP2>(F.lds + RING_OFF, g, S, E); } GRID_BAR();
    if (PH(7)) { PHASE_PTRS(); pg8::Gemm g{(const bf16*)(ws + WS_AB), (const bf16*)(ws + WS_WIN), M, NIN, D}; pg8::StaticOrder S; S.init(M, NIN, F.G, (int)blockIdx.x);
      pg8::EpiMlstmIn E{(bf16*)(ws + WS_MQ), (bf16*)(ws + WS_MK), (bf16*)(ws + WS_MV), (bf16*)(ws + WS_OG), SSQ(2)};
      pg8::gemm_phase<pg8::EpiMlstmIn, pg8::StaticOrder, PG8_ALIGN, PG8_SP2>(F.lds + RING_OFF, g, S, E); } GRID_BAR();
    if (PH(8)) { PHASE_PTRS(); pa_mlstm_local(F, P); } GRID_BAR();
    if (PH(9)) { PHASE_PTRS(); pb_mlstm_scan(F, P); } GRID_BAR();
    if (PH(10)) { PHASE_PTRS(); pc_mlstm_out(F, P); } GRID_BAR();
    if (PH(11)) { PHASE_PTRS(); pg8::Gemm g{(const bf16*)(ws + WS_AB), (const bf16*)(ws + WS_WOUT), M, D, D}; pg8::StaticOrder S; S.init(M, D, F.G, (int)blockIdx.x);
      pg8::EpiRes<true> E{P.out, P.out, (bf16*)(ws + WS_HB1), SSQ(3)};
      pg8::gemm_phase<pg8::EpiRes<true>, pg8::StaticOrder, PG8_ALIGN, PG8_SP2>(F.lds + RING_OFF, g, S, E); } GRID_BAR();
    if (PH(12)) { PHASE_PTRS(); pg8::Gemm g{(const bf16*)(ws + WS_HB1), (const bf16*)(ws + WS_WGU) + (size_t)NGU * D, M, NGU, D}; pg8::StaticOrder S; S.init(M, NGU, F.G, (int)blockIdx.x);
      pg8::EpiSwiGLU E{(bf16*)(ws + WS_ACT), SSQ(3)};
      pg8::gemm_phase<pg8::EpiSwiGLU, pg8::StaticOrder, PG8_ALIGN, PG8_SP2>(F.lds + RING_OFF, g, S, E); } GRID_BAR();
    if (PH(13)) { PHASE_PTRS(); pg8::Gemm g{(const bf16*)(ws + WS_ACT), (const bf16*)(ws + WS_WD) + (size_t)D * DFF, M, D, DFF}; pg8::StaticOrder S; S.init(M, D, F.G, (int)blockIdx.x);
      pg8::EpiRes<false> E{P.out, P.out, nullptr, nullptr};
      pg8::gemm_phase<pg8::EpiRes<false>, pg8::StaticOrder, PG8_ALIGN, PG8_SP2>(F.lds + RING_OFF, g, S, E); } GRID_BAR();
    if (PH(14)) { PHASE_PTRS(); p_final_norm(F, P); }
}

extern "C" void kernel_launch(void* const* d_in, const int* in_sizes, int n_in, void* d_out, int out_size, void* d_ws, size_t ws_size, hipStream_t stream) {
    static int grid = 0;
    if (grid == 0) {
        if (n_in != 13 || in_sizes[0] != M * D || out_size != M * D || ws_size < WS_END) { fprintf(stderr, "kernel_launch: unexpected shapes (n_in %d, in0 %d, out %d, ws %zu); nothing launched\n", n_in, n_in > 0 ? in_sizes[0] : -1, out_size, ws_size); grid = -1; return; }
        int dev = 0, cus = 0, per_cu = 0;
        if (hipGetDevice(&dev) != hipSuccess || hipDeviceGetAttribute(&cus, hipDeviceAttributeMultiprocessorCount, dev) != hipSuccess) { grid = -1; return; }
        if (hipFuncSetAttribute((const void*)mk_fwd, hipFuncAttributeMaxDynamicSharedMemorySize, LDS_BYTES) != hipSuccess) { fprintf(stderr, "kernel_launch: hipFuncSetAttribute failed\n"); grid = -1; return; }
        if (hipOccupancyMaxActiveBlocksPerMultiprocessor(&per_cu, (const void*)mk_fwd, NWAVES * 64, LDS_BYTES) != hipSuccess || per_cu < 1) { fprintf(stderr, "kernel_launch: occupancy query reports %d blocks per CU\n", per_cu); }
        (void)hipGetLastError();
        grid = cus;
    }
    if (grid < 0) return;
    if (hipMemsetAsync((char*)d_ws + WS_CTL, 0, CTL_ZERO_BYTES, stream) != hipSuccess) { fprintf(stderr, "kernel_launch: hipMemsetAsync failed\n"); return; }
    Args a{};
    a.p.x = (const float*)d_in[0]; a.p.attn_norm = (const float*)d_in[1]; a.p.w_qkv = (const float*)d_in[2]; a.p.w_o = (const float*)d_in[3];
    a.p.mlstm_norm = (const float*)d_in[4]; a.p.w_in = (const float*)d_in[5]; a.p.b_gates = (const float*)d_in[6]; a.p.head_norm = (const float*)d_in[7]; a.p.w_out = (const float*)d_in[8];
    a.p.ffn_norm = (const float*)d_in[9]; a.p.w_gu = (const float*)d_in[10]; a.p.w_down = (const float*)d_in[11]; a.p.final_norm = (const float*)d_in[12];
    a.p.out = (float*)d_out; a.p.ws = (unsigned char*)d_ws;
    hipLaunchKernelGGL(mk_fwd, dim3(grid), dim3(NWAVES * 64), LDS_BYTES, stream, a);
    const hipError_t le = hipPeekAtLastError();
    if (le != hipSuccess) fprintf(stderr, "kernel_launch: launch failed: %s\n", hipGetErrorName(le));
}
```

```cpp
#include <hip/hip_runtime.h>
#include <cstdio>
#include <cstdint>
namespace pg8 {
#define PG8_LAS __attribute__((address_space(3)))
typedef unsigned short bf16_t;
typedef short bf16x8 __attribute__((ext_vector_type(8)));
typedef float f32x4 __attribute__((ext_vector_type(4)));
typedef unsigned u32x4 __attribute__((ext_vector_type(4)));
constexpr int BM = 256, BK = 64, HALF = 128, HTB = HALF * BK * 2  , STAGE_BYTES = 8 * HTB, NXCD = 8, WGM = 8;

__host__ __device__ __forceinline__ int lds_byte(int r, int c) { const int st = (r >> 4) * 2 + (c >> 5), rr = r & 15, cc = c & 31, ob = rr * 64 + cc * 2; return st * 1024 + (ob ^ (((ob >> 9) & 1) << 5)); }
__host__ __device__ __forceinline__ void stage_rc(int b, int& R, int& C) { const int st = b / 1024, sb = b % 1024, swz = sb ^ (((sb >> 9) & 1) << 5); R = (st >> 1) * 16 + swz / 64; C = (st & 1) * 32 + (swz % 64) / 2; }
__host__ __device__ __forceinline__ int perm32(int rho) { const int n = rho >> 4, i = rho & 15; return 8 * (i >> 2) + 4 * n + (i & 3); }

struct Unit { int pm, pn; };
struct Gemm { const bf16_t* A; const bf16_t* Bt; int M, N, K; };

struct StaticOrder {
    int nM, nN, nwg, G, c;
    __host__ __device__ void init(int M, int N, int G_, int c_) { nM = M / BM; nN = N / BM; nwg = nM * nN; G = G_; c = c_; }
    __host__ __device__ bool next(int i, Unit& u) const {
        const long L = (long)i * G + c; if (L >= nwg) return false;
        int wgid = (int)L; { const int q = nwg / NXCD, r = nwg % NXCD, xcd = wgid % NXCD, off = wgid / NXCD; wgid = (xcd < r ? xcd * (q + 1) : r * (q + 1) + (xcd - r) * q) + off; }
        const int nig = WGM * nN, gid = wgid / nig, fm = gid * WGM, gsz = (nM - fm) < WGM ? (nM - fm) : WGM;
        u.pm = fm + ((wgid % nig) % gsz); u.pn = (wgid % nig) / gsz; return true;
    }
    __device__ __forceinline__ void a_ready(const Unit&) const {}
    __device__ __forceinline__ void done(const Unit&) const {}
};
__device__ __forceinline__ unsigned cvt_pk_bf16(float lo, float hi) { unsigned r; asm volatile("v_cvt_pk_bf16_f32 %0, %1, %2" : "=v"(r) : "v"(lo), "v"(hi)); return r; }
typedef float f32x2 __attribute__((ext_vector_type(2)));
constexpr float RMS_EPS_F = 1e-6f;
constexpr float QSCALE_LOG2 = 0.18033688011112042f;
__device__ __forceinline__ float row_rstd(const float* ssq, int row) {
    const f32x4* p = (const f32x4*)(ssq + (size_t)row * 16);
    const f32x4 a = p[0], b = p[1], c = p[2], d = p[3];
    const float s = (((a[0] + a[1]) + (a[2] + a[3])) + ((b[0] + b[1]) + (b[2] + b[3]))) + (((c[0] + c[1]) + (c[2] + c[3])) + ((d[0] + d[1]) + (d[2] + d[3])));
    return __builtin_amdgcn_rsqf(s * (1.0f / 1024.0f) + RMS_EPS_F);
}
__device__ __forceinline__ u32x4 pack8(const f32x4& v0, const f32x4& v1) { u32x4 w; w.x = cvt_pk_bf16(v0[0], v0[1]); w.y = cvt_pk_bf16(v0[2], v0[3]); w.z = cvt_pk_bf16(v1[0], v1[1]); w.w = cvt_pk_bf16(v1[2], v1[3]); return w; }

struct EpiQKV {
    static constexpr bool PERM = true, AFTER_DRAIN = false;
    bf16_t* QKV; size_t tstride; const float* ssq; const float* rope; float* kmean;
    __device__ __forceinline__ void operator()(const f32x4 (&acc)[2][2][4][2], const Unit& u, int wr, int wc, int fr, int fq) const {
        const int t = u.pn >> 2;
        bf16_t* base = QKV + (size_t)t * tstride;
        const int col0 = (u.pn & 3) * BM + wc * 32 + 8 * fq;
        const bool rot = (t < 2) && ((wc & 1) == 0) && (fq < 2);
        const float sc = (t == 0) ? QSCALE_LOG2 : 1.0f;
        const int lane = fq * 16 + fr;
        float rv[2];
#pragma unroll
        for (int ai = 0; ai < 2; ++ai) rv[ai] = row_rstd(ssq, u.pm * BM + ai * HALF + wr * 64 + lane);
#pragma unroll
        for (int bj = 0; bj < 2; ++bj) {
            f32x4 ks0 = (f32x4){0.f, 0.f, 0.f, 0.f}, ks1 = ks0;
#pragma unroll
            for (int ai = 0; ai < 2; ++ai)
#pragma unroll
                for (int m = 0; m < 4; ++m) {
                    const int row = u.pm * BM + ai * HALF + wr * 64 + m * 16 + fr;
                    const float rs = __shfl(rv[ai], m * 16 + fr);
                    f32x4 v0 = acc[ai][bj][m][0] * rs, v1 = acc[ai][bj][m][1] * rs;
                    if (rot) { const f32x4* rp = (const f32x4*)(rope + (size_t)(row & 8191) * 16 + 8 * fq); const f32x4 cs0 = rp[0], cs1 = rp[1];
                        const f32x4 c = (f32x4){cs0[0], cs0[2], cs1[0], cs1[2]}, s = (f32x4){cs0[1], cs0[3], cs1[1], cs1[3]};
                        const f32x4 x1 = v0, x2 = v1; v0 = x1 * c - x2 * s; v1 = x2 * c + x1 * s; }
                    if (t == 1) { ks0 += v0; ks1 += v1; }
                    v0 = v0 * sc; v1 = v1 * sc;
                    *(u32x4*)(base + (size_t)row * 1024 + col0 + bj * HALF) = pack8(v0, v1);
                    asm volatile("" ::: "memory");
                }
            if (t == 1) {
                float* km = kmean + (size_t)u.pm * 1024 + col0 + bj * HALF;
#pragma unroll
                for (int j = 0; j < 4; ++j) {
                    float r0 = ks0[j]; r0 += __shfl_xor(r0, 1); r0 += __shfl_xor(r0, 2); r0 += __shfl_xor(r0, 4); r0 += __shfl_xor(r0, 8);
                    float r1 = ks1[j]; r1 += __shfl_xor(r1, 1); r1 += __shfl_xor(r1, 2); r1 += __shfl_xor(r1, 4); r1 += __shfl_xor(r1, 8);
                    if (fr == 0) { atomicAdd(km + j, r0 * (1.0f / 256.0f)); atomicAdd(km + 4 + j, r1 * (1.0f / 256.0f)); }
                }
            }
        }
    }
};

template <bool WRITE_HB> struct EpiRes {
    static constexpr bool PERM = true, AFTER_DRAIN = false;
    const float* base; float* out; bf16_t* hb; float* ssq_out; int live;
    __device__ __forceinline__ void operator()(const f32x4 (&acc)[2][2][4][2], const Unit& u, int wr, int wc, int fr, int fq) const {
        const int col0 = u.pn * BM + wc * 32 + 8 * fq;
#pragma unroll
        for (int ai = 0; ai < 2; ++ai)
#pragma unroll
            for (int m = 0; m < 4; ++m) {
                const int row = u.pm * BM + ai * HALF + wr * 64 + m * 16 + fr;
                float ss = 0.f;
#pragma unroll
                for (int bj = 0; bj < 2; ++bj) {
                    const size_t off = (size_t)row * 1024 + col0 + bj * HALF;
                    const f32x4 b0 = *(const f32x4*)(base + off), b1 = *(const f32x4*)(base + off + 4);
                    const f32x4 v0 = acc[ai][bj][m][0] + b0, v1 = acc[ai][bj][m][1] + b1;
                    if (live) { *(f32x4*)(out + off) = v0; *(f32x4*)(out + off + 4) = v1; }
                    ss += ((v0[0] * v0[0] + v0[1] * v0[1]) + (v0[2] * v0[2] + v0[3] * v0[3])) + ((v1[0] * v1[0] + v1[1] * v1[1]) + (v1[2] * v1[2] + v1[3] * v1[3]));
                    if (WRITE_HB && live) *(u32x4*)(hb + off) = pack8(v0, v1);
                }
                if (WRITE_HB) { ss += __shfl_xor(ss, 16); ss += __shfl_xor(ss, 32); if (fq == 0 && live) ssq_out[(size_t)row * 16 + u.pn * 4 + wc] = ss; }
            }
    }
};

struct EpiSwiGLU {
    static constexpr bool PERM = true, AFTER_DRAIN = false;
    bf16_t* act; const float* ssq;
    __device__ __forceinline__ void operator()(const f32x4 (&acc)[2][2][4][2], const Unit& u, int wr, int wc, int fr, int fq) const {
        const int col0 = u.pn * HALF + wc * 32 + 8 * fq;
#pragma unroll
        for (int ai = 0; ai < 2; ++ai)
#pragma unroll
            for (int m = 0; m < 4; ++m) {
                const int row = u.pm * BM + ai * HALF + wr * 64 + m * 16 + fr;
                const float rs = row_rstd(ssq, row);
                f32x4 o[2];
#pragma unroll
                for (int n = 0; n < 2; ++n) {
                    const f32x4 g = acc[ai][0][m][n] * rs, up = acc[ai][1][m][n] * rs;
#pragma unroll
                    for (int j = 0; j < 4; ++j) { const float e = __builtin_amdgcn_exp2f(g[j] * -1.4426950408889634f); o[n][j] = g[j] * up[j] * __builtin_amdgcn_rcpf(1.0f + e); }
                }
                *(u32x4*)(act + (size_t)row * 2816 + col0) = pack8(o[0], o[1]);
            }
    }
};

struct EpiMlstmIn {
    static constexpr bool PERM = true, AFTER_DRAIN = false;
    bf16_t* MQ; bf16_t* MK; bf16_t* MV; bf16_t* OG; const float* ssq;
    __device__ __forceinline__ void operator()(const f32x4 (&acc)[2][2][4][2], const Unit& u, int wr, int wc, int fr, int fq) const {
        bf16_t* base; int ld, colt; float sc = 1.0f; bool sig = false;
        if (u.pn < 2) { base = MQ; ld = 512; colt = u.pn * BM; sc = 0.125f; }
        else if (u.pn < 4) { base = MK; ld = 512; colt = (u.pn - 2) * BM; }
        else if (u.pn < 8) { base = MV; ld = 1024; colt = (u.pn - 4) * BM; }
        else { base = OG; ld = 1024; colt = (u.pn - 8) * BM; sig = true; }
        const int col0 = colt + wc * 32 + 8 * fq;
#pragma unroll
        for (int ai = 0; ai < 2; ++ai)
#pragma unroll
            for (int m = 0; m < 4; ++m) {
                const int row = u.pm * BM + ai * HALF + wr * 64 + m * 16 + fr;
                const float rs = row_rstd(ssq, row) * sc;
#pragma unroll
                for (int bj = 0; bj < 2; ++bj) {
                    f32x4 v0 = acc[ai][bj][m][0] * rs, v1 = acc[ai][bj][m][1] * rs;
                    if (sig) {
#pragma unroll
                        for (int j = 0; j < 4; ++j) { v0[j] = __builtin_amdgcn_rcpf(1.0f + __builtin_amdgcn_exp2f(v0[j] * -1.4426950408889634f)); v1[j] = __builtin_amdgcn_rcpf(1.0f + __builtin_amdgcn_exp2f(v1[j] * -1.4426950408889634f)); }
                    }
                    *(u32x4*)(base + (size_t)row * ld + col0 + bj * HALF) = pack8(v0, v1);
                }
            }
    }
};
template <class Epi, class Sched, bool ALIGN_EPI = false, bool SP2 = false>
__device__ __forceinline__ void gemm_phase(PG8_LAS unsigned char* lds, const Gemm g, const Sched& S, const Epi& E) {
    int tid_ = threadIdx.x; asm volatile("" : "+v"(tid_));
    const int tid = tid_, wid = __builtin_amdgcn_readfirstlane(tid >> 6), lane = tid & 63, wr = wid >> 2, wc = wid & 3, fr = lane & 15, fq = lane >> 4;
    const int K = g.K, nt = K / BK;
    unsigned voffA[2], voffB[2];
#pragma unroll
    for (int i = 0; i < 2; ++i) { int R, C; stage_rc(tid * 16 + i * 8192, R, C); const int Rb = Epi::PERM ? ((R & ~31) + perm32(R & 31)) : R;
        voffA[i] = (unsigned)(R * K + C) * 2u; voffB[i] = (unsigned)(Rb * K + C) * 2u; }
    const size_t kstep = (size_t)(BK * 2);
    const size_t hstep = (size_t)HALF * K * 2;
    const size_t tstep = 2 * hstep;
    const unsigned ldsw = (unsigned)wid * 1024u;
    const int aoff = lds_byte(wr * 64 + fr, fq * 8), boff = lds_byte(wc * 32 + fr, fq * 8);
#define PG8_SA(b, h) (((b) * 2 + (h)) * HTB)
#define PG8_SB(b, h) ((4 + (b) * 2 + (h)) * HTB)
#define PG8_STAGE(bufoff, gbase, voff) do { _Pragma("unroll") for (int _i = 0; _i < 2; ++_i) \
        __builtin_amdgcn_global_load_lds((const unsigned*)((const char*)(gbase) + (voff)[_i]), (PG8_LAS unsigned*)(lds + (bufoff) + ldsw + _i * 8192), 16, 0, 0); } while (0)
#define PG8_LDA(dst, b, h) do { _Pragma("unroll") for (int m = 0; m < 4; ++m) _Pragma("unroll") for (int k = 0; k < 2; ++k) dst[m][k] = *(const PG8_LAS bf16x8*)(lds + PG8_SA(b, h) + aoff + m * 2048 + k * 1024); } while (0)
#define PG8_LDB(dst, b, h) do { _Pragma("unroll") for (int n = 0; n < 2; ++n) _Pragma("unroll") for (int k = 0; k < 2; ++k) dst[n][k] = *(const PG8_LAS bf16x8*)(lds + PG8_SB(b, h) + boff + n * 2048 + k * 1024); } while (0)
#define PG8_MMA(ai, bj, At, Bt) do { __builtin_amdgcn_s_setprio(1); _Pragma("unroll") for (int m = 0; m < 4; ++m) _Pragma("unroll") for (int n = 0; n < 2; ++n) _Pragma("unroll") for (int k = 0; k < 2; ++k) \
        acc[ai][bj][m][n] = __builtin_amdgcn_mfma_f32_16x16x32_bf16(Bt[n][k], At[m][k], acc[ai][bj][m][n], 0, 0, 0); __builtin_amdgcn_s_setprio(0); } while (0)
#define PG8_WAIT_V(n) asm volatile("s_waitcnt vmcnt(" #n ")" ::: "memory")
#define PG8_WAIT_L(n) asm volatile("s_waitcnt lgkmcnt(" #n ")" ::: "memory")
#define PG8_BAR __builtin_amdgcn_s_barrier()
#define PG8_SCHED __builtin_amdgcn_sched_barrier(0)
    Unit cur, nxt; int ui = 0;
    if (!S.next(0, cur)) return;
    f32x4 acc[2][2][4][2];
#pragma unroll
    for (int a = 0; a < 2; ++a)
#pragma unroll
        for (int b = 0; b < 2; ++b)
#pragma unroll
            for (int m = 0; m < 4; ++m)
#pragma unroll
                for (int n = 0; n < 2; ++n) acc[a][b][m][n] = (f32x4){0.f, 0.f, 0.f, 0.f};
    bf16x8 At[4][2], B0[2][2], B1[2][2];
    const char* cA = (const char*)g.A + (size_t)cur.pm * tstep; const char* cB = (const char*)g.Bt + (size_t)cur.pn * tstep;
    S.a_ready(cur);
    if constexpr (SP2) {
        PG8_STAGE(PG8_SB(0, 0), cB, voffB); PG8_STAGE(PG8_SB(0, 1), cB + hstep, voffB); PG8_STAGE(PG8_SA(0, 0), cA, voffA); PG8_STAGE(PG8_SA(0, 1), cA + hstep, voffA);
        if (wr == 1) PG8_BAR;
        PG8_WAIT_V(2); PG8_BAR;
        PG8_STAGE(PG8_SB(1, 0), cB + kstep, voffB); PG8_STAGE(PG8_SA(1, 0), cA + kstep, voffA); PG8_STAGE(PG8_SB(1, 1), cB + hstep + kstep, voffB);
        PG8_WAIT_V(6); PG8_BAR;
    } else {
        PG8_STAGE(PG8_SB(0, 0), cB, voffB); PG8_STAGE(PG8_SA(0, 0), cA, voffA); PG8_STAGE(PG8_SB(0, 1), cB + hstep, voffB); PG8_STAGE(PG8_SA(0, 1), cA + hstep, voffA);
        if (wr == 1) PG8_BAR;
        PG8_WAIT_V(4); PG8_BAR;
        PG8_STAGE(PG8_SB(1, 0), cB + kstep, voffB); PG8_STAGE(PG8_SA(1, 0), cA + kstep, voffA); PG8_STAGE(PG8_SB(1, 1), cB + hstep + kstep, voffB);
        PG8_WAIT_V(6); PG8_BAR;
    }
    for (;;) {
        const bool has_next = S.next(ui + 1, nxt);
        const char* nA = has_next ? (const char*)g.A + (size_t)nxt.pm * tstep : cA; const char* nB = has_next ? (const char*)g.Bt + (size_t)nxt.pn * tstep : cB;
        for (int t = 0; t < nt; t += 2) {
            const bool last = (t == nt - 2);
            const char* a1 = cA + (size_t)(t + 1) * kstep;
            const char* a2 = last ? nA : cA + (size_t)(t + 2) * kstep; const char* b2 = last ? nB : cB + (size_t)(t + 2) * kstep;
            const char* a3 = a2 + kstep; const char* b3 = b2 + kstep;
            if (last && has_next) S.a_ready(nxt);
            if constexpr (SP2) {
            PG8_LDB(B0, 0, 0); PG8_LDB(B1, 0, 1); PG8_SCHED; PG8_LDA(At, 0, 0); PG8_STAGE(PG8_SA(1, 1), a1 + hstep, voffA);
            PG8_WAIT_V(8); PG8_WAIT_L(0); PG8_BAR; PG8_MMA(0, 0, At, B0); PG8_MMA(0, 1, At, B1); PG8_BAR; PG8_SCHED;
            PG8_LDA(At, 0, 1); PG8_STAGE(PG8_SB(0, 0), b2, voffB); PG8_STAGE(PG8_SB(0, 1), b2 + hstep, voffB); PG8_STAGE(PG8_SA(0, 0), a2, voffA);
            PG8_WAIT_V(8); PG8_WAIT_L(0); PG8_BAR; PG8_MMA(1, 0, At, B0); PG8_MMA(1, 1, At, B1); PG8_BAR; PG8_SCHED;
            PG8_LDB(B0, 1, 0); PG8_LDB(B1, 1, 1); PG8_SCHED; PG8_LDA(At, 1, 0); PG8_STAGE(PG8_SA(0, 1), a2 + hstep, voffA);
            PG8_WAIT_V(8); PG8_WAIT_L(0); PG8_BAR; PG8_MMA(0, 0, At, B0); PG8_MMA(0, 1, At, B1); PG8_BAR; PG8_SCHED;
            PG8_LDA(At, 1, 1); PG8_STAGE(PG8_SB(1, 0), b3, voffB); PG8_STAGE(PG8_SB(1, 1), b3 + hstep, voffB); PG8_STAGE(PG8_SA(1, 0), a3, voffA);
            PG8_WAIT_V(8); PG8_WAIT_L(0); PG8_BAR; PG8_MMA(1, 0, At, B0); PG8_MMA(1, 1, At, B1); PG8_BAR; PG8_SCHED;
            } else {
            PG8_LDB(B0, 0, 0); PG8_SCHED; PG8_LDA(At, 0, 0); PG8_STAGE(PG8_SA(1, 1), a1 + hstep, voffA);
            PG8_WAIT_L(8); PG8_BAR; PG8_WAIT_L(0); PG8_MMA(0, 0, At, B0); PG8_BAR; PG8_SCHED;
            PG8_LDB(B1, 0, 1); PG8_STAGE(PG8_SB(0, 0), b2, voffB);
            PG8_BAR; PG8_WAIT_L(0); PG8_MMA(0, 1, At, B1); PG8_BAR;
            PG8_LDA(At, 0, 1); PG8_STAGE(PG8_SA(0, 0), a2, voffA);
            PG8_BAR; PG8_WAIT_L(0); PG8_MMA(1, 0, At, B0); PG8_BAR; PG8_SCHED;
            PG8_STAGE(PG8_SB(0, 1), b2 + hstep, voffB);
            PG8_WAIT_V(6); PG8_BAR; PG8_MMA(1, 1, At, B1); PG8_BAR;
            PG8_LDB(B0, 1, 0); PG8_SCHED; PG8_LDA(At, 1, 0); PG8_STAGE(PG8_SA(0, 1), a2 + hstep, voffA);
            PG8_WAIT_L(8); PG8_BAR; PG8_WAIT_L(0); PG8_MMA(0, 0, At, B0); PG8_BAR; PG8_SCHED;
            PG8_LDB(B1, 1, 1); PG8_STAGE(PG8_SB(1, 0), b3, voffB);
            PG8_BAR; PG8_WAIT_L(0); PG8_MMA(0, 1, At, B1); PG8_BAR;
            PG8_LDA(At, 1, 1); PG8_STAGE(PG8_SA(1, 0), a3, voffA);
            PG8_BAR; PG8_WAIT_L(0); PG8_MMA(1, 0, At, B0); PG8_BAR; PG8_SCHED;
            PG8_STAGE(PG8_SB(1, 1), b3 + hstep, voffB);
            PG8_WAIT_V(6); PG8_BAR; PG8_MMA(1, 1, At, B1); PG8_BAR;
            }
        }
        if constexpr (ALIGN_EPI) { if (wr == 0) PG8_BAR; }
        if constexpr (!Epi::AFTER_DRAIN) { E(acc, cur, wr, wc, fr, fq); S.done(cur); }
        if (!has_next) break;
#pragma unroll
        for (int a = 0; a < 2; ++a)
#pragma unroll
            for (int b = 0; b < 2; ++b)
#pragma unroll
                for (int m = 0; m < 4; ++m)
#pragma unroll
                    for (int n = 0; n < 2; ++n) acc[a][b][m][n] = (f32x4){0.f, 0.f, 0.f, 0.f};
        cur = nxt; cA = nA; cB = nB; ++ui;
        if constexpr (ALIGN_EPI) { if (wr == 1) PG8_BAR; }
    }
    PG8_WAIT_V(0);
    if constexpr (!ALIGN_EPI) { if (wr == 0) PG8_BAR; }
    PG8_BAR;
    if constexpr (Epi::AFTER_DRAIN) { E.fused(acc, cur, wr, wc, fr, fq, lds, wid, lane); S.done(cur); }
#undef PG8_SA
#undef PG8_SB
#undef PG8_STAGE
#undef PG8_LDA
#undef PG8_LDB
#undef PG8_MMA
#undef PG8_WAIT_V
#undef PG8_WAIT_L
#undef PG8_BAR
#undef PG8_SCHED
}
}

#ifndef PG8_SP2
#define PG8_SP2 true
#endif
#ifndef PG8_ALIGN
#define PG8_ALIGN true
#endif
#define GAS __attribute__((address_space(1)))
#define LAS __attribute__((address_space(3)))
typedef unsigned short bf16;
typedef unsigned v4u __attribute__((ext_vector_type(4)));
typedef float f32x4 __attribute__((ext_vector_type(4)));
typedef short bf16x8 __attribute__((ext_vector_type(8)));
typedef GAS unsigned gu32;
typedef GAS unsigned long long gu64;
#define RLX_AGENT __ATOMIC_RELAXED, __HIP_MEMORY_SCOPE_AGENT
#define LDS_WAIT() asm volatile("s_waitcnt lgkmcnt(0)" ::: "memory")
#define VM_WAIT() asm volatile("s_waitcnt vmcnt(0)" ::: "memory")
__device__ __forceinline__ unsigned long long rt() { return __builtin_amdgcn_s_memrealtime(); }
__device__ __forceinline__ unsigned f2bf(float f) { unsigned u = __builtin_bit_cast(unsigned, f); return (u + 0x7fffu + ((u >> 16) & 1u)) >> 16; }
__device__ __forceinline__ unsigned pk2(float lo, float hi) { return f2bf(lo) | (f2bf(hi) << 16); }

#define XB_TMO      128
#define XB_XCNT(j)  (256  + 64 * (j))
#define XB_XSUB(j)  (1280 + 64 * (j))
#define XB_XGEN(j)  (2304 + 64 * (j))
#define XB_TOP      3328
#define XB_TOPGEN   3392
#define XCD_BAR_WORDS 3456
#define XB_SPIN_CAP (1u << 18)

__device__ __forceinline__ unsigned xb_ld(unsigned* p)              { return __hip_atomic_load(p, __ATOMIC_RELAXED, __HIP_MEMORY_SCOPE_AGENT); }
__device__ __forceinline__ unsigned xb_add(unsigned* p, unsigned v) { return __hip_atomic_fetch_add(p, v, __ATOMIC_RELAXED, __HIP_MEMORY_SCOPE_AGENT); }
__device__ __forceinline__ unsigned xb_xcc_id() { return (unsigned)__builtin_amdgcn_s_getreg((3 << 11) | 20) & 0xFu; }
#define XB_SPIN(cond, bar) do { unsigned _sp = 0; while (cond) { __builtin_amdgcn_s_sleep(1); \
    if ((++_sp & 255u) == 0u) { if (xb_ld(&(bar)[XB_TMO])) break; if (_sp > XB_SPIN_CAP) { atomicAdd(&(bar)[XB_TMO], 1u); break; } } } } while (0)

struct XcdBarrier {
    unsigned* bar; unsigned x;
    volatile LAS unsigned* st;
};

__device__ __forceinline__ XcdBarrier xcd_barrier_post(unsigned* bar, volatile LAS unsigned* st) {
    XcdBarrier b; b.bar = bar; b.x = xb_xcc_id(); b.st = st;
    if (threadIdx.x == 0) (void)xb_add(&bar[XB_XCNT(b.x)], 1u);
    return b;
}
__device__ __forceinline__ void xcd_barrier_complete(unsigned* bar, unsigned x, unsigned& nloc, unsigned& nx) {
    const unsigned G = gridDim.x * gridDim.y * gridDim.z;
    unsigned sum, cnt, mine, sp = 0u;
    for (;;) {
        sum = 0u; cnt = 0u; mine = 0u;
#pragma unroll
        for (unsigned j = 0; j < 16; ++j) { const unsigned c = xb_ld(&bar[XB_XCNT(j)]); sum += c; cnt += (c > 0u) ? 1u : 0u; mine = (j == x) ? c : mine; }
        if (sum == G) break;
        __builtin_amdgcn_s_sleep(1);
        if ((++sp & 255u) == 0u) { if (xb_ld(&bar[XB_TMO])) break; if (sp > XB_SPIN_CAP) { atomicAdd(&bar[XB_TMO], 1u); break; } }
    }
    nloc = mine > 0u ? mine : 1u; nx = cnt > 0u ? cnt : 1u;
}

__device__ __forceinline__ void xcd_barrier(const XcdBarrier& b) {
    asm volatile("s_waitcnt vmcnt(0)" ::: "memory");
    __syncthreads();
    if (threadIdx.x == 0) {
        unsigned* bar = b.bar;
        __builtin_amdgcn_s_waitcnt(0);
        unsigned nloc = b.st[0], nx = b.st[1];
        if (nloc == 0u) { xcd_barrier_complete(bar, b.x, nloc, nx); b.st[0] = nloc; b.st[1] = nx; }
        const unsigned old = xb_add(&bar[XB_XSUB(b.x)], 1u);
        const unsigned gen = old / nloc;
        if (old + 1u == (gen + 1u) * nloc) {
            __builtin_amdgcn_fence(__ATOMIC_RELEASE, "agent");
            asm volatile("s_waitcnt vmcnt(0)" ::: "memory");
            const unsigned og = xb_add(&bar[XB_TOP], 1u);
            const unsigned tg = og / nx;
            if (og + 1u == (tg + 1u) * nx) xb_add(&bar[XB_TOPGEN], 1u);
            else XB_SPIN(xb_ld(&bar[XB_TOPGEN]) == tg, bar);
            __builtin_amdgcn_fence(__ATOMIC_ACQUIRE, "agent");
            xb_add(&bar[XB_XGEN(b.x)], 1u);
            asm volatile("s_waitcnt vmcnt(0)" ::: "memory");
        } else {
            XB_SPIN(xb_ld(&bar[XB_XGEN(b.x)]) == gen, bar);
            __builtin_amdgcn_fence(__ATOMIC_ACQUIRE, "agent");
            asm volatile("s_waitcnt vmcnt(0)" ::: "memory");
        }
    }
    __syncthreads();
}
constexpr int NWAVES = 8;
constexpr int BATCH = 2, SEQ = 8192, D = 1024, M = BATCH * SEQ, NH = 16, HD = 64, MB = 256, NBLK = SEQ / MB;
constexpr int DFF = 2816, NGU = 2 * DFF;
constexpr int MH = 8, DK = 64, DV = 128, LCH = 64, NCH = SEQ / LCH, NUNIT = BATCH * MH * NCH;
constexpr int NIN = 3072, NINW = 3088;
constexpr float RMS_EPS = 1e-6f, SOFTCAP = 15.0f, LOG2E = 1.4426950408889634f;

constexpr size_t MiB = 1u << 20;
constexpr size_t WS_CTL = 0, CTL_ZERO_BYTES = 1 * MiB;
constexpr size_t WS_KMEAN = 512 * 1024;
constexpr size_t WS_SSQ = 1 * MiB;
constexpr size_t WS_BIG = 5 * MiB;
constexpr size_t WS_SEL = 6 * MiB;
constexpr size_t WS_ROPE = 7 * MiB;
constexpr size_t WS_WG = 7 * MiB + 512 * 1024;
constexpr size_t WS_WQKV = 8 * MiB, WS_WO = 14 * MiB, WS_WIN = 16 * MiB, WS_WOUT = 22 * MiB, WS_WGU = 24 * MiB  , WS_WD = 46 * MiB  ;
constexpr size_t WS_NLOC = 57 * MiB;
constexpr size_t WS_SCAL = 57 * MiB + 512 * 1024;
constexpr size_t WS_AB = 64 * MiB;
constexpr size_t WS_Q = 96 * MiB, WS_K = 128 * MiB, WS_V = 160 * MiB;
constexpr size_t WS_HB1 = 96 * MiB;
constexpr size_t WS_ACT = 128 * MiB;
constexpr size_t WS_MQ = 96 * MiB, WS_MK = 112 * MiB, WS_MV = 128 * MiB, WS_OG = 160 * MiB, WS_CLOC = 192 * MiB;
constexpr size_t WS_END = 256 * MiB;
constexpr int CW_BAR = 4096;

constexpr int RING_OFF = 0, RING_BYTES = 131072;
constexpr int LDSCTL_OFF = RING_BYTES, MISC_OFF = LDSCTL_OFF + 320;
constexpr int LDS_BYTES = 163840;
static_assert(MISC_OFF + 128 <= LDS_BYTES, "LDS map");

__device__ __forceinline__ float bf2f(unsigned short h) { return __builtin_bit_cast(float, (unsigned)h << 16); }
__device__ __forceinline__ float bflo(unsigned w) { return __builtin_bit_cast(float, w << 16); }
__device__ __forceinline__ float bfhi(unsigned w) { return __builtin_bit_cast(float, w & 0xffff0000u); }
__device__ __forceinline__ float wave_sum(float v) {
#pragma unroll
    for (int o = 1; o < 64; o <<= 1) v += __shfl_xor(v, o);
    return v;
}
__device__ __forceinline__ float wave_max(float v) {
#pragma unroll
    for (int o = 1; o < 64; o <<= 1) v = fmaxf(v, __shfl_xor(v, o));
    return v;
}
__device__ __forceinline__ float fexp(float x) { return __builtin_amdgcn_exp2f(x * LOG2E); }

__device__ __forceinline__ int ltid() { int t = threadIdx.x; asm volatile("" : "+v"(t)); return t; }
struct Frame {
    LAS unsigned char* lds;
    volatile LAS unsigned* MISC;
    gu32* ctl;
    int wave, vcu, G;
};

template <int MODE> __device__ __forceinline__ int src_col(int n) {
    if (MODE == 1) {
        if (n >= 2048) return n;
        const int s = n & 63; int d = s;
        if (s < 16) d = (s & 3) | ((s & 4) << 1) | ((s & 8) >> 1);
        return (n & ~63) | d;
    }
    if (MODE == 2) { const int pn = n >> 8, r = n & 255; return (r < 128) ? pn * 128 + r : DFF + pn * 128 + (r - 128); }
    return n;
}
template <int MODE> __device__ __forceinline__ void p0_transpose_item(const float* W, int K, int Nsrc, int Nout, const float* kscale, bf16* WT, int item, int lane) {
    const int nblk = Nout / 64, kb = item / nblk, nb = item - kb * nblk, k0 = 32 * kb, n = 64 * nb + lane;
    const float* wp = W + (size_t)k0 * Nsrc + src_col<MODE>(n);
    float v[32];
#pragma unroll
    for (int i = 0; i < 32; ++i) v[i] = wp[(size_t)i * Nsrc];
    if (kscale) {
#pragma unroll
        for (int i = 0; i < 32; ++i) v[i] *= kscale[k0 + i]; }
    GAS v4u* op = (GAS v4u*)(WT + (size_t)n * K + k0);
#pragma unroll
    for (int c = 0; c < 4; ++c) { v4u o; o.x = pk2(v[8 * c], v[8 * c + 1]); o.y = pk2(v[8 * c + 2], v[8 * c + 3]); o.z = pk2(v[8 * c + 4], v[8 * c + 5]); o.w = pk2(v[8 * c + 6], v[8 * c + 7]); op[c] = o; }
}

struct Ptrs {
    const float *x, *attn_norm, *w_qkv, *w_o, *mlstm_norm, *w_in, *b_gates, *head_norm, *w_out, *ffn_norm, *w_gu, *w_down, *final_norm;
    float* out; unsigned char* ws;
};

__device__ __forceinline__ void p0_prologue(Frame& F, const Ptrs& P) {
    const int tid_l = ltid(), lane_l = tid_l & 63; (void)lane_l;
    unsigned char* ws = P.ws;
    const int gw = F.vcu * NWAVES + F.wave, NGW = F.G * NWAVES;
    constexpr int I_QKV = (D / 32) * (3 * D / 64), I_O = (D / 32) * (D / 64), I_IN = (D / 32) * (NIN / 64), I_GU = (D / 32) * (NGU / 64), I_DN = (DFF / 32) * (D / 64);
    constexpr int NITEMS = I_QKV + I_O + I_IN + I_O + 2 * I_GU + 2 * I_DN;
    for (int it = gw; it < NITEMS; it += NGW) {
        int r = it;
        if (r < I_QKV) { p0_transpose_item<1>(P.w_qkv, D, 3 * D, 3 * D, P.attn_norm, (bf16*)(ws + WS_WQKV), r, lane_l); continue; } r -= I_QKV;
        if (r < I_O) { p0_transpose_item<0>(P.w_o, D, D, D, nullptr, (bf16*)(ws + WS_WO), r, lane_l); continue; } r -= I_O;
        if (r < I_IN) { p0_transpose_item<0>(P.w_in, D, NINW, NIN, P.mlstm_norm, (bf16*)(ws + WS_WIN), r, lane_l); continue; } r -= I_IN;
        if (r < I_O) { p0_transpose_item<0>(P.w_out, D, D, D, nullptr, (bf16*)(ws + WS_WOUT), r, lane_l); continue; } r -= I_O;
        if (r < 2 * I_GU) { const int l = r / I_GU; p0_transpose_item<2>(P.w_gu + (size_t)l * D * NGU, D, NGU, NGU, P.ffn_norm + l * D, (bf16*)(ws + WS_WGU) + (size_t)l * NGU * D, r % I_GU, lane_l); continue; } r -= 2 * I_GU;
        { const int l = r / I_DN; p0_transpose_item<0>(P.w_down + (size_t)l * DFF * D, DFF, D, D, nullptr, (bf16*)(ws + WS_WD) + (size_t)l * D * DFF, r % I_DN, lane_l); }
    }
    const int gt = F.vcu * (NWAVES * 64) + tid_l, NGT = F.G * NWAVES * 64;
    { bf16* WG = (bf16*)(ws + WS_WG); for (int i = gt; i < 16 * D; i += NGT) { const int j = i >> 10, k = i & 1023; WG[i] = (bf16)f2bf(P.mlstm_norm[k] * P.w_in[(size_t)k * NINW + NIN + j]); } }
    { float* rope = (float*)(ws + WS_ROPE);
      for (int i = gt; i < SEQ * 8; i += NGT) { const int pos = i >> 3, j = i & 7;
          const float invf = j == 0 ? 1.0f : j == 1 ? 0.1939227432012558f : j == 2 ? 0.03760603070259094f : j == 3 ? 0.007292664609849453f : j == 4 ? 0.0014142135623842478f : j == 5 ? 0.00027424818836152554f : j == 6 ? 5.3182957344688475e-05f : 1.0313385246263351e-05f;
          const float ang = __fmul_rn((float)pos, invf);
          const double rev = (double)ang * 0.15915494309189533577; const float fr = (float)(rev - __builtin_rint(rev));
          rope[2 * i] = __builtin_amdgcn_cosf(fr); rope[2 * i + 1] = __builtin_amdgcn_sinf(fr); } }
    { bf16* xb = (bf16*)(ws + WS_AB); float* ssq0 = (float*)(ws + WS_SSQ);
      for (int m = gw; m < M; m += NGW) {
          const GAS f32x4* xr = (const GAS f32x4*)(P.x + (size_t)m * D) + lane_l; f32x4 v[4]; float s = 0.f;
#pragma unroll
          for (int j = 0; j < 4; ++j) { v[j] = xr[64 * j]; s += (v[j].x * v[j].x + v[j].y * v[j].y) + (v[j].z * v[j].z + v[j].w * v[j].w); }
          s = wave_sum(s);
          GAS unsigned long long* o8 = (GAS unsigned long long*)(xb + (size_t)m * D) + lane_l;
#pragma unroll
          for (int j = 0; j < 4; ++j) o8[64 * j] = (unsigned long long)pk2(v[j].x, v[j].y) | ((unsigned long long)pk2(v[j].z, v[j].w) << 32);
          if (lane_l < 16) ssq0[(size_t)m * 16 + lane_l] = (lane_l == 0) ? s : 0.f;
      } }
}

namespace moba {
typedef short bf16x8 __attribute__((ext_vector_type(8)));
typedef short s16x4 __attribute__((ext_vector_type(4)));
typedef float f32x16 __attribute__((ext_vector_type(16)));
typedef unsigned u32x4 __attribute__((ext_vector_type(4)));
typedef LAS const char* lds_cptr;
typedef short v4i16_t __attribute__((ext_vector_type(4)));
typedef float f32x2_t __attribute__((ext_vector_type(2))); typedef __bf16 bf16x2_t __attribute__((ext_vector_type(2)));
constexpr int THRL = 8;
constexpr int L_K = 0, L_V = 32768, L_WS = 65536  , L_STG = 73728  , L_QL = 106496  , L_MISC = 122880;
constexpr size_t WS_SEGCNT = 58 * MiB;
constexpr size_t WS_P2 = 192 * MiB;
constexpr size_t WS_PLSE = 224 * MiB;
constexpr size_t WS_SEGLIST = 232 * MiB;
constexpr int CW_Q3 = 8192;
constexpr size_t PART_STRIDE = (size_t)M * D * 2;

__device__ __forceinline__ int crow(int r, int hi) { return (r & 3) + 8 * (r >> 2) + 4 * hi; }
__device__ __forceinline__ void glds16(const void* gsrc, unsigned lds_dst) { unsigned keep;
    asm volatile("s_mov_b32 %0, m0\n\ts_mov_b32 m0, %2\n\ts_nop 0\n\tglobal_load_lds_dwordx4 %1, off\n\ts_mov_b32 m0, %0" : "=&s"(keep) : "v"(gsrc), "s"(lds_dst) : "memory"); }
__device__ __forceinline__ unsigned cvtpk_s(float lo, float hi) { f32x2_t v = {lo, hi}; bf16x2_t b = __builtin_convertvector(v, bf16x2_t); return __builtin_bit_cast(unsigned, b); }
__device__ __forceinline__ s16x4 vtr(lds_cptr p) { return __builtin_bit_cast(s16x4, __builtin_amdgcn_ds_read_tr16_b64_v4i16((LAS v4i16_t*)p)); }
#define MOBA_MX3(a, b, c) __builtin_fmaxf(__builtin_fmaxf((a), (b)), (c))
__device__ __forceinline__ float rowmax(const f32x16& p0, const f32x16& p1) {
    float a = MOBA_MX3(p0[0], p0[1], p1[0]), b = MOBA_MX3(p0[2], p0[3], p1[1]); a = MOBA_MX3(a, p1[2], p1[3]);
#pragma unroll
    for (int r = 4; r < 16; r += 4) { a = MOBA_MX3(a, p0[r], p0[r + 1]); b = MOBA_MX3(b, p0[r + 2], p0[r + 3]); a = MOBA_MX3(a, p1[r], p1[r + 1]); b = MOBA_MX3(b, p1[r + 2], p1[r + 3]); }
    float m = __builtin_fmaxf(a, b); auto rr = __builtin_amdgcn_permlane32_swap(__float_as_uint(m), __float_as_uint(m), false, false);
    return __builtin_fmaxf(__uint_as_float(rr[0]), __uint_as_float(rr[1])); }
__device__ __forceinline__ float halves_sum(float v) { auto rr = __builtin_amdgcn_permlane32_swap(__float_as_uint(v), __float_as_uint(v), false, false); return __uint_as_float(rr[0]) + __uint_as_float(rr[1]); }
#define MOBA_MFMA(a, b, c) __builtin_amdgcn_mfma_f32_32x32x16_bf16(a, b, c, 0, 0, 0)

__device__ __forceinline__ void stage_kv(const bf16* K, const bf16* V, int b, int h, int j, LAS unsigned char* lds, int wid, int lane) {
    const size_t row0 = (size_t)b * SEQ + (size_t)j * MB;
    const bf16* ksrc = K + (row0 + lane) * D + h * HD + wid * 8;
    const bf16* vsrc = V + (row0 + 16 * (wid & 3) + (lane >> 2)) * D + h * HD + (wid >> 2) * 32 + (lane & 3) * 8;
    const unsigned kdst = (unsigned)(uintptr_t)(lds + L_K) + wid * 1024, vdst = (unsigned)(uintptr_t)(lds + L_V) + wid * 1024;
#pragma unroll
    for (int t = 0; t < 4; ++t) { glds16(ksrc + (size_t)t * 64 * D, (unsigned)__builtin_amdgcn_readfirstlane(kdst + t * 8192)); glds16(vsrc + (size_t)t * 64 * D, (unsigned)__builtin_amdgcn_readfirstlane(vdst + t * 8192)); }
    asm volatile("s_waitcnt vmcnt(0) lgkmcnt(0)\n\ts_barrier" ::: "memory");
}

template <bool CAUSAL> __device__ __forceinline__ void wave_block(const bf16x8 (&qr)[4], lds_cptr kbase, lds_cptr vbase, int ntiles, int qrel, LAS float* wsf, int lane, f32x16& o0, f32x16& o1, float& mhat, float& lsum) {
    const int r32 = lane & 31, hi = lane >> 5;
    const lds_cptr kp0 = kbase + hi * 1024 + r32 * 16;
    const lds_cptr vp0 = vbase + ((lane >> 4) & 1) * 32 + (lane & 3) * 8 + (4 * hi + ((lane & 15) >> 2)) * 64;
    o0 = f32x16{}; o1 = f32x16{}; mhat = 0.f; lsum = 0.f;
    int kt0 = 0; asm volatile("" : "+s"(kt0));
#pragma nounroll
    for (int kt = kt0; kt < ntiles; ++kt) {
        const lds_cptr kp = kp0 + kt * 8192, vp = vp0 + kt * 8192;
        bf16x8 kf[8];
#pragma unroll
        for (int d0 = 0; d0 < 4; ++d0) { kf[2 * d0] = *(const LAS bf16x8*)(kp + d0 * 2048); kf[2 * d0 + 1] = *(const LAS bf16x8*)(kp + d0 * 2048 + 512); }
        f32x16 negm;
#pragma unroll
        for (int r = 0; r < 16; ++r) negm[r] = 0.f - mhat;
        f32x16 c0 = MOBA_MFMA(kf[0], qr[0], negm), c1 = MOBA_MFMA(kf[1], qr[0], negm);
        c0 = MOBA_MFMA(kf[2], qr[1], c0); c1 = MOBA_MFMA(kf[3], qr[1], c1);
        c0 = MOBA_MFMA(kf[4], qr[2], c0); c1 = MOBA_MFMA(kf[5], qr[2], c1);
        c0 = MOBA_MFMA(kf[6], qr[3], c0); c1 = MOBA_MFMA(kf[7], qr[3], c1);
        if (CAUSAL && kt == ntiles - 1) { int rel = qrel - 64 * kt - 4 * hi; asm volatile("" : "+v"(rel));
#pragma unroll
            for (int r = 0; r < 16; ++r) { const int kv = (r & 3) + 8 * (r >> 2);
                c0[r] = __builtin_fminf(c0[r], __builtin_bit_cast(float, 0x7F800000u | ((unsigned)((rel - kv) >> 31) & 0x80000000u)));
                c1[r] = __builtin_fminf(c1[r], __builtin_bit_cast(float, 0x7F800000u | ((unsigned)((rel - kv - 32) >> 31) & 0x80000000u))); } }
        const float rm = rowmax(c0, c1);
        bool resc = false; float dl = 0.f;
        if (kt == 0) { dl = rm; mhat = rm; }
        else if (__any(rm > (float)THRL)) { dl = __builtin_fmaxf(rm, 0.f); mhat += dl; const float f = __builtin_amdgcn_exp2f(-dl); lsum *= f; if (hi == 0) wsf[r32] = f; resc = true; }
        float sacc = 0.f;
#pragma unroll
        for (int r = 0; r < 16; ++r) { c0[r] = __builtin_amdgcn_exp2f(c0[r] - dl); c1[r] = __builtin_amdgcn_exp2f(c1[r] - dl); sacc += c0[r] + c1[r]; }
        lsum += sacc;
        if (resc) { asm volatile("s_waitcnt lgkmcnt(0)" ::: "memory");
#pragma unroll
            for (int r = 0; r < 16; ++r) { const float f = wsf[crow(r, hi)]; o0[r] *= f; o1[r] *= f; } }
        u32x4 pw0, pw1, pw2, pw3;
        pw0 = (u32x4){cvtpk_s(c0[0], c0[1]), cvtpk_s(c0[2], c0[3]), cvtpk_s(c0[4], c0[5]), cvtpk_s(c0[6], c0[7])}; pw1 = (u32x4){cvtpk_s(c0[8], c0[9]), cvtpk_s(c0[10], c0[11]), cvtpk_s(c0[12], c0[13]), cvtpk_s(c0[14], c0[15])};
        pw2 = (u32x4){cvtpk_s(c1[0], c1[1]), cvtpk_s(c1[2], c1[3]), cvtpk_s(c1[4], c1[5]), cvtpk_s(c1[6], c1[7])}; pw3 = (u32x4){cvtpk_s(c1[8], c1[9]), cvtpk_s(c1[10], c1[11]), cvtpk_s(c1[12], c1[13]), cvtpk_s(c1[14], c1[15])};
        s16x4 vlo[8], vhi[8];
#pragma unroll
        for (int i = 0; i < 8; ++i) { vlo[i] = vtr(vp + ((i >> 2) * 4096 + (i & 3) * 1024)); vhi[i] = vtr(vp + ((i >> 2) * 4096 + (i & 3) * 1024 + 512)); }
#define MOBA_PAF(k) __builtin_bit_cast(bf16x8, pw##k)
#define MOBA_VFR(i) (bf16x8){vlo[i][0], vlo[i][1], vlo[i][2], vlo[i][3], vhi[i][0], vhi[i][1], vhi[i][2], vhi[i][3]}
        o0 = MOBA_MFMA(MOBA_PAF(0), MOBA_VFR(0), o0); o1 = MOBA_MFMA(MOBA_PAF(0), MOBA_VFR(4), o1); o0 = MOBA_MFMA(MOBA_PAF(1), MOBA_VFR(1), o0); o1 = MOBA_MFMA(MOBA_PAF(1), MOBA_VFR(5), o1);
        o0 = MOBA_MFMA(MOBA_PAF(2), MOBA_VFR(2), o0); o1 = MOBA_MFMA(MOBA_PAF(2), MOBA_VFR(6), o1); o0 = MOBA_MFMA(MOBA_PAF(3), MOBA_VFR(3), o0); o1 = MOBA_MFMA(MOBA_PAF(3), MOBA_VFR(7), o1);
#undef MOBA_PAF
#undef MOBA_VFR
    }
    lsum = halves_sum(lsum);
}
__device__ __forceinline__ void stage_o(const f32x16& o0, const f32x16& o1, float lsum, LAS float* wsf, LAS unsigned short* stg, int lane) {
    const int r32 = lane & 31, hi = lane >> 5;
    if (hi == 0) wsf[32 + r32] = __builtin_amdgcn_rcpf(lsum);
    asm volatile("s_waitcnt lgkmcnt(0)" ::: "memory");
#pragma unroll
    for (int r = 0; r < 16; ++r) { const int orow = crow(r, hi); const float rl = wsf[32 + orow];
        stg[orow * 64 + r32] = (unsigned short)f2bf(o0[r] * rl); stg[orow * 64 + 32 + r32] = (unsigned short)f2bf(o1[r] * rl); }
    asm volatile("s_waitcnt lgkmcnt(0)" ::: "memory");
}

__device__ __forceinline__ bool better(float g, int n, float gk, int ik) { return g > gk || (g == gk && n < ik); }
__device__ __forceinline__ void ins3(float g, int n, float& g1, int& i1, float& g2, int& i2, float& g3, int& i3) {
    const bool b1 = better(g, n, g1, i1), b2 = better(g, n, g2, i2), b3 = better(g, n, g3, i3);
    const float n3 = b2 ? g2 : (b3 ? g : g3); const int m3 = b2 ? i2 : (b3 ? n : i3);
    const float n2 = b1 ? g1 : (b2 ? g : g2); const int m2 = b1 ? i1 : (b2 ? n : i2);
    g1 = b1 ? g : g1; i1 = b1 ? n : i1; g2 = n2; i2 = m2; g3 = n3; i3 = m3;
}
}

__device__ __forceinline__ void p2_gating(Frame& F, const Ptrs& P) {
    using namespace moba;
    const int tid_l = ltid(), lane_l = tid_l & 63; (void)lane_l;
    const bf16* Q = (const bf16*)(P.ws + WS_Q); const float* kmean = (const float*)(P.ws + WS_KMEAN);
    unsigned* segcnt = (unsigned*)(P.ws + WS_SEGCNT); unsigned short* seglist = (unsigned short*)(P.ws + WS_SEGLIST);
    LAS unsigned char* himg = F.lds + RING_OFF; LAS unsigned char* limg = himg + 4096; LAS unsigned* cntL = (LAS unsigned*)(limg + 4096);
    const int tid = tid_l, lane = lane_l, r32 = lane & 31, hi = lane >> 5, wid = F.wave;
    for (int unit = F.vcu; unit < BATCH * NH * NBLK; unit += F.G) {
        const int bh = unit >> 5, cur = unit & 31, b = bh >> 4, h = bh & 15;
        if (cur == 0) continue;
        { const int n = tid >> 4, c4 = (tid & 15) * 4; f32x4 x = (f32x4){0.f, 0.f, 0.f, 0.f};
          if (n < cur) x = *(const f32x4*)(kmean + (size_t)(b * NBLK + n) * D + h * HD + c4);
          const unsigned h01 = cvtpk_s(x.x, x.y), h23 = cvtpk_s(x.z, x.w);
          const unsigned l01 = cvtpk_s(x.x - bflo(h01), x.y - bfhi(h01)), l23 = cvtpk_s(x.z - bflo(h23), x.w - bfhi(h23));
          const int off = (c4 >> 3) * 512 + n * 16 + (c4 & 7) * 2;
          typedef unsigned u32x2v __attribute__((ext_vector_type(2)));
          *(LAS u32x2v*)(himg + off) = (u32x2v){h01, h23}; *(LAS u32x2v*)(limg + off) = (u32x2v){l01, l23};
          if (tid < 32) cntL[tid] = 0u; }
        LDS_WAIT(); __syncthreads();
        const int tl = cur * MB + wid * 32 + r32;
        float g1 = -INFINITY, g2 = -INFINITY, g3 = -INFINITY; int i1 = 255, i2 = 255, i3 = 255;
        {
            const bf16* qp = Q + (size_t)(b * SEQ + tl) * D + h * HD + hi * 8;
            f32x16 g = f32x16{};
#pragma unroll
            for (int d0 = 0; d0 < 4; ++d0) { const bf16x8 qr = *(const bf16x8*)(qp + d0 * 16);
                const bf16x8 ah = *(const LAS bf16x8*)(himg + (2 * d0 + hi) * 512 + r32 * 16), al = *(const LAS bf16x8*)(limg + (2 * d0 + hi) * 512 + r32 * 16);
                g = MOBA_MFMA(ah, qr, g); g = MOBA_MFMA(al, qr, g); }
            int nb = 4 * hi; asm volatile("" : "+v"(nb));
#pragma unroll
            for (int r = 0; r < 16; ++r) { const int n = nb + (r & 3) + 8 * (r >> 2); const float gv = (n < cur) ? g[r] : -INFINITY; ins3(gv, (n < cur) ? n : 255, g1, i1, g2, i2, g3, i3); }
        }
        {
            const float og1 = __uint_as_float(__builtin_amdgcn_permlane32_swap(__float_as_uint(g1), __float_as_uint(g1), false, false)[hi ? 0 : 1]);
            const float og2 = __uint_as_float(__builtin_amdgcn_permlane32_swap(__float_as_uint(g2), __float_as_uint(g2), false, false)[hi ? 0 : 1]);
            const float og3 = __uint_as_float(__builtin_amdgcn_permlane32_swap(__float_as_uint(g3), __float_as_uint(g3), false, false)[hi ? 0 : 1]);
            const int oi1 = (int)__builtin_amdgcn_permlane32_swap((unsigned)i1, (unsigned)i1, false, false)[hi ? 0 : 1];
            const int oi2 = (int)__builtin_amdgcn_permlane32_swap((unsigned)i2, (unsigned)i2, false, false)[hi ? 0 : 1];
            const int oi3 = (int)__builtin_amdgcn_permlane32_swap((unsigned)i3, (unsigned)i3, false, false)[hi ? 0 : 1];
            if (oi1 != 255) ins3(og1, oi1, g1, i1, g2, i2, g3, i3);
            if (oi2 != 255) ins3(og2, oi2, g1, i1, g2, i2, g3, i3);
            if (oi3 != 255) ins3(og3, oi3, g1, i1, g2, i2, g3, i3);
        }
        if (hi == 0) {
#define P2_EMIT(j, r) do { if ((j) != 255) { const unsigned pos = __hip_atomic_fetch_add(cntL + (j), 1u, __ATOMIC_RELAXED, __HIP_MEMORY_SCOPE_WORKGROUP); \
                    seglist[((size_t)(bh * 32 + (j)) * 32 + cur) * 256 + pos] = (unsigned short)(tl | ((r) << 13)); } } while (0)
            P2_EMIT(i1, 0); P2_EMIT(i2, 1); P2_EMIT(i3, 2);
#undef P2_EMIT
        }
        LDS_WAIT(); __syncthreads();
        if (tid < cur) segcnt[(bh * 32 + tid) * 32 + cur] = cntL[tid];
        LDS_WAIT(); __syncthreads();
    }
}

__device__ __forceinline__ void p3_gathered(Frame& F, const Ptrs& P, int pass = 0) {
    const int tid_l = ltid(), lane_l = tid_l & 63; (void)lane_l;
    using namespace moba;
    unsigned char* ws = P.ws;
    const bf16* Q = (const bf16*)(ws + WS_Q); const bf16* K = (const bf16*)(ws + WS_K); const bf16* V = (const bf16*)(ws + WS_V);
    const unsigned* segcnt = (const unsigned*)(ws + WS_SEGCNT); const unsigned short* seglist = (const unsigned short*)(ws + WS_SEGLIST);
    float* plse = (float*)(ws + WS_PLSE);
    LAS unsigned short* ql = (LAS unsigned short*)(F.lds + L_QL); LAS unsigned* misc = (LAS unsigned*)(F.lds + L_MISC);
    LAS float* wsf = (LAS float*)(F.lds + L_WS) + F.wave * 256; LAS unsigned short* stg = (LAS unsigned short*)(F.lds + L_STG) + F.wave * 2048;
    const int tid = tid_l, lane = lane_l, wid = F.wave, r32 = lane & 31, hi = lane >> 5;
    for (;;) {
        if (tid == 0) misc[0] = __hip_atomic_fetch_add(F.ctl + CW_Q3 + 64 * pass, 1u, RLX_AGENT);
        LDS_WAIT(); __syncthreads();
        const int item = (int)misc[0];
        if (item >= 31 * 32) break;
        const int j = item >> 5, bh = item & 31, b = bh >> 4, h = bh & 15;
        if (tid < 32) {
            const unsigned c = (tid > j) ? segcnt[(bh * 32 + j) * 32 + tid] : 0u; unsigned s = c;
#pragma unroll
            for (int o = 1; o < 32; o <<= 1) { const unsigned t = __shfl_up(s, o, 32); if (tid >= o) s += t; }
            misc[32 + tid] = s - c; misc[64 + tid] = c; if (tid == 31) misc[1] = s;
        }
        LDS_WAIT(); __syncthreads();
        const int n = (int)misc[1];
        for (int cur = j + 1; cur < 32; ++cur) { const int c = (int)misc[64 + cur], off = (int)misc[32 + cur]; const unsigned short* sp = seglist + ((size_t)(bh * 32 + j) * 32 + cur) * 256;
            for (int i = tid; i < c; i += NWAVES * 64) ql[off + i] = sp[i]; }
        stage_kv(K, V, b, h, j, F.lds, wid, lane);
        const int ngroups = (n + 31) >> 5;
        for (int g = wid; g < ngroups; g += NWAVES) {
            const int idx = g * 32 + r32; const unsigned e = ql[idx < n ? idx : n - 1]; const int tl = (int)(e & 8191u);
            const bf16* qp = Q + (size_t)(b * SEQ + tl) * D + h * HD + hi * 8;
            bf16x8 qr[4];
#pragma unroll
            for (int d0 = 0; d0 < 4; ++d0) qr[d0] = *(const bf16x8*)(qp + d0 * 16);
            f32x16 o0, o1; float mhat, lsum;
            wave_block<false>(qr, (lds_cptr)(F.lds + L_K), (lds_cptr)(F.lds + L_V), 4, 0, wsf, lane, o0, o1, mhat, lsum);
            stage_o(o0, o1, lsum, wsf, stg, lane);
            if (hi == 0 && idx < n) plse[((size_t)(e >> 13) * M + (size_t)(b * SEQ + tl)) * 16 + h] = mhat + __builtin_amdgcn_logf(lsum);
#pragma unroll
            for (int i = 0; i < 4; ++i) { const int row = i * 8 + (lane >> 3), ch = lane & 7, ix = g * 32 + row;
                if (ix < n) { const unsigned e2 = ql[ix]; const unsigned rk = e2 >> 13; const size_t t2 = (size_t)(b * SEQ) + (e2 & 8191u);
                    unsigned char* pb = (rk == 2u) ? (ws + WS_P2) : ((unsigned char*)P.out + (size_t)rk * PART_STRIDE);
                    *(u32x4*)(pb + (t2 * D + h * HD + ch * 8) * 2) = *(const LAS u32x4*)(stg + row * 64 + ch * 8); } }
            LDS_WAIT();
        }
        LDS_WAIT(); __syncthreads();
    }
}

__device__ __forceinline__ void p4_own_combine(Frame& F, const Ptrs& P) {
    const int tid_l = ltid(), lane_l = tid_l & 63; (void)lane_l;
    using namespace moba;
    unsigned char* ws = P.ws; asm volatile("" : "+v"(ws));
    unsigned char* outp = (unsigned char*)P.out; asm volatile("" : "+v"(outp));
    const bf16* Q = (const bf16*)(ws + WS_Q); const bf16* K = (const bf16*)(ws + WS_K); const bf16* V = (const bf16*)(ws + WS_V); bf16* O = (bf16*)(ws + WS_AB);
    const float* plse = (const float*)(ws + WS_PLSE);
    const int lane = lane_l, wid = F.wave, r32 = lane & 31, hi = lane >> 5, widv = tid_l >> 6;
    LAS float* wsf = (LAS float*)(F.lds + L_WS) + widv * 256; LAS unsigned short* stg = (LAS unsigned short*)(F.lds + L_STG) + widv * 2048;
    for (int unit = F.vcu; unit < BATCH * NH * NBLK; unit += F.G) {
        const int bh = unit >> 5, cur = unit & 31, b = bh >> 4, h = bh & 15;
        stage_kv(K, V, b, h, cur, F.lds, wid, lane);
        const size_t t0 = (size_t)b * SEQ + (size_t)cur * MB + widv * 32;
        const bf16* qp = Q + (t0 + r32) * D + h * HD + hi * 8;
        bf16x8 qr[4];
#pragma unroll
        for (int d0 = 0; d0 < 4; ++d0) qr[d0] = *(const bf16x8*)(qp + d0 * 16);
        f32x16 o0, o1; float mhat, lsum;
        wave_block<true>(qr, (lds_cptr)(F.lds + L_K), (lds_cptr)(F.lds + L_V), (wid >> 1) + 1, widv * 32 + r32, wsf, lane, o0, o1, mhat, lsum);
        stage_o(o0, o1, lsum, wsf, stg, lane);
        const int nv = cur < 3 ? cur : 3;
        { const float l0 = mhat + __builtin_amdgcn_logf(lsum); float lr[3]; float mx = l0;
#pragma unroll
          for (int r = 0; r < 3; ++r) { lr[r] = (r < nv) ? plse[((size_t)r * M + t0 + r32) * 16 + h] : -INFINITY; mx = __builtin_fmaxf(mx, lr[r]); }
          const float w0 = __builtin_amdgcn_exp2f(l0 - mx); float wr[3]; float ws_ = w0;
#pragma unroll
          for (int r = 0; r < 3; ++r) { wr[r] = __builtin_amdgcn_exp2f(lr[r] - mx); ws_ += wr[r]; }
          const float inv = 1.0f / ws_;
          if (hi == 0) { wsf[64 + r32 * 4] = w0 * inv; wsf[64 + r32 * 4 + 1] = wr[0] * inv; wsf[64 + r32 * 4 + 2] = wr[1] * inv; wsf[64 + r32 * 4 + 3] = wr[2] * inv; } }
        LDS_WAIT();
#pragma unroll
        for (int i = 0; i < 4; ++i) { const int row = i * 8 + (lane >> 3), ch = lane & 7; const size_t off = (t0 + row) * D + h * HD + ch * 8;
            const u32x4 ow = *(const LAS u32x4*)(stg + row * 64 + ch * 8); const float w0 = wsf[64 + row * 4];
            float a[8] = {w0 * bflo(ow.x), w0 * bfhi(ow.x), w0 * bflo(ow.y), w0 * bfhi(ow.y), w0 * bflo(ow.z), w0 * bfhi(ow.z), w0 * bflo(ow.w), w0 * bfhi(ow.w)};
#pragma unroll
            for (int r = 0; r < 3; ++r) if (r < nv) { const unsigned char* pb = (r == 2) ? (ws + WS_P2) : (outp + (size_t)r * PART_STRIDE);
                const u32x4 pw = *(const u32x4*)(pb + off * 2); const float w = wsf[64 + row * 4 + 1 + r];
                a[0] += w * bflo(pw.x); a[1] += w * bfhi(pw.x); a[2] += w * bflo(pw.y); a[3] += w * bfhi(pw.y); a[4] += w * bflo(pw.z); a[5] += w * bfhi(pw.z); a[6] += w * bflo(pw.w); a[7] += w * bfhi(pw.w); }
            v4u w; w.x = pk2(a[0], a[1]); w.y = pk2(a[2], a[3]); w.z = pk2(a[4], a[5]); w.w = pk2(a[6], a[7]); *(v4u*)(O + off) = w; }
        LDS_WAIT(); __syncthreads();
    }
}

namespace mls {
using namespace moba;
typedef float f32x4v __attribute__((ext_vector_type(4)));
constexpr int XTRA_OFF = LDSCTL_OFF + 512;
__device__ __forceinline__ float softcap_f(float g) { const float x = g * (1.0f / SOFTCAP); const float e = fexp(2.0f * x); return SOFTCAP * (e - 1.0f) / (e + 1.0f); }
__device__ __forceinline__ float logsigmoid_f(float f) { return fminf(f, 0.f) - __builtin_amdgcn_logf(1.0f + fexp(-fabsf(f))) * 0.6931471805599453f; }
__device__ __forceinline__ float scan_add(float v, int lane) {
#pragma unroll
    for (int o = 1; o < 64; o <<= 1) { const float t = __shfl_up(v, o); if (lane >= o) v += t; }
    return v; }
__device__ __forceinline__ float scan_max(float v, int lane) {
#pragma unroll
    for (int o = 1; o < 64; o <<= 1) { const float t = __shfl_up(v, o); if (lane >= o) v = fmaxf(v, t); }
    return v; }
__device__ __forceinline__ bf16x8 trfrag(lds_cptr p, int ks) { const s16x4 lo = vtr(p + ks * 1024), hi = vtr(p + ks * 1024 + 512); return (bf16x8){lo[0], lo[1], lo[2], lo[3], hi[0], hi[1], hi[2], hi[3]}; }
__device__ __forceinline__ v4u scale8(const v4u w, float s) { v4u o; o.x = cvtpk_s(bflo(w.x) * s, bfhi(w.x) * s); o.y = cvtpk_s(bflo(w.y) * s, bfhi(w.y) * s); o.z = cvtpk_s(bflo(w.z) * s, bfhi(w.z) * s); o.w = cvtpk_s(bflo(w.w) * s, bfhi(w.w) * s); return o; }
}

__device__ __forceinline__ void pa_mlstm_local(Frame& F, const Ptrs& P) {
    const int tid_l = ltid(), lane_l = tid_l & 63; (void)lane_l;
    using namespace mls;
    unsigned char* ws = P.ws;
    const bf16* HB = (const bf16*)(ws + WS_AB); const bf16* MK = (const bf16*)(ws + WS_MK); const bf16* MV = (const bf16*)(ws + WS_MV);
    const bf16* WGb = (const bf16*)(ws + WS_WG); const float* ssq = (const float*)(ws + WS_SSQ) + (size_t)2 * M * 16;
    bf16* cloc = (bf16*)(ws + WS_CLOC); float* nloc = (float*)(ws + WS_NLOC); float* scal = (float*)(ws + WS_SCAL); float* BIG = (float*)(ws + WS_BIG);
    const int tid = tid_l, lane = tid & 63, wid = F.wave, r32 = lane & 31, hi = lane >> 5, fr = lane & 15, fq = lane >> 4;
    LAS float* gpart = (LAS float*)(F.lds + RING_OFF);
    LAS float* igA = (LAS float*)(F.lds + XTRA_OFF); LAS float* lfA = igA + 8 * 64;
    LAS unsigned char* kimg = F.lds + RING_OFF + wid * 16384; LAS unsigned char* vimg = kimg + 8192;
    const lds_cptr ktr = (lds_cptr)kimg + ((lane >> 4) & 1) * 32 + (lane & 3) * 8 + (4 * hi + ((lane & 15) >> 2)) * 64;
    const lds_cptr vtrp = ktr + 8192;
    for (int unit = F.vcu; unit < BATCH * NCH; unit += F.G) {
        const int b = unit >> 7, c = unit & 127; const size_t t0 = (size_t)b * SEQ + (size_t)c * LCH;
        {
            pg8::f32x4 acc[4];
#pragma unroll
            for (int m = 0; m < 4; ++m) acc[m] = (pg8::f32x4){0.f, 0.f, 0.f, 0.f};
#pragma unroll
            for (int ks = 0; ks < 4; ++ks) { const int k0 = wid * 128 + ks * 32 + fq * 8;
                const bf16x8 bw = *(const bf16x8*)(WGb + (size_t)fr * D + k0);
#pragma unroll
                for (int m = 0; m < 4; ++m) { const bf16x8 a = *(const bf16x8*)(HB + (t0 + m * 16 + fr) * D + k0); acc[m] = __builtin_amdgcn_mfma_f32_16x16x32_bf16(a, bw, acc[m], 0, 0, 0); } }
#pragma unroll
            for (int m = 0; m < 4; ++m)
#pragma unroll
                for (int r = 0; r < 4; ++r) gpart[(wid * 64 + m * 16 + 4 * fq + r) * 16 + fr] = acc[m][r];
        }
        LDS_WAIT(); __syncthreads();
#pragma unroll
        for (int e = 0; e < 2; ++e) { const int o = tid * 2 + e, row = o >> 4, col = o & 15; float s = 0.f;
#pragma unroll
            for (int w = 0; w < 8; ++w) s += gpart[(w * 64 + row) * 16 + col];
            const float val = softcap_f(s * pg8::row_rstd(ssq, (int)t0 + row) + P.b_gates[col]);
            if (col < 8) igA[col * 64 + row] = val; else lfA[(col - 8) * 64 + row] = logsigmoid_f(val); }
        LDS_WAIT(); __syncthreads();
        const int h = wid, mu = (b * MH + h) * NCH + c;
        const float ig = igA[h * 64 + lane], bcum = scan_add(lfA[h * 64 + lane], lane), bL = __shfl(bcum, 63);
        const float a = bL - bcum + ig, ml = wave_max(a), wgt = fexp(a - ml);
        BIG[(size_t)mu * 128 + lane] = bcum; BIG[(size_t)mu * 128 + 64 + lane] = ig;
        if (lane == 0) { scal[mu] = ml; scal[NUNIT + mu] = bL; }
        {
            const v4u* kp = (const v4u*)(MK + (t0 + lane) * 512 + h * DK);
#pragma unroll
            for (int ch = 0; ch < 8; ++ch) *(LAS v4u*)(kimg + (ch >> 2) * 4096 + lane * 64 + (ch & 3) * 16) = scale8(kp[ch], wgt);
        }
#pragma unroll 1
        for (int rv = 0; rv < 2; ++rv) {
            { const v4u* vp = (const v4u*)(MV + (t0 + lane) * 1024 + h * DV + rv * 64);
#pragma unroll
              for (int ch = 0; ch < 8; ++ch) *(LAS v4u*)(vimg + (ch >> 2) * 4096 + lane * 64 + (ch & 3) * 16) = vp[ch]; }
            LDS_WAIT();
#pragma unroll
            for (int kt = 0; kt < 2; ++kt) {
                bf16x8 af[4];
#pragma unroll
                for (int ks = 0; ks < 4; ++ks) af[ks] = trfrag(ktr + kt * 4096, ks);
#pragma unroll
                for (int vt = 0; vt < 2; ++vt) {
                    f32x16 d = f32x16{};
#pragma unroll
                    for (int ks = 0; ks < 4; ++ks) d = MOBA_MFMA(af[ks], trfrag(vtrp + vt * 4096, ks), d);
                    bf16* cp = cloc + (size_t)mu * 8192 + (size_t)(rv * 64 + vt * 32 + r32) * 64 + kt * 32 + 4 * hi;
#pragma unroll
                    for (int g = 0; g < 4; ++g) { uint2 w; w.x = cvtpk_s(d[4 * g], d[4 * g + 1]); w.y = cvtpk_s(d[4 * g + 2], d[4 * g + 3]); *(uint2*)(cp + 8 * g) = w; }
                }
                if (rv == 0) {
                    const bf16x8 ones = (bf16x8){0x3F80, 0x3F80, 0x3F80, 0x3F80, 0x3F80, 0x3F80, 0x3F80, 0x3F80};
                    f32x16 d = f32x16{};
#pragma unroll
                    for (int ks = 0; ks < 4; ++ks) d = MOBA_MFMA(af[ks], ones, d);
                    if (r32 == 0) {
#pragma unroll
                        for (int r = 0; r < 16; ++r) nloc[(size_t)mu * 64 + kt * 32 + crow(r, hi)] = d[r]; }
                }
            }
            LDS_WAIT();
        }
        LDS_WAIT(); __syncthreads();
    }
}
__device__ __forceinline__ void pb_mlstm_scan(Frame& F, const Ptrs& P, bool dry = false) {
    const int tid_l = ltid(), lane_l = tid_l & 63; (void)lane_l;
    unsigned char* ws = P.ws;
    bf16* cloc = (bf16*)(ws + WS_CLOC); float* nloc = (float*)(ws + WS_NLOC); float* scal = (float*)(ws + WS_SCAL);
    LAS float* dec = (LAS float*)(F.lds + RING_OFF); LAS float* scl = dec + NCH;
    const int tid = tid_l;
    for (int unit = F.vcu; unit < BATCH * MH * 16; unit += F.G) {
        const int bh = unit >> 4, sl = unit & 15;
        if (tid < 64) {
            float mp = 0.f;
            for (int c = 0; c < NCH; ++c) { const int mu = bh * NCH + c; const float ml = scal[mu], bl = scal[NUNIT + mu];
                const float mn = fmaxf(bl + mp, ml);
                if (tid == 0) { dec[c] = fexp(bl + mp - mn); scl[c] = fexp(ml - mn); if (sl == 0 && !dry) scal[2 * NUNIT + mu] = mp; }
                mp = mn; }
        }
        LDS_WAIT(); __syncthreads();
        { bf16* p = cloc + (size_t)bh * NCH * 8192 + sl * 512 + tid; bf16* pw = dry ? p + (size_t)32 * MiB / 2 : p; float st = 0.f;
#pragma unroll 1
          for (int c0 = 0; c0 < NCH; c0 += 16) { unsigned short x[16];
#pragma unroll
              for (int i = 0; i < 16; ++i) x[i] = p[(size_t)(c0 + i) * 8192];
#pragma unroll
              for (int i = 0; i < 16; ++i) { pw[(size_t)(c0 + i) * 8192] = (bf16)f2bf(st); st = dec[c0 + i] * st + scl[c0 + i] * bf2f(x[i]); } } }
        if (sl == 0 && tid < 64 && !dry) { float* p = nloc + (size_t)bh * NCH * 64 + tid; float st = 0.f;
#pragma unroll 1
            for (int c0 = 0; c0 < NCH; c0 += 16) { float x[16];
#pragma unroll
                for (int i = 0; i < 16; ++i) x[i] = p[(size_t)(c0 + i) * 64];
#pragma unroll
                for (int i = 0; i < 16; ++i) { p[(size_t)(c0 + i) * 64] = st; st = dec[c0 + i] * st + scl[c0 + i] * x[i]; } } }
        LDS_WAIT(); __syncthreads();
    }
}
__device__ __forceinline__ void pc_mlstm_out(Frame& F, const Ptrs& P) {
    const int tid_l = ltid(), lane_l = tid_l & 63; (void)lane_l;
    using namespace mls;
    unsigned char* ws = P.ws;
    const bf16* MQ = (const bf16*)(ws + WS_MQ); const bf16* MK = (const bf16*)(ws + WS_MK); const bf16* MV = (const bf16*)(ws + WS_MV); const bf16* OG = (const bf16*)(ws + WS_OG);
    const bf16* cin = (const bf16*)(ws + WS_CLOC); const float* nin = (const float*)(ws + WS_NLOC); const float* scal = (const float*)(ws + WS_SCAL); const float* BIG = (const float*)(ws + WS_BIG);
    bf16* Y = (bf16*)(ws + WS_AB);
    const int tid = tid_l, lane = tid & 63, wid = F.wave, r32 = lane & 31, hi = lane >> 5, qg = wid & 1, vt = wid >> 1;
    constexpr int LK = 0, LV = 8192, LH = 24576, HP = 132;
    LAS float* hst = (LAS float*)(F.lds + RING_OFF + LH);
    LAS float* garr = (LAS float*)(F.lds + mls::XTRA_OFF); LAS float* mmarr = garr + 64; LAS float* barr = mmarr + 64; LAS float* nn = barr + 64; LAS float* wsf = nn + 64 + wid * 64;
    const lds_cptr kp0 = (lds_cptr)(F.lds + RING_OFF + LK) + hi * 1024 + r32 * 16;
    const lds_cptr vp0 = (lds_cptr)(F.lds + RING_OFF + LV) + vt * 4096 + ((lane >> 4) & 1) * 32 + (lane & 3) * 8 + (4 * hi + ((lane & 15) >> 2)) * 64;
    for (int unit = F.vcu; unit < NUNIT; unit += F.G) {
        const int bh = unit >> 7, c = unit & 127, b = bh >> 3, h = bh & 7; const size_t t0 = (size_t)b * SEQ + (size_t)c * LCH;
        const float m_in = scal[2 * NUNIT + unit];
        {
            const unsigned lds0 = (unsigned)(uintptr_t)(F.lds + RING_OFF);
            glds16(MK + (t0 + lane) * 512 + h * DK + wid * 8, (unsigned)__builtin_amdgcn_readfirstlane(lds0 + LK + wid * 1024));
#pragma unroll
            for (int i = 0; i < 2; ++i) { const int p = wid + 8 * i;
                glds16(MV + (t0 + 16 * (p & 3) + (lane >> 2)) * 1024 + h * DV + (p >> 2) * 32 + (lane & 3) * 8, (unsigned)__builtin_amdgcn_readfirstlane(lds0 + LV + p * 1024)); }
        }
        if (wid == 0) {
            const float bc = BIG[(size_t)unit * 128 + lane], g = BIG[(size_t)unit * 128 + 64 + lane] - bc;
            garr[lane] = g; mmarr[lane] = fmaxf(m_in, scan_max(g, lane)); barr[lane] = bc; nn[lane] = nin[(size_t)unit * 64 + lane];
        }
        asm volatile("s_waitcnt vmcnt(0) lgkmcnt(0)\n\ts_barrier" ::: "memory");
        {
            const int l = qg * 32 + r32;
            const bf16* qp = MQ + (t0 + l) * 512 + h * DK + hi * 8;
            bf16x8 qr[4], cf[4];
#pragma unroll
            for (int d0 = 0; d0 < 4; ++d0) qr[d0] = *(const bf16x8*)(qp + d0 * 16);
            const bf16* cp = cin + (size_t)unit * 8192 + (size_t)(vt * 32 + r32) * 64 + hi * 8;
#pragma unroll
            for (int d0 = 0; d0 < 4; ++d0) cf[d0] = *(const bf16x8*)(cp + d0 * 16);
            bf16x8 kf[8];
#pragma unroll
            for (int d0 = 0; d0 < 4; ++d0) { kf[2 * d0] = *(const LAS bf16x8*)(kp0 + d0 * 2048); kf[2 * d0 + 1] = *(const LAS bf16x8*)(kp0 + d0 * 2048 + 512); }
            f32x16 c0 = f32x16{}, c1 = f32x16{};
#pragma unroll
            for (int d0 = 0; d0 < 4; ++d0) { c0 = MOBA_MFMA(kf[2 * d0], qr[d0], c0); c1 = MOBA_MFMA(kf[2 * d0 + 1], qr[d0], c1); }
            const float mml = mmarr[l];
            float rsum = 0.f; int lrel = l - 4 * hi; asm volatile("" : "+v"(lrel));
#pragma unroll
            for (int r = 0; r < 16; ++r) { const int s0 = crow(r, hi), s1 = s0 + 32, sr = (r & 3) + 8 * (r >> 2);
                const float e0 = __builtin_amdgcn_exp2f((garr[s0] - mml) * LOG2E), e1 = __builtin_amdgcn_exp2f((garr[s1] - mml) * LOG2E);
                c0[r] = __builtin_bit_cast(float, __builtin_bit_cast(unsigned, c0[r] * e0) & ~(unsigned)((lrel - sr) >> 31));
                c1[r] = __builtin_bit_cast(float, __builtin_bit_cast(unsigned, c1[r] * e1) & ~(unsigned)((lrel - sr - 32) >> 31)); rsum += c0[r] + c1[r]; }
            rsum = halves_sum(rsum);
            float qn = 0.f;
#pragma unroll
            for (int d0 = 0; d0 < 4; ++d0)
#pragma unroll
                for (int j = 0; j < 8; ++j) qn += bf2f((unsigned short)qr[d0][j]) * nn[d0 * 16 + hi * 8 + j];
            qn = halves_sum(qn);
            const float inter = fexp(m_in - mml), den = inter * qn + rsum, rd = 1.0f / fmaxf(fabsf(den), fexp(-(barr[l] + mml)));
            if (hi == 0) { wsf[r32] = inter; wsf[32 + r32] = rd; }
            f32x16 o = f32x16{};
#pragma unroll
            for (int d0 = 0; d0 < 4; ++d0) o = MOBA_MFMA(qr[d0], cf[d0], o);
            asm volatile("s_waitcnt lgkmcnt(0)" ::: "memory");
#pragma unroll
            for (int r = 0; r < 16; ++r) o[r] *= wsf[crow(r, hi)];
            u32x4 pw0, pw1, pw2, pw3;
            pw0 = (u32x4){cvtpk_s(c0[0], c0[1]), cvtpk_s(c0[2], c0[3]), cvtpk_s(c0[4], c0[5]), cvtpk_s(c0[6], c0[7])}; pw1 = (u32x4){cvtpk_s(c0[8], c0[9]), cvtpk_s(c0[10], c0[11]), cvtpk_s(c0[12], c0[13]), cvtpk_s(c0[14], c0[15])};
            pw2 = (u32x4){cvtpk_s(c1[0], c1[1]), cvtpk_s(c1[2], c1[3]), cvtpk_s(c1[4], c1[5]), cvtpk_s(c1[6], c1[7])}; pw3 = (u32x4){cvtpk_s(c1[8], c1[9]), cvtpk_s(c1[10], c1[11]), cvtpk_s(c1[12], c1[13]), cvtpk_s(c1[14], c1[15])};
            o = MOBA_MFMA(__builtin_bit_cast(bf16x8, pw0), trfrag(vp0, 0), o); o = MOBA_MFMA(__builtin_bit_cast(bf16x8, pw1), trfrag(vp0, 1), o);
            o = MOBA_MFMA(__builtin_bit_cast(bf16x8, pw2), trfrag(vp0, 2), o); o = MOBA_MFMA(__builtin_bit_cast(bf16x8, pw3), trfrag(vp0, 3), o);
#pragma unroll
            for (int r = 0; r < 16; ++r) hst[(qg * 32 + crow(r, hi)) * HP + vt * 32 + r32] = o[r] * wsf[32 + crow(r, hi)];
        }
        LDS_WAIT(); __syncthreads();
        {
            const int l = tid >> 3, vb = (tid & 7) * 16; float hv[16]; float ss = 0.f;
#pragma unroll
            for (int j = 0; j < 4; ++j) { const mls::f32x4v x = *(const LAS mls::f32x4v*)(hst + l * HP + vb + 4 * j); hv[4 * j] = x.x; hv[4 * j + 1] = x.y; hv[4 * j + 2] = x.z; hv[4 * j + 3] = x.w; ss += (x.x * x.x + x.y * x.y) + (x.z * x.z + x.w * x.w); }
            ss += __shfl_xor(ss, 1); ss += __shfl_xor(ss, 2); ss += __shfl_xor(ss, 4);
            const float r = __builtin_amdgcn_rsqf(ss * (1.0f / 128.0f) + RMS_EPS);
            const size_t off = (t0 + l) * D + h * DV + vb; const v4u* gp = (const v4u*)(OG + off); const f32x4* np = (const f32x4*)(P.head_norm + h * DV + vb);
            float y[16];
#pragma unroll
            for (int i = 0; i < 2; ++i) { const v4u u = gp[i]; const f32x4 n0 = np[2 * i], n1 = np[2 * i + 1];
                y[8 * i] = bflo(u.x) * hv[8 * i] * r * n0.x; y[8 * i + 1] = bfhi(u.x) * hv[8 * i + 1] * r * n0.y; y[8 * i + 2] = bflo(u.y) * hv[8 * i + 2] * r * n0.z; y[8 * i + 3] = bfhi(u.y) * hv[8 * i + 3] * r * n0.w;
                y[8 * i + 4] = bflo(u.z) * hv[8 * i + 4] * r * n1.x; y[8 * i + 5] = bfhi(u.z) * hv[8 * i + 5] * r * n1.y; y[8 * i + 6] = bflo(u.w) * hv[8 * i + 6] * r * n1.z; y[8 * i + 7] = bfhi(u.w) * hv[8 * i + 7] * r * n1.w; }
            v4u* yp = (v4u*)(Y + off);
#pragma unroll
            for (int i = 0; i < 2; ++i) { v4u o; o.x = pk2(y[8 * i], y[8 * i + 1]); o.y = pk2(y[8 * i + 2], y[8 * i + 3]); o.z = pk2(y[8 * i + 4], y[8 * i + 5]); o.w = pk2(y[8 * i + 6], y[8 * i + 7]); yp[i] = o; }
        }
        LDS_WAIT(); __syncthreads();
    }
}
__device__ __forceinline__ void p_final_norm(Frame& F, const Ptrs& P, bool dry = false) {
    const int tid_l = ltid(), lane_l = tid_l & 63; (void)lane_l;
    const int gw = F.vcu * NWAVES + F.wave, NGW = F.G * NWAVES;
    const f32x4* wn = (const f32x4*)P.final_norm + lane_l;
    for (int m = gw; m < M; m += NGW) {
        GAS f32x4* xr = (GAS f32x4*)(P.out + (size_t)m * D) + lane_l; f32x4 v[4]; float s = 0.f;
#pragma unroll
        for (int j = 0; j < 4; ++j) { v[j] = xr[64 * j]; s += (v[j].x * v[j].x + v[j].y * v[j].y) + (v[j].z * v[j].z + v[j].w * v[j].w); }
        const float r = __builtin_amdgcn_rsqf(wave_sum(s) * (1.0f / D) + RMS_EPS);
        { GAS f32x4* xw = dry ? (GAS f32x4*)((float*)(P.ws + WS_AB) + (size_t)m * D) + lane_l : xr;
#pragma unroll
        for (int j = 0; j < 4; ++j) xw[64 * j] = v[j] * r * wn[64 * j]; }
    }
}

struct Args { Ptrs p; };
__device__ __forceinline__ Ptrs load_ptrs() {
#if defined(__HIP_DEVICE_COMPILE__)
    typedef __attribute__((address_space(4))) const unsigned long long* kptr_t;
    kptr_t kp = (kptr_t)__builtin_amdgcn_kernarg_segment_ptr();
    asm volatile("" : "+s"(kp));
    Ptrs p;
    p.x = (const float*)kp[0]; p.attn_norm = (const float*)kp[1]; p.w_qkv = (const float*)kp[2]; p.w_o = (const float*)kp[3]; p.mlstm_norm = (const float*)kp[4]; p.w_in = (const float*)kp[5];
    p.b_gates = (const float*)kp[6]; p.head_norm = (const float*)kp[7]; p.w_out = (const float*)kp[8]; p.ffn_norm = (const float*)kp[9]; p.w_gu = (const float*)kp[10]; p.w_down = (const float*)kp[11];
    p.final_norm = (const float*)kp[12]; p.out = (float*)kp[13]; p.ws = (unsigned char*)kp[14];
    return p;
#else
    return Ptrs{};
#endif
}
__global__ void __launch_bounds__(NWAVES * 64, 2) mk_fwd(Args args) {
    extern __shared__ __attribute__((aligned(16))) unsigned char lds[];
    Frame F;
    F.lds = (LAS unsigned char*)lds;
    F.MISC = (volatile LAS unsigned*)(F.lds + MISC_OFF);
    F.wave = __builtin_amdgcn_readfirstlane((int)threadIdx.x >> 6);
    F.G = gridDim.x; { const int bx = blockIdx.x; F.vcu = (F.G % 8 == 0) ? (bx % 8) * (F.G / 8) + bx / 8 : bx; }
    F.ctl = (gu32*)(args.p.ws + WS_CTL);
    for (int u = ((int)threadIdx.x); u < (LDS_BYTES - LDSCTL_OFF) / 4; u += NWAVES * 64) ((LAS unsigned*)(F.lds + LDSCTL_OFF))[u] = 0u;
    __syncthreads();
    XcdBarrier bar = xcd_barrier_post((unsigned*)(F.ctl + CW_BAR), F.MISC + 8);
#define GRID_BAR() xcd_barrier(bar)
#ifndef PH_MASK
#define PH_MASK 0xFFFFF
#endif
#define PH(k) ((PH_MASK >> (k)) & 1)
#ifndef DUP_MASK
#define DUP_MASK 0
#endif
#ifndef EXTRA_BARS
#define EXTRA_BARS 0
#endif
#define REP(k) for (int rep_ = 0; rep_ <= ((DUP_MASK >> (k)) & 1); ++rep_)
#define PHASE_PTRS() const Ptrs P = load_ptrs(); unsigned char* const ws = P.ws; (void)ws
#define SSQ(i) ((float*)(ws + WS_SSQ) + (size_t)(i) * M * 16)

    REP(0) if (PH(0)) { PHASE_PTRS(); p0_prologue(F, P); } GRID_BAR();
    _Pragma("unroll 1") for (int xb_ = 0; xb_ < EXTRA_BARS; ++xb_) GRID_BAR();
    REP(1) if (PH(1)) { PHASE_PTRS(); pg8::Gemm g{(const bf16*)(ws + WS_AB), (const bf16*)(ws + WS_WQKV), M, 3 * D, D}; pg8::StaticOrder S; S.init(M, 3 * D, F.G, (int)blockIdx.x);
      pg8::EpiQKV E{(bf16*)(ws + WS_Q), (size_t)(WS_K - WS_Q) / 2, SSQ(0), (const float*)(ws + WS_ROPE), (float*)(ws + WS_KMEAN)};
      pg8::gemm_phase<pg8::EpiQKV, pg8::StaticOrder, PG8_ALIGN, PG8_SP2>(F.lds + RING_OFF, g, S, E); } GRID_BAR();
    REP(2) if (PH(2)) { PHASE_PTRS(); p2_gating(F, P); } GRID_BAR();
    REP(3) if (PH(3)) { PHASE_PTRS(); p3_gathered(F, P, rep_); } GRID_BAR();
    REP(15) if (PH(15)) { PHASE_PTRS(); p4_own_combine(F, P); } GRID_BAR();
    REP(4) if (PH(4)) { PHASE_PTRS(); pg8::Gemm g{(const bf16*)(ws + WS_AB), (const bf16*)(ws + WS_WO), M, D, D}; pg8::StaticOrder S; S.init(M, D, F.G, (int)blockIdx.x);
      pg8::EpiRes<true> E{P.x, P.out, (bf16*)(ws + WS_HB1), SSQ(1), 1};
      pg8::gemm_phase<pg8::EpiRes<true>, pg8::StaticOrder, PG8_ALIGN, PG8_SP2>(F.lds + RING_OFF, g, S, E); } GRID_BAR();
    REP(5) if (PH(5)) { PHASE_PTRS(); pg8::Gemm g{(const bf16*)(ws + WS_HB1), (const bf16*)(ws + WS_WGU), M, NGU, D}; pg8::StaticOrder S; S.init(M, NGU, F.G, (int)blockIdx.x);
      pg8::EpiSwiGLU E{(bf16*)(ws + WS_ACT), SSQ(1)};
      pg8::gemm_phase<pg8::EpiSwiGLU, pg8::StaticOrder, PG8_ALIGN, PG8_SP2>(F.lds + RING_OFF, g, S, E); } GRID_BAR();
    REP(6) if (PH(6)) { PHASE_PTRS(); pg8::Gemm g{(const bf16*)(ws + WS_ACT), (const bf16*)(ws + WS_WD), M, D, DFF}; pg8::StaticOrder S; S.init(M, D, F.G, (int)blockIdx.x);
      int live = (rep_ == ((DUP_MASK >> 6) & 1)); asm volatile("" : "+s"(live)); pg8::EpiRes<true> E{P.out, P.out, (bf16*)(ws + WS_AB), SSQ(2), live};
      pg8::gemm_phase<pg8::EpiRes<true>, pg8::StaticOrder, PG8_ALIGN, PG8_SP2>(F.lds + RING_OFF, g, S, E); } GRID_BAR();
    REP(7) if (PH(7)) { PHASE_PTRS(); pg8::Gemm g{(const bf16*)(ws + WS_AB), (const bf16*)(ws + WS_WIN), M, NIN, D}; pg8::StaticOrder S; S.init(M, NIN, F.G, (int)blockIdx.x);
      pg8::EpiMlstmIn E{(bf16*)(ws + WS_MQ), (bf16*)(ws + WS_MK), (bf16*)(ws + WS_MV), (bf16*)(ws + WS_OG), SSQ(2)};
      pg8::gemm_phase<pg8::EpiMlstmIn, pg8::StaticOrder, PG8_ALIGN, PG8_SP2>(F.lds + RING_OFF, g, S, E); } GRID_BAR();
    REP(8) if (PH(8)) { PHASE_PTRS(); pa_mlstm_local(F, P); } GRID_BAR();
    REP(9) if (PH(9)) { PHASE_PTRS(); pb_mlstm_scan(F, P, rep_ < ((DUP_MASK >> 9) & 1)); } GRID_BAR();
    REP(10) if (PH(10)) { PHASE_PTRS(); pc_mlstm_out(F, P); } GRID_BAR();
    if (PH(11)) { PHASE_PTRS(); pg8::Gemm g{(const bf16*)(ws + WS_AB), (const bf16*)(ws + WS_WOUT), M, D, D}; pg8::StaticOrder S; S.init(M, D, F.G, (int)blockIdx.x);
      pg8::EpiRes<true> E{P.out, P.out, (bf16*)(ws + WS_HB1), SSQ(3), 1};
      pg8::gemm_phase<pg8::EpiRes<true>, pg8::StaticOrder, PG8_ALIGN, PG8_SP2>(F.lds + RING_OFF, g, S, E); } GRID_BAR();
    if (PH(12)) { PHASE_PTRS(); pg8::Gemm g{(const bf16*)(ws + WS_HB1), (const bf16*)(ws + WS_WGU) + (size_t)NGU * D, M, NGU, D}; pg8::StaticOrder S; S.init(M, NGU, F.G, (int)blockIdx.x);
      pg8::EpiSwiGLU E{(bf16*)(ws + WS_ACT), SSQ(3)};
      pg8::gemm_phase<pg8::EpiSwiGLU, pg8::StaticOrder, PG8_ALIGN, PG8_SP2>(F.lds + RING_OFF, g, S, E); } GRID_BAR();
    if (PH(13)) { PHASE_PTRS(); pg8::Gemm g{(const bf16*)(ws + WS_ACT), (const bf16*)(ws + WS_WD) + (size_t)D * DFF, M, D, DFF}; pg8::StaticOrder S; S.init(M, D, F.G, (int)blockIdx.x);
      pg8::EpiRes<false> E{P.out, P.out, nullptr, nullptr, 1};
      pg8::gemm_phase<pg8::EpiRes<false>, pg8::StaticOrder, PG8_ALIGN, PG8_SP2>(F.lds + RING_OFF, g, S, E); } GRID_BAR();
    REP(14) if (PH(14)) { PHASE_PTRS(); p_final_norm(F, P, rep_ < ((DUP_MASK >> 14) & 1)); }
}

extern "C" void kernel_launch(void* const* d_in, const int* in_sizes, int n_in, void* d_out, int out_size, void* d_ws, size_t ws_size, hipStream_t stream) {
    static int grid = 0;
    if (grid == 0) {
        if (n_in != 13 || in_sizes[0] != M * D || out_size != M * D || ws_size < WS_END) { fprintf(stderr, "kernel_launch: unexpected shapes (n_in %d, in0 %d, out %d, ws %zu); nothing launched\n", n_in, n_in > 0 ? in_sizes[0] : -1, out_size, ws_size); grid = -1; return; }
        int dev = 0, cus = 0, per_cu = 0;
        if (hipGetDevice(&dev) != hipSuccess || hipDeviceGetAttribute(&cus, hipDeviceAttributeMultiprocessorCount, dev) != hipSuccess) { grid = -1; return; }
        if (hipFuncSetAttribute((const void*)mk_fwd, hipFuncAttributeMaxDynamicSharedMemorySize, LDS_BYTES) != hipSuccess) { fprintf(stderr, "kernel_launch: hipFuncSetAttribute failed\n"); grid = -1; return; }
        if (hipOccupancyMaxActiveBlocksPerMultiprocessor(&per_cu, (const void*)mk_fwd, NWAVES * 64, LDS_BYTES) != hipSuccess || per_cu < 1) { fprintf(stderr, "kernel_launch: occupancy query reports %d blocks per CU\n", per_cu); }
        (void)hipGetLastError();
        grid = cus;
    }
    if (grid < 0) return;
    if (hipMemsetAsync((char*)d_ws + WS_CTL, 0, CTL_ZERO_BYTES, stream) != hipSuccess) { fprintf(stderr, "kernel_launch: hipMemsetAsync failed\n"); return; }
    Args a{};
    a.p.x = (const float*)d_in[0]; a.p.attn_norm = (const float*)d_in[1]; a.p.w_qkv = (const float*)d_in[2]; a.p.w_o = (const float*)d_in[3];
    a.p.mlstm_norm = (const float*)d_in[4]; a.p.w_in = (const float*)d_in[5]; a.p.b_gates = (const float*)d_in[6]; a.p.head_norm = (const float*)d_in[7]; a.p.w_out = (const float*)d_in[8];
    a.p.ffn_norm = (const float*)d_in[9]; a.p.w_gu = (const float*)d_in[10]; a.p.w_down = (const float*)d_in[11]; a.p.final_norm = (const float*)d_in[12];
    a.p.out = (float*)d_out; a.p.ws = (unsigned char*)d_ws;
    hipLaunchKernelGGL(mk_fwd, dim3(grid), dim3(NWAVES * 64), LDS_BYTES, stream, a);
    const hipError_t le = hipPeekAtLastError();
    if (le != hipSuccess) fprintf(stderr, "kernel_launch: launch failed: %s\n", hipGetErrorName(le));
}
```

```cpp
#include <hip/hip_runtime.h>
#include <cstdio>
#include <cstdint>
namespace pg8 {
#define PG8_LAS __attribute__((address_space(3)))
typedef unsigned short bf16_t;
typedef short bf16x8 __attribute__((ext_vector_type(8)));
typedef float f32x4 __attribute__((ext_vector_type(4)));
typedef unsigned u32x4 __attribute__((ext_vector_type(4)));
constexpr int BM = 256, BK = 64, HALF = 128, HTB = HALF * BK * 2  , STAGE_BYTES = 8 * HTB, NXCD = 8, WGM = 8;

__host__ __device__ __forceinline__ int lds_byte(int r, int c) { const int st = (r >> 4) * 2 + (c >> 5), rr = r & 15, cc = c & 31, ob = rr * 64 + cc * 2; return st * 1024 + (ob ^ (((ob >> 9) & 1) << 5)); }
__host__ __device__ __forceinline__ void stage_rc(int b, int& R, int& C) { const int st = b / 1024, sb = b % 1024, swz = sb ^ (((sb >> 9) & 1) << 5); R = (st >> 1) * 16 + swz / 64; C = (st & 1) * 32 + (swz % 64) / 2; }
__host__ __device__ __forceinline__ int perm32(int rho) { const int n = rho >> 4, i = rho & 15; return 8 * (i >> 2) + 4 * n + (i & 3); }

struct Unit { int pm, pn; };
struct Gemm { const bf16_t* A; const bf16_t* Bt; int M, N, K; };

struct StaticOrder {
    int nM, nN, nwg, G, c;
    __host__ __device__ void init(int M, int N, int G_, int c_) { nM = M / BM; nN = N / BM; nwg = nM * nN; G = G_; c = c_; }
    __host__ __device__ bool next(int i, Unit& u) const {
        const long L = (long)i * G + c; if (L >= nwg) return false;
        int wgid = (int)L; { const int q = nwg / NXCD, r = nwg % NXCD, xcd = wgid % NXCD, off = wgid / NXCD; wgid = (xcd < r ? xcd * (q + 1) : r * (q + 1) + (xcd - r) * q) + off; }
        const int nig = WGM * nN, gid = wgid / nig, fm = gid * WGM, gsz = (nM - fm) < WGM ? (nM - fm) : WGM;
        u.pm = fm + ((wgid % nig) % gsz); u.pn = (wgid % nig) / gsz; return true;
    }
    __device__ __forceinline__ void a_ready(const Unit&) const {}
    __device__ __forceinline__ void done(const Unit&) const {}
};
__device__ __forceinline__ unsigned cvt_pk_bf16(float lo, float hi) { unsigned r; asm volatile("v_cvt_pk_bf16_f32 %0, %1, %2" : "=v"(r) : "v"(lo), "v"(hi)); return r; }
typedef float f32x2 __attribute__((ext_vector_type(2)));
constexpr float RMS_EPS_F = 1e-6f;
constexpr float QSCALE_LOG2 = 0.18033688011112042f;
__device__ __forceinline__ float row_rstd(const float* ssq, int row) {
    const f32x4* p = (const f32x4*)(ssq + (size_t)row * 16);
    const f32x4 a = p[0], b = p[1], c = p[2], d = p[3];
    const float s = (((a[0] + a[1]) + (a[2] + a[3])) + ((b[0] + b[1]) + (b[2] + b[3]))) + (((c[0] + c[1]) + (c[2] + c[3])) + ((d[0] + d[1]) + (d[2] + d[3])));
    return __builtin_amdgcn_rsqf(s * (1.0f / 1024.0f) + RMS_EPS_F);
}
__device__ __forceinline__ u32x4 pack8(const f32x4& v0, const f32x4& v1) { u32x4 w; w.x = cvt_pk_bf16(v0[0], v0[1]); w.y = cvt_pk_bf16(v0[2], v0[3]); w.z = cvt_pk_bf16(v1[0], v1[1]); w.w = cvt_pk_bf16(v1[2], v1[3]); return w; }

struct EpiQKV {
    static constexpr bool PERM = true, AFTER_DRAIN = false;
    bf16_t* QKV; size_t tstride; const float* ssq; const float* rope; float* kmean;
    __device__ __forceinline__ void operator()(const f32x4 (&acc)[2][2][4][2], const Unit& u, int wr, int wc, int fr, int fq) const {
        const int t = u.pn >> 2;
        bf16_t* base = QKV + (size_t)t * tstride;
        const int col0 = (u.pn & 3) * BM + wc * 32 + 8 * fq;
        const bool rot = (t < 2) && ((wc & 1) == 0) && (fq < 2);
        const float sc = (t == 0) ? QSCALE_LOG2 : 1.0f;
        const int lane = fq * 16 + fr;
        float rv[2];
#pragma unroll
        for (int ai = 0; ai < 2; ++ai) rv[ai] = row_rstd(ssq, u.pm * BM + ai * HALF + wr * 64 + lane);
#pragma unroll
        for (int bj = 0; bj < 2; ++bj) {
            f32x4 ks0 = (f32x4){0.f, 0.f, 0.f, 0.f}, ks1 = ks0;
#pragma unroll
            for (int ai = 0; ai < 2; ++ai)
#pragma unroll
                for (int m = 0; m < 4; ++m) {
                    const int row = u.pm * BM + ai * HALF + wr * 64 + m * 16 + fr;
                    const float rs = __shfl(rv[ai], m * 16 + fr);
                    f32x4 v0 = acc[ai][bj][m][0] * rs, v1 = acc[ai][bj][m][1] * rs;
                    if (rot) { const f32x4* rp = (const f32x4*)(rope + (size_t)(row & 8191) * 16 + 8 * fq); const f32x4 cs0 = rp[0], cs1 = rp[1];
                        const f32x4 c = (f32x4){cs0[0], cs0[2], cs1[0], cs1[2]}, s = (f32x4){cs0[1], cs0[3], cs1[1], cs1[3]};
                        const f32x4 x1 = v0, x2 = v1; v0 = x1 * c - x2 * s; v1 = x2 * c + x1 * s; }
                    if (t == 1) { ks0 += v0; ks1 += v1; }
                    v0 = v0 * sc; v1 = v1 * sc;
                    *(u32x4*)(base + (size_t)row * 1024 + col0 + bj * HALF) = pack8(v0, v1);
                    asm volatile("" ::: "memory");
                }
            if (t == 1) {
                float* km = kmean + (size_t)u.pm * 1024 + col0 + bj * HALF;
#pragma unroll
                for (int j = 0; j < 4; ++j) {
                    float r0 = ks0[j]; r0 += __shfl_xor(r0, 1); r0 += __shfl_xor(r0, 2); r0 += __shfl_xor(r0, 4); r0 += __shfl_xor(r0, 8);
                    float r1 = ks1[j]; r1 += __shfl_xor(r1, 1); r1 += __shfl_xor(r1, 2); r1 += __shfl_xor(r1, 4); r1 += __shfl_xor(r1, 8);
                    if (fr == 0) { atomicAdd(km + j, r0 * (1.0f / 256.0f)); atomicAdd(km + 4 + j, r1 * (1.0f / 256.0f)); }
                }
            }
        }
    }
};

template <bool BASE_F32, bool OUT_F32> struct EpiRes {
    static constexpr bool PERM = true, AFTER_DRAIN = false;
    const void* base; void* out; float* ssq_out;
    __device__ __forceinline__ void operator()(const f32x4 (&acc)[2][2][4][2], const Unit& u, int wr, int wc, int fr, int fq) const {
        const int col0 = u.pn * BM + wc * 32 + 8 * fq;
#pragma unroll
        for (int ai = 0; ai < 2; ++ai)
#pragma unroll
            for (int m = 0; m < 4; ++m) {
                const int row = u.pm * BM + ai * HALF + wr * 64 + m * 16 + fr;
                float ss = 0.f;
#pragma unroll
                for (int bj = 0; bj < 2; ++bj) {
                    const size_t off = (size_t)row * 1024 + col0 + bj * HALF;
                    f32x4 b0, b1;
                    if (BASE_F32) { b0 = *(const f32x4*)((const float*)base + off); b1 = *(const f32x4*)((const float*)base + off + 4); }
                    else { const u32x4 w = *(const u32x4*)((const bf16_t*)base + off);
                        b0 = (f32x4){__builtin_bit_cast(float, w.x << 16), __builtin_bit_cast(float, w.x & 0xffff0000u), __builtin_bit_cast(float, w.y << 16), __builtin_bit_cast(float, w.y & 0xffff0000u)};
                        b1 = (f32x4){__builtin_bit_cast(float, w.z << 16), __builtin_bit_cast(float, w.z & 0xffff0000u), __builtin_bit_cast(float, w.w << 16), __builtin_bit_cast(float, w.w & 0xffff0000u)}; }
                    const f32x4 v0 = acc[ai][bj][m][0] + b0, v1 = acc[ai][bj][m][1] + b1;
                    if (OUT_F32) { *(f32x4*)((float*)out + off) = v0; *(f32x4*)((float*)out + off + 4) = v1; }
                    else { *(u32x4*)((bf16_t*)out + off) = pack8(v0, v1);
                        ss += ((v0[0] * v0[0] + v0[1] * v0[1]) + (v0[2] * v0[2] + v0[3] * v0[3])) + ((v1[0] * v1[0] + v1[1] * v1[1]) + (v1[2] * v1[2] + v1[3] * v1[3])); }
                }
                if (!OUT_F32) { ss += __shfl_xor(ss, 16); ss += __shfl_xor(ss, 32); if (fq == 0) ssq_out[(size_t)row * 16 + u.pn * 4 + wc] = ss; }
            }
    }
};

struct EpiSwiGLU {
    static constexpr bool PERM = true, AFTER_DRAIN = false;
    bf16_t* act; const float* ssq;
    __device__ __forceinline__ void operator()(const f32x4 (&acc)[2][2][4][2], const Unit& u, int wr, int wc, int fr, int fq) const {
        const int col0 = u.pn * HALF + wc * 32 + 8 * fq;
#pragma unroll
        for (int ai = 0; ai < 2; ++ai)
#pragma unroll
            for (int m = 0; m < 4; ++m) {
                const int row = u.pm * BM + ai * HALF + wr * 64 + m * 16 + fr;
                const float rs = row_rstd(ssq, row);
                f32x4 o[2];
#pragma unroll
                for (int n = 0; n < 2; ++n) {
                    const f32x4 g = acc[ai][0][m][n] * rs, up = acc[ai][1][m][n] * rs;
#pragma unroll
                    for (int j = 0; j < 4; ++j) { const float e = __builtin_amdgcn_exp2f(g[j] * -1.4426950408889634f); o[n][j] = g[j] * up[j] * __builtin_amdgcn_rcpf(1.0f + e); }
                }
                *(u32x4*)(act + (size_t)row * 2816 + col0) = pack8(o[0], o[1]);
            }
    }
};

struct EpiMlstmIn {
    static constexpr bool PERM = true, AFTER_DRAIN = false;
    bf16_t* MQ; bf16_t* MK; bf16_t* MV; bf16_t* OG; const float* ssq;
    __device__ __forceinline__ void operator()(const f32x4 (&acc)[2][2][4][2], const Unit& u, int wr, int wc, int fr, int fq) const {
        bf16_t* base; int ld, colt; float sc = 1.0f; bool sig = false;
        if (u.pn < 2) { base = MQ; ld = 512; colt = u.pn * BM; sc = 0.125f; }
        else if (u.pn < 4) { base = MK; ld = 512; colt = (u.pn - 2) * BM; }
        else if (u.pn < 8) { base = MV; ld = 1024; colt = (u.pn - 4) * BM; }
        else { base = OG; ld = 1024; colt = (u.pn - 8) * BM; sig = true; }
        const int col0 = colt + wc * 32 + 8 * fq;
#pragma unroll
        for (int ai = 0; ai < 2; ++ai)
#pragma unroll
            for (int m = 0; m < 4; ++m) {
                const int row = u.pm * BM + ai * HALF + wr * 64 + m * 16 + fr;
                const float rs = row_rstd(ssq, row) * sc;
#pragma unroll
                for (int bj = 0; bj < 2; ++bj) {
                    f32x4 v0 = acc[ai][bj][m][0] * rs, v1 = acc[ai][bj][m][1] * rs;
                    if (sig) {
#pragma unroll
                        for (int j = 0; j < 4; ++j) { v0[j] = __builtin_amdgcn_rcpf(1.0f + __builtin_amdgcn_exp2f(v0[j] * -1.4426950408889634f)); v1[j] = __builtin_amdgcn_rcpf(1.0f + __builtin_amdgcn_exp2f(v1[j] * -1.4426950408889634f)); }
                    }
                    *(u32x4*)(base + (size_t)row * ld + col0 + bj * HALF) = pack8(v0, v1);
                }
            }
    }
};
template <class Epi, class Sched, bool ALIGN_EPI = false, bool SP2 = false>
__device__ __forceinline__ void gemm_phase(PG8_LAS unsigned char* lds, const Gemm g, const Sched& S, const Epi& E) {
    int tid_ = threadIdx.x; asm volatile("" : "+v"(tid_));
    const int tid = tid_, wid = __builtin_amdgcn_readfirstlane(tid >> 6), lane = tid & 63, wr = wid >> 2, wc = wid & 3, fr = lane & 15, fq = lane >> 4;
    const int K = g.K, nt = K / BK;
    unsigned voffA[2], voffB[2];
#pragma unroll
    for (int i = 0; i < 2; ++i) { int R, C; stage_rc(tid * 16 + i * 8192, R, C); const int Rb = Epi::PERM ? ((R & ~31) + perm32(R & 31)) : R;
        voffA[i] = (unsigned)(R * K + C) * 2u; voffB[i] = (unsigned)(Rb * K + C) * 2u; }
    const size_t kstep = (size_t)(BK * 2);
    const size_t hstep = (size_t)HALF * K * 2;
    const size_t tstep = 2 * hstep;
    const unsigned ldsw = (unsigned)wid * 1024u;
    const int aoff = lds_byte(wr * 64 + fr, fq * 8), boff = lds_byte(wc * 32 + fr, fq * 8);
#define PG8_SA(b, h) (((b) * 2 + (h)) * HTB)
#define PG8_SB(b, h) ((4 + (b) * 2 + (h)) * HTB)
#define PG8_STAGE(bufoff, gbase, voff) do { _Pragma("unroll") for (int _i = 0; _i < 2; ++_i) \
        __builtin_amdgcn_global_load_lds((const unsigned*)((const char*)(gbase) + (voff)[_i]), (PG8_LAS unsigned*)(lds + (bufoff) + ldsw + _i * 8192), 16, 0, 0); } while (0)
#define PG8_LDA(dst, b, h) do { _Pragma("unroll") for (int m = 0; m < 4; ++m) _Pragma("unroll") for (int k = 0; k < 2; ++k) dst[m][k] = *(const PG8_LAS bf16x8*)(lds + PG8_SA(b, h) + aoff + m * 2048 + k * 1024); } while (0)
#define PG8_LDB(dst, b, h) do { _Pragma("unroll") for (int n = 0; n < 2; ++n) _Pragma("unroll") for (int k = 0; k < 2; ++k) dst[n][k] = *(const PG8_LAS bf16x8*)(lds + PG8_SB(b, h) + boff + n * 2048 + k * 1024); } while (0)
#define PG8_MMA(ai, bj, At, Bt) do { __builtin_amdgcn_s_setprio(1); _Pragma("unroll") for (int m = 0; m < 4; ++m) _Pragma("unroll") for (int n = 0; n < 2; ++n) _Pragma("unroll") for (int k = 0; k < 2; ++k) \
        acc[ai][bj][m][n] = __builtin_amdgcn_mfma_f32_16x16x32_bf16(Bt[n][k], At[m][k], acc[ai][bj][m][n], 0, 0, 0); __builtin_amdgcn_s_setprio(0); } while (0)
#define PG8_WAIT_V(n) asm volatile("s_waitcnt vmcnt(" #n ")" ::: "memory")
#define PG8_WAIT_L(n) asm volatile("s_waitcnt lgkmcnt(" #n ")" ::: "memory")
#define PG8_BAR __builtin_amdgcn_s_barrier()
#define PG8_SCHED __builtin_amdgcn_sched_barrier(0)
    Unit cur, nxt; int ui = 0;
    if (!S.next(0, cur)) return;
    f32x4 acc[2][2][4][2];
#pragma unroll
    for (int a = 0; a < 2; ++a)
#pragma unroll
        for (int b = 0; b < 2; ++b)
#pragma unroll
            for (int m = 0; m < 4; ++m)
#pragma unroll
                for (int n = 0; n < 2; ++n) acc[a][b][m][n] = (f32x4){0.f, 0.f, 0.f, 0.f};
    bf16x8 At[4][2], B0[2][2], B1[2][2];
    const char* cA = (const char*)g.A + (size_t)cur.pm * tstep; const char* cB = (const char*)g.Bt + (size_t)cur.pn * tstep;
    S.a_ready(cur);
    if constexpr (SP2) {
        PG8_STAGE(PG8_SB(0, 0), cB, voffB); PG8_STAGE(PG8_SB(0, 1), cB + hstep, voffB); PG8_STAGE(PG8_SA(0, 0), cA, voffA); PG8_STAGE(PG8_SA(0, 1), cA + hstep, voffA);
        if (wr == 1) PG8_BAR;
        PG8_WAIT_V(2); PG8_BAR;
        PG8_STAGE(PG8_SB(1, 0), cB + kstep, voffB); PG8_STAGE(PG8_SA(1, 0), cA + kstep, voffA); PG8_STAGE(PG8_SB(1, 1), cB + hstep + kstep, voffB);
        PG8_WAIT_V(6); PG8_BAR;
    } else {
        PG8_STAGE(PG8_SB(0, 0), cB, voffB); PG8_STAGE(PG8_SA(0, 0), cA, voffA); PG8_STAGE(PG8_SB(0, 1), cB + hstep, voffB); PG8_STAGE(PG8_SA(0, 1), cA + hstep, voffA);
        if (wr == 1) PG8_BAR;
        PG8_WAIT_V(4); PG8_BAR;
        PG8_STAGE(PG8_SB(1, 0), cB + kstep, voffB); PG8_STAGE(PG8_SA(1, 0), cA + kstep, voffA); PG8_STAGE(PG8_SB(1, 1), cB + hstep + kstep, voffB);
        PG8_WAIT_V(6); PG8_BAR;
    }
    for (;;) {
        const bool has_next = S.next(ui + 1, nxt);
        const char* nA = has_next ? (const char*)g.A + (size_t)nxt.pm * tstep : cA; const char* nB = has_next ? (const char*)g.Bt + (size_t)nxt.pn * tstep : cB;
        for (int t = 0; t < nt; t += 2) {
            const bool last = (t == nt - 2);
            const char* a1 = cA + (size_t)(t + 1) * kstep;
            const char* a2 = last ? nA : cA + (size_t)(t + 2) * kstep; const char* b2 = last ? nB : cB + (size_t)(t + 2) * kstep;
            const char* a3 = a2 + kstep; const char* b3 = b2 + kstep;
            if (last && has_next) S.a_ready(nxt);
            if constexpr (SP2) {
            PG8_LDB(B0, 0, 0); PG8_LDB(B1, 0, 1); PG8_SCHED; PG8_LDA(At, 0, 0); PG8_STAGE(PG8_SA(1, 1), a1 + hstep, voffA);
            PG8_WAIT_V(8); PG8_WAIT_L(0); PG8_BAR; PG8_MMA(0, 0, At, B0); PG8_MMA(0, 1, At, B1); PG8_BAR; PG8_SCHED;
            PG8_LDA(At, 0, 1); PG8_STAGE(PG8_SB(0, 0), b2, voffB); PG8_STAGE(PG8_SB(0, 1), b2 + hstep, voffB); PG8_STAGE(PG8_SA(0, 0), a2, voffA);
            PG8_WAIT_V(8); PG8_WAIT_L(0); PG8_BAR; PG8_MMA(1, 0, At, B0); PG8_MMA(1, 1, At, B1); PG8_BAR; PG8_SCHED;
            PG8_LDB(B0, 1, 0); PG8_LDB(B1, 1, 1); PG8_SCHED; PG8_LDA(At, 1, 0); PG8_STAGE(PG8_SA(0, 1), a2 + hstep, voffA);
            PG8_WAIT_V(8); PG8_WAIT_L(0); PG8_BAR; PG8_MMA(0, 0, At, B0); PG8_MMA(0, 1, At, B1); PG8_BAR; PG8_SCHED;
            PG8_LDA(At, 1, 1); PG8_STAGE(PG8_SB(1, 0), b3, voffB); PG8_STAGE(PG8_SB(1, 1), b3 + hstep, voffB); PG8_STAGE(PG8_SA(1, 0), a3, voffA);
            PG8_WAIT_V(8); PG8_WAIT_L(0); PG8_BAR; PG8_MMA(1, 0, At, B0); PG8_MMA(1, 1, At, B1); PG8_BAR; PG8_SCHED;
            } else {
            PG8_LDB(B0, 0, 0); PG8_SCHED; PG8_LDA(At, 0, 0); PG8_STAGE(PG8_SA(1, 1), a1 + hstep, voffA);
            PG8_WAIT_L(8); PG8_BAR; PG8_WAIT_L(0); PG8_MMA(0, 0, At, B0); PG8_BAR; PG8_SCHED;
            PG8_LDB(B1, 0, 1); PG8_STAGE(PG8_SB(0, 0), b2, voffB);
            PG8_BAR; PG8_WAIT_L(0); PG8_MMA(0, 1, At, B1); PG8_BAR;
            PG8_LDA(At, 0, 1); PG8_STAGE(PG8_SA(0, 0), a2, voffA);
            PG8_BAR; PG8_WAIT_L(0); PG8_MMA(1, 0, At, B0); PG8_BAR; PG8_SCHED;
            PG8_STAGE(PG8_SB(0, 1), b2 + hstep, voffB);
            PG8_WAIT_V(6); PG8_BAR; PG8_MMA(1, 1, At, B1); PG8_BAR;
            PG8_LDB(B0, 1, 0); PG8_SCHED; PG8_LDA(At, 1, 0); PG8_STAGE(PG8_SA(0, 1), a2 + hstep, voffA);
            PG8_WAIT_L(8); PG8_BAR; PG8_WAIT_L(0); PG8_MMA(0, 0, At, B0); PG8_BAR; PG8_SCHED;
            PG8_LDB(B1, 1, 1); PG8_STAGE(PG8_SB(1, 0), b3, voffB);
            PG8_BAR; PG8_WAIT_L(0); PG8_MMA(0, 1, At, B1); PG8_BAR;
            PG8_LDA(At, 1, 1); PG8_STAGE(PG8_SA(1, 0), a3, voffA);
            PG8_BAR; PG8_WAIT_L(0); PG8_MMA(1, 0, At, B0); PG8_BAR; PG8_SCHED;
            PG8_STAGE(PG8_SB(1, 1), b3 + hstep, voffB);
            PG8_WAIT_V(6); PG8_BAR; PG8_MMA(1, 1, At, B1); PG8_BAR;
            }
        }
        if constexpr (ALIGN_EPI) { if (wr == 0) PG8_BAR; }
        if constexpr (!Epi::AFTER_DRAIN) { E(acc, cur, wr, wc, fr, fq); S.done(cur); }
        if (!has_next) break;
#pragma unroll
        for (int a = 0; a < 2; ++a)
#pragma unroll
            for (int b = 0; b < 2; ++b)
#pragma unroll
                for (int m = 0; m < 4; ++m)
#pragma unroll
                    for (int n = 0; n < 2; ++n) acc[a][b][m][n] = (f32x4){0.f, 0.f, 0.f, 0.f};
        cur = nxt; cA = nA; cB = nB; ++ui;
        if constexpr (ALIGN_EPI) { if (wr == 1) PG8_BAR; }
    }
    PG8_WAIT_V(0);
    if constexpr (!ALIGN_EPI) { if (wr == 0) PG8_BAR; }
    PG8_BAR;
    if constexpr (Epi::AFTER_DRAIN) { E.fused(acc, cur, wr, wc, fr, fq, lds, wid, lane); S.done(cur); }
#undef PG8_SA
#undef PG8_SB
#undef PG8_STAGE
#undef PG8_LDA
#undef PG8_LDB
#undef PG8_MMA
#undef PG8_WAIT_V
#undef PG8_WAIT_L
#undef PG8_BAR
#undef PG8_SCHED
}
}

#ifndef PG8_SP2
#define PG8_SP2 true
#endif
#ifndef PG8_ALIGN
#define PG8_ALIGN true
#endif
#define GAS __attribute__((address_space(1)))
#define LAS __attribute__((address_space(3)))
typedef unsigned short bf16;
typedef unsigned v4u __attribute__((ext_vector_type(4)));
typedef float f32x4 __attribute__((ext_vector_type(4)));
typedef short bf16x8 __attribute__((ext_vector_type(8)));
typedef GAS unsigned gu32;
typedef GAS unsigned long long gu64;
#define RLX_AGENT __ATOMIC_RELAXED, __HIP_MEMORY_SCOPE_AGENT
#define LDS_WAIT() asm volatile("s_waitcnt lgkmcnt(0)" ::: "memory")
#define VM_WAIT() asm volatile("s_waitcnt vmcnt(0)" ::: "memory")
__device__ __forceinline__ unsigned long long rt() { return __builtin_amdgcn_s_memrealtime(); }
__device__ __forceinline__ unsigned f2bf(float f) { unsigned u = __builtin_bit_cast(unsigned, f); return (u + 0x7fffu + ((u >> 16) & 1u)) >> 16; }
__device__ __forceinline__ unsigned pk2(float lo, float hi) { return f2bf(lo) | (f2bf(hi) << 16); }

#define XB_TMO      128
#define XB_XCNT(j)  (256  + 64 * (j))
#define XB_XSUB(j)  (1280 + 64 * (j))
#define XB_XGEN(j)  (2304 + 64 * (j))
#define XB_TOP      3328
#define XB_TOPGEN   3392
#define XCD_BAR_WORDS 3456
#define XB_SPIN_CAP (1u << 18)

__device__ __forceinline__ unsigned xb_ld(unsigned* p)              { return __hip_atomic_load(p, __ATOMIC_RELAXED, __HIP_MEMORY_SCOPE_AGENT); }
__device__ __forceinline__ unsigned xb_add(unsigned* p, unsigned v) { return __hip_atomic_fetch_add(p, v, __ATOMIC_RELAXED, __HIP_MEMORY_SCOPE_AGENT); }
__device__ __forceinline__ unsigned xb_xcc_id() { return (unsigned)__builtin_amdgcn_s_getreg((3 << 11) | 20) & 0xFu; }
#define XB_SPIN(cond, bar) do { unsigned _sp = 0; while (cond) { __builtin_amdgcn_s_sleep(1); \
    if ((++_sp & 255u) == 0u) { if (xb_ld(&(bar)[XB_TMO])) break; if (_sp > XB_SPIN_CAP) { atomicAdd(&(bar)[XB_TMO], 1u); break; } } } } while (0)

struct XcdBarrier {
    unsigned* bar; unsigned x;
    volatile LAS unsigned* st;
};

__device__ __forceinline__ XcdBarrier xcd_barrier_post(unsigned* bar, volatile LAS unsigned* st) {
    XcdBarrier b; b.bar = bar; b.x = xb_xcc_id(); b.st = st;
    if (threadIdx.x == 0) (void)xb_add(&bar[XB_XCNT(b.x)], 1u);
    return b;
}
__device__ __forceinline__ void xcd_barrier_complete(unsigned* bar, unsigned x, unsigned& nloc, unsigned& nx) {
    const unsigned G = gridDim.x * gridDim.y * gridDim.z;
    unsigned sum, cnt, mine, sp = 0u;
    for (;;) {
        sum = 0u; cnt = 0u; mine = 0u;
#pragma unroll
        for (unsigned j = 0; j < 16; ++j) { const unsigned c = xb_ld(&bar[XB_XCNT(j)]); sum += c; cnt += (c > 0u) ? 1u : 0u; mine = (j == x) ? c : mine; }
        if (sum == G) break;
        __builtin_amdgcn_s_sleep(1);
        if ((++sp & 255u) == 0u) { if (xb_ld(&bar[XB_TMO])) break; if (sp > XB_SPIN_CAP) { atomicAdd(&bar[XB_TMO], 1u); break; } }
    }
    nloc = mine > 0u ? mine : 1u; nx = cnt > 0u ? cnt : 1u;
}

__device__ __forceinline__ void xcd_barrier(const XcdBarrier& b) {
    asm volatile("s_waitcnt vmcnt(0)" ::: "memory");
    __syncthreads();
    if (threadIdx.x == 0) {
        unsigned* bar = b.bar;
        __builtin_amdgcn_s_waitcnt(0);
        unsigned nloc = b.st[0], nx = b.st[1];
        if (nloc == 0u) { xcd_barrier_complete(bar, b.x, nloc, nx); b.st[0] = nloc; b.st[1] = nx; }
        const unsigned old = xb_add(&bar[XB_XSUB(b.x)], 1u);
        const unsigned gen = old / nloc;
        if (old + 1u == (gen + 1u) * nloc) {
            __builtin_amdgcn_fence(__ATOMIC_RELEASE, "agent");
            asm volatile("s_waitcnt vmcnt(0)" ::: "memory");
            const unsigned og = xb_add(&bar[XB_TOP], 1u);
            const unsigned tg = og / nx;
            if (og + 1u == (tg + 1u) * nx) xb_add(&bar[XB_TOPGEN], 1u);
            else XB_SPIN(xb_ld(&bar[XB_TOPGEN]) == tg, bar);
            __builtin_amdgcn_fence(__ATOMIC_ACQUIRE, "agent");
            xb_add(&bar[XB_XGEN(b.x)], 1u);
            asm volatile("s_waitcnt vmcnt(0)" ::: "memory");
        } else {
            XB_SPIN(xb_ld(&bar[XB_XGEN(b.x)]) == gen, bar);
            __builtin_amdgcn_fence(__ATOMIC_ACQUIRE, "agent");
            asm volatile("s_waitcnt vmcnt(0)" ::: "memory");
        }
    }
    __syncthreads();
}
constexpr int NWAVES = 8;
constexpr int BATCH = 2, SEQ = 8192, D = 1024, M = BATCH * SEQ, NH = 16, HD = 64, MB = 256, NBLK = SEQ / MB;
constexpr int DFF = 2816, NGU = 2 * DFF;
constexpr int MH = 8, DK = 64, DV = 128, LCH = 64, NCH = SEQ / LCH, NUNIT = BATCH * MH * NCH;
constexpr int NIN = 3072, NINW = 3088;
constexpr float RMS_EPS = 1e-6f, SOFTCAP = 15.0f, LOG2E = 1.4426950408889634f;

constexpr size_t MiB = 1u << 20;
constexpr size_t WS_CTL = 0, CTL_ZERO_BYTES = 1 * MiB;
constexpr size_t WS_KMEAN = 512 * 1024;
constexpr size_t WS_SSQ = 1 * MiB;
constexpr size_t WS_BIG = 5 * MiB;
constexpr size_t WS_SEL = 6 * MiB;
constexpr size_t WS_ROPE = 7 * MiB;
constexpr size_t WS_WG = 7 * MiB + 512 * 1024;
constexpr size_t WS_WQKV = 8 * MiB, WS_WO = 14 * MiB, WS_WIN = 16 * MiB, WS_WOUT = 22 * MiB, WS_WGU = 24 * MiB  , WS_WD = 46 * MiB  ;
constexpr size_t WS_NLOC = 57 * MiB;
constexpr size_t WS_SCAL = 57 * MiB + 512 * 1024;
constexpr size_t WS_AB = 64 * MiB;
constexpr size_t WS_Q = 96 * MiB, WS_K = 128 * MiB, WS_V = 160 * MiB;
constexpr size_t WS_HB1 = 96 * MiB;
constexpr size_t WS_ACT = 128 * MiB;
constexpr size_t WS_MQ = 96 * MiB, WS_MK = 112 * MiB, WS_MV = 128 * MiB, WS_OG = 160 * MiB, WS_CLOC = 192 * MiB;
constexpr size_t WS_Y = 224 * MiB;
constexpr size_t WS_END = 256 * MiB;
constexpr int CW_BAR = 4096;

constexpr int RING_OFF = 0, RING_BYTES = 131072;
constexpr int LDSCTL_OFF = RING_BYTES, MISC_OFF = LDSCTL_OFF + 320;
constexpr int LDS_BYTES = 163840;
static_assert(MISC_OFF + 128 <= LDS_BYTES, "LDS map");

__device__ __forceinline__ float bf2f(unsigned short h) { return __builtin_bit_cast(float, (unsigned)h << 16); }
__device__ __forceinline__ float bflo(unsigned w) { return __builtin_bit_cast(float, w << 16); }
__device__ __forceinline__ float bfhi(unsigned w) { return __builtin_bit_cast(float, w & 0xffff0000u); }
__device__ __forceinline__ float wave_sum(float v) {
#pragma unroll
    for (int o = 1; o < 64; o <<= 1) v += __shfl_xor(v, o);
    return v;
}
__device__ __forceinline__ float wave_max(float v) {
#pragma unroll
    for (int o = 1; o < 64; o <<= 1) v = fmaxf(v, __shfl_xor(v, o));
    return v;
}
__device__ __forceinline__ float fexp(float x) { return __builtin_amdgcn_exp2f(x * LOG2E); }

__device__ __forceinline__ int ltid() { int t = threadIdx.x; asm volatile("" : "+v"(t)); return t; }
struct Frame {
    LAS unsigned char* lds;
    volatile LAS unsigned* MISC;
    gu32* ctl;
    int wave, vcu, G;
};

template <int MODE> __device__ __forceinline__ int src_col(int n) {
    if (MODE == 1) {
        if (n >= 2048) return n;
        const int s = n & 63; int d = s;
        if (s < 16) d = (s & 3) | ((s & 4) << 1) | ((s & 8) >> 1);
        return (n & ~63) | d;
    }
    if (MODE == 2) { const int pn = n >> 8, r = n & 255; return (r < 128) ? pn * 128 + r : DFF + pn * 128 + (r - 128); }
    return n;
}
template <int MODE> __device__ __forceinline__ void p0_transpose_item(const float* W, int K, int Nsrc, int Nout, const float* kscale, bf16* WT, int item, int lane) {
    const int nblk = Nout / 64, kb = item / nblk, nb = item - kb * nblk, k0 = 32 * kb, n = 64 * nb + lane;
    const float* wp = W + (size_t)k0 * Nsrc + src_col<MODE>(n);
    float v[32];
#pragma unroll
    for (int i = 0; i < 32; ++i) v[i] = wp[(size_t)i * Nsrc];
    if (kscale) {
#pragma unroll
        for (int i = 0; i < 32; ++i) v[i] *= kscale[k0 + i]; }
    GAS v4u* op = (GAS v4u*)(WT + (size_t)n * K + k0);
#pragma unroll
    for (int c = 0; c < 4; ++c) { v4u o; o.x = pk2(v[8 * c], v[8 * c + 1]); o.y = pk2(v[8 * c + 2], v[8 * c + 3]); o.z = pk2(v[8 * c + 4], v[8 * c + 5]); o.w = pk2(v[8 * c + 6], v[8 * c + 7]); op[c] = o; }
}

struct Ptrs {
    const float *x, *attn_norm, *w_qkv, *w_o, *mlstm_norm, *w_in, *b_gates, *head_norm, *w_out, *ffn_norm, *w_gu, *w_down, *final_norm;
    float* out; unsigned char* ws;
};

__device__ __forceinline__ void p0_prologue(Frame& F, const Ptrs& P) {
    const int tid_l = ltid(), lane_l = tid_l & 63; (void)lane_l;
    unsigned char* ws = P.ws;
    const int gw = F.vcu * NWAVES + F.wave, NGW = F.G * NWAVES;
    constexpr int I_QKV = (D / 32) * (3 * D / 64), I_O = (D / 32) * (D / 64), I_IN = (D / 32) * (NIN / 64), I_GU = (D / 32) * (NGU / 64), I_DN = (DFF / 32) * (D / 64);
    constexpr int NITEMS = I_QKV + I_O + I_IN + I_O + 2 * I_GU + 2 * I_DN;
    for (int it = gw; it < NITEMS; it += NGW) {
        int r = it;
        if (r < I_QKV) { p0_transpose_item<1>(P.w_qkv, D, 3 * D, 3 * D, P.attn_norm, (bf16*)(ws + WS_WQKV), r, lane_l); continue; } r -= I_QKV;
        if (r < I_O) { p0_transpose_item<0>(P.w_o, D, D, D, nullptr, (bf16*)(ws + WS_WO), r, lane_l); continue; } r -= I_O;
        if (r < I_IN) { p0_transpose_item<0>(P.w_in, D, NINW, NIN, P.mlstm_norm, (bf16*)(ws + WS_WIN), r, lane_l); continue; } r -= I_IN;
        if (r < I_O) { p0_transpose_item<0>(P.w_out, D, D, D, nullptr, (bf16*)(ws + WS_WOUT), r, lane_l); continue; } r -= I_O;
        if (r < 2 * I_GU) { const int l = r / I_GU; p0_transpose_item<2>(P.w_gu + (size_t)l * D * NGU, D, NGU, NGU, P.ffn_norm + l * D, (bf16*)(ws + WS_WGU) + (size_t)l * NGU * D, r % I_GU, lane_l); continue; } r -= 2 * I_GU;
        { const int l = r / I_DN; p0_transpose_item<0>(P.w_down + (size_t)l * DFF * D, DFF, D, D, nullptr, (bf16*)(ws + WS_WD) + (size_t)l * D * DFF, r % I_DN, lane_l); }
    }
    const int gt = F.vcu * (NWAVES * 64) + tid_l, NGT = F.G * NWAVES * 64;
    { bf16* WG = (bf16*)(ws + WS_WG); for (int i = gt; i < 16 * D; i += NGT) { const int j = i >> 10, k = i & 1023; WG[i] = (bf16)f2bf(P.mlstm_norm[k] * P.w_in[(size_t)k * NINW + NIN + j]); } }
    { float* rope = (float*)(ws + WS_ROPE);
      for (int i = gt; i < SEQ * 8; i += NGT) { const int pos = i >> 3, j = i & 7;
          const float invf = j == 0 ? 1.0f : j == 1 ? 0.1939227432012558f : j == 2 ? 0.03760603070259094f : j == 3 ? 0.007292664609849453f : j == 4 ? 0.0014142135623842478f : j == 5 ? 0.00027424818836152554f : j == 6 ? 5.3182957344688475e-05f : 1.0313385246263351e-05f;
          const float ang = __fmul_rn((float)pos, invf);
          const double rev = (double)ang * 0.15915494309189533577; const float fr = (float)(rev - __builtin_rint(rev));
          rope[2 * i] = __builtin_amdgcn_cosf(fr); rope[2 * i + 1] = __builtin_amdgcn_sinf(fr); } }
    { bf16* xb = (bf16*)(ws + WS_AB); float* ssq0 = (float*)(ws + WS_SSQ);
      for (int m = gw; m < M; m += NGW) {
          const GAS f32x4* xr = (const GAS f32x4*)(P.x + (size_t)m * D) + lane_l; f32x4 v[4]; float s = 0.f;
#pragma unroll
          for (int j = 0; j < 4; ++j) { v[j] = xr[64 * j]; s += (v[j].x * v[j].x + v[j].y * v[j].y) + (v[j].z * v[j].z + v[j].w * v[j].w); }
          s = wave_sum(s);
          GAS unsigned long long* o8 = (GAS unsigned long long*)(xb + (size_t)m * D) + lane_l;
#pragma unroll
          for (int j = 0; j < 4; ++j) o8[64 * j] = (unsigned long long)pk2(v[j].x, v[j].y) | ((unsigned long long)pk2(v[j].z, v[j].w) << 32);
          if (lane_l < 16) ssq0[(size_t)m * 16 + lane_l] = (lane_l == 0) ? s : 0.f;
      } }
}

namespace moba {
typedef short bf16x8 __attribute__((ext_vector_type(8)));
typedef short s16x4 __attribute__((ext_vector_type(4)));
typedef float f32x16 __attribute__((ext_vector_type(16)));
typedef unsigned u32x4 __attribute__((ext_vector_type(4)));
typedef LAS const char* lds_cptr;
typedef short v4i16_t __attribute__((ext_vector_type(4)));
typedef float f32x2_t __attribute__((ext_vector_type(2))); typedef __bf16 bf16x2_t __attribute__((ext_vector_type(2)));
constexpr int THRL = 8;
constexpr int L_K = 0, L_V = 32768, L_WS = 65536  , L_STG = 73728  , L_QL = 106496  , L_MISC = 122880;
constexpr size_t WS_SEGCNT = 58 * MiB;
constexpr size_t WS_P2 = 192 * MiB;
constexpr size_t WS_PLSE = 224 * MiB;
constexpr size_t WS_SEGLIST = 232 * MiB;
constexpr int CW_TOT = 12288;
constexpr int LCAP = 8192;
constexpr int CW_Q3 = 8192;
constexpr size_t PART_STRIDE = (size_t)M * D * 2;

__device__ __forceinline__ int crow(int r, int hi) { return (r & 3) + 8 * (r >> 2) + 4 * hi; }
__device__ __forceinline__ void glds16(const void* gsrc, unsigned lds_dst) { unsigned keep;
    asm volatile("s_mov_b32 %0, m0\n\ts_mov_b32 m0, %2\n\ts_nop 0\n\tglobal_load_lds_dwordx4 %1, off\n\ts_mov_b32 m0, %0" : "=&s"(keep) : "v"(gsrc), "s"(lds_dst) : "memory"); }
__device__ __forceinline__ unsigned cvtpk_s(float lo, float hi) { f32x2_t v = {lo, hi}; bf16x2_t b = __builtin_convertvector(v, bf16x2_t); return __builtin_bit_cast(unsigned, b); }
__device__ __forceinline__ s16x4 vtr(lds_cptr p) { return __builtin_bit_cast(s16x4, __builtin_amdgcn_ds_read_tr16_b64_v4i16((LAS v4i16_t*)p)); }
#define MOBA_MX3(a, b, c) __builtin_fmaxf(__builtin_fmaxf((a), (b)), (c))
__device__ __forceinline__ float rowmax(const f32x16& p0, const f32x16& p1) {
    float a = MOBA_MX3(p0[0], p0[1], p1[0]), b = MOBA_MX3(p0[2], p0[3], p1[1]); a = MOBA_MX3(a, p1[2], p1[3]);
#pragma unroll
    for (int r = 4; r < 16; r += 4) { a = MOBA_MX3(a, p0[r], p0[r + 1]); b = MOBA_MX3(b, p0[r + 2], p0[r + 3]); a = MOBA_MX3(a, p1[r], p1[r + 1]); b = MOBA_MX3(b, p1[r + 2], p1[r + 3]); }
    float m = __builtin_fmaxf(a, b); auto rr = __builtin_amdgcn_permlane32_swap(__float_as_uint(m), __float_as_uint(m), false, false);
    return __builtin_fmaxf(__uint_as_float(rr[0]), __uint_as_float(rr[1])); }
__device__ __forceinline__ float halves_sum(float v) { auto rr = __builtin_amdgcn_permlane32_swap(__float_as_uint(v), __float_as_uint(v), false, false); return __uint_as_float(rr[0]) + __uint_as_float(rr[1]); }
#define MOBA_MFMA(a, b, c) __builtin_amdgcn_mfma_f32_32x32x16_bf16(a, b, c, 0, 0, 0)

__device__ __forceinline__ void stage_kv(const bf16* K, const bf16* V, int b, int h, int j, LAS unsigned char* lds, int wid, int lane) {
    const size_t row0 = (size_t)b * SEQ + (size_t)j * MB;
    const bf16* ksrc = K + (row0 + lane) * D + h * HD + wid * 8;
    const bf16* vsrc = V + (row0 + 16 * (wid & 3) + (lane >> 2)) * D + h * HD + (wid >> 2) * 32 + (lane & 3) * 8;
    const unsigned kdst = (unsigned)(uintptr_t)(lds + L_K) + wid * 1024, vdst = (unsigned)(uintptr_t)(lds + L_V) + wid * 1024;
#pragma unroll
    for (int t = 0; t < 4; ++t) { glds16(ksrc + (size_t)t * 64 * D, (unsigned)__builtin_amdgcn_readfirstlane(kdst + t * 8192)); glds16(vsrc + (size_t)t * 64 * D, (unsigned)__builtin_amdgcn_readfirstlane(vdst + t * 8192)); }
    asm volatile("s_waitcnt vmcnt(0) lgkmcnt(0)\n\ts_barrier" ::: "memory");
}

template <bool CAUSAL> __device__ __forceinline__ void wave_block(const bf16x8 (&qr)[4], lds_cptr kbase, lds_cptr vbase, int ntiles, int qrel, LAS float* wsf, int lane, f32x16& o0, f32x16& o1, float& mhat, float& lsum) {
    const int r32 = lane & 31, hi = lane >> 5;
    const lds_cptr kp0 = kbase + hi * 1024 + r32 * 16;
    const lds_cptr vp0 = vbase + ((lane >> 4) & 1) * 32 + (lane & 3) * 8 + (4 * hi + ((lane & 15) >> 2)) * 64;
    o0 = f32x16{}; o1 = f32x16{}; mhat = 0.f; lsum = 0.f;
    bf16x8 kf[8];
#define MOBA_KLOAD(kt_) do { const lds_cptr kp_ = kp0 + (kt_) * 8192; _Pragma("unroll") for (int d0 = 0; d0 < 4; ++d0) { kf[2 * d0] = *(const LAS bf16x8*)(kp_ + d0 * 2048); kf[2 * d0 + 1] = *(const LAS bf16x8*)(kp_ + d0 * 2048 + 512); } } while (0)
    MOBA_KLOAD(0);
#pragma unroll
    for (int kt = 0; kt < 4; ++kt) {
        if (kt < ntiles) {
            const lds_cptr vp = vp0 + kt * 8192;
            s16x4 vlo[8], vhi[8];
#pragma unroll
            for (int i = 0; i < 8; ++i) { vlo[i] = vtr(vp + ((i >> 2) * 4096 + (i & 3) * 1024)); vhi[i] = vtr(vp + ((i >> 2) * 4096 + (i & 3) * 1024 + 512)); }
            f32x16 negm;
#pragma unroll
            for (int r = 0; r < 16; ++r) negm[r] = 0.f - mhat;
            f32x16 c0 = MOBA_MFMA(kf[0], qr[0], negm), c1 = MOBA_MFMA(kf[1], qr[0], negm);
            c0 = MOBA_MFMA(kf[2], qr[1], c0); c1 = MOBA_MFMA(kf[3], qr[1], c1);
            c0 = MOBA_MFMA(kf[4], qr[2], c0); c1 = MOBA_MFMA(kf[5], qr[2], c1);
            c0 = MOBA_MFMA(kf[6], qr[3], c0); c1 = MOBA_MFMA(kf[7], qr[3], c1);
            __builtin_amdgcn_sched_barrier(0);
            if (kt + 1 < 4 && kt + 1 < ntiles) MOBA_KLOAD(kt + 1);
            if (CAUSAL && kt == ntiles - 1) { int rel = qrel - 64 * kt - 4 * hi; asm volatile("" : "+v"(rel));
#pragma unroll
                for (int r = 0; r < 16; ++r) { const int kv = (r & 3) + 8 * (r >> 2);
                    c0[r] = __builtin_fminf(c0[r], __builtin_bit_cast(float, 0x7F800000u | ((unsigned)((rel - kv) >> 31) & 0x80000000u)));
                    c1[r] = __builtin_fminf(c1[r], __builtin_bit_cast(float, 0x7F800000u | ((unsigned)((rel - kv - 32) >> 31) & 0x80000000u))); } }
            const float rm = rowmax(c0, c1);
            bool resc = false; float dl = 0.f;
            if (kt == 0) { dl = rm; mhat = rm; }
            else if (__any(rm > (float)THRL)) { dl = __builtin_fmaxf(rm, 0.f); mhat += dl; const float f = __builtin_amdgcn_exp2f(-dl); lsum *= f; if (hi == 0) wsf[r32] = f; resc = true; }
            float sacc = 0.f;
#pragma unroll
            for (int r = 0; r < 16; ++r) { c0[r] = __builtin_amdgcn_exp2f(c0[r] - dl); c1[r] = __builtin_amdgcn_exp2f(c1[r] - dl); sacc += c0[r] + c1[r]; }
            lsum += sacc;
            if (resc) { asm volatile("s_waitcnt lgkmcnt(0)" ::: "memory");
#pragma unroll
                for (int r = 0; r < 16; ++r) { const float f = wsf[crow(r, hi)]; o0[r] *= f; o1[r] *= f; } }
            u32x4 pw0, pw1, pw2, pw3;
            pw0 = (u32x4){cvtpk_s(c0[0], c0[1]), cvtpk_s(c0[2], c0[3]), cvtpk_s(c0[4], c0[5]), cvtpk_s(c0[6], c0[7])}; pw1 = (u32x4){cvtpk_s(c0[8], c0[9]), cvtpk_s(c0[10], c0[11]), cvtpk_s(c0[12], c0[13]), cvtpk_s(c0[14], c0[15])};
            pw2 = (u32x4){cvtpk_s(c1[0], c1[1]), cvtpk_s(c1[2], c1[3]), cvtpk_s(c1[4], c1[5]), cvtpk_s(c1[6], c1[7])}; pw3 = (u32x4){cvtpk_s(c1[8], c1[9]), cvtpk_s(c1[10], c1[11]), cvtpk_s(c1[12], c1[13]), cvtpk_s(c1[14], c1[15])};
            __builtin_amdgcn_sched_barrier(0);
#define MOBA_PAF(k) __builtin_bit_cast(bf16x8, pw##k)
#define MOBA_VFR(i) (bf16x8){vlo[i][0], vlo[i][1], vlo[i][2], vlo[i][3], vhi[i][0], vhi[i][1], vhi[i][2], vhi[i][3]}
            o0 = MOBA_MFMA(MOBA_PAF(0), MOBA_VFR(0), o0); o1 = MOBA_MFMA(MOBA_PAF(0), MOBA_VFR(4), o1); o0 = MOBA_MFMA(MOBA_PAF(1), MOBA_VFR(1), o0); o1 = MOBA_MFMA(MOBA_PAF(1), MOBA_VFR(5), o1);
            o0 = MOBA_MFMA(MOBA_PAF(2), MOBA_VFR(2), o0); o1 = MOBA_MFMA(MOBA_PAF(2), MOBA_VFR(6), o1); o0 = MOBA_MFMA(MOBA_PAF(3), MOBA_VFR(3), o0); o1 = MOBA_MFMA(MOBA_PAF(3), MOBA_VFR(7), o1);
#undef MOBA_PAF
#undef MOBA_VFR
            __builtin_amdgcn_sched_barrier(0);
        }
    }
#undef MOBA_KLOAD
    lsum = halves_sum(lsum);
}
__device__ __forceinline__ void stage_o(const f32x16& o0, const f32x16& o1, float lsum, LAS float* wsf, LAS unsigned short* stg, int lane) {
    const int r32 = lane & 31, hi = lane >> 5;
    if (hi == 0) wsf[32 + r32] = __builtin_amdgcn_rcpf(lsum);
    asm volatile("s_waitcnt lgkmcnt(0)" ::: "memory");
#pragma unroll
    for (int r = 0; r < 16; ++r) { const int orow = crow(r, hi); const float rl = wsf[32 + orow];
        stg[orow * 64 + r32] = (unsigned short)f2bf(o0[r] * rl); stg[orow * 64 + 32 + r32] = (unsigned short)f2bf(o1[r] * rl); }
    asm volatile("s_waitcnt lgkmcnt(0)" ::: "memory");
}

__device__ __forceinline__ bool better(float g, int n, float gk, int ik) { return g > gk || (g == gk && n < ik); }
__device__ __forceinline__ void ins3(float g, int n, float& g1, int& i1, float& g2, int& i2, float& g3, int& i3) {
    const bool b1 = better(g, n, g1, i1), b2 = better(g, n, g2, i2), b3 = better(g, n, g3, i3);
    const float n3 = b2 ? g2 : (b3 ? g : g3); const int m3 = b2 ? i2 : (b3 ? n : i3);
    const float n2 = b1 ? g1 : (b2 ? g : g2); const int m2 = b1 ? i1 : (b2 ? n : i2);
    g1 = b1 ? g : g1; i1 = b1 ? n : i1; g2 = n2; i2 = m2; g3 = n3; i3 = m3;
}
}

__device__ __forceinline__ void p2_gating(Frame& F, const Ptrs& P) {
    using namespace moba;
    const int tid_l = ltid(), lane_l = tid_l & 63; (void)lane_l;
    const bf16* Q = (const bf16*)(P.ws + WS_Q); const float* kmean = (const float*)(P.ws + WS_KMEAN);
    unsigned short* seglist = (unsigned short*)(P.ws + WS_SEGLIST);
    LAS unsigned char* himg = F.lds + RING_OFF; LAS unsigned char* limg = himg + 4096; LAS unsigned* cntL = (LAS unsigned*)(limg + 4096);
    const int tid = tid_l, lane = lane_l, r32 = lane & 31, hi = lane >> 5, wid = F.wave;
    for (int unit = F.vcu; unit < BATCH * NH * NBLK; unit += F.G) {
        const int bh = unit >> 5, cur = unit & 31, b = bh >> 4, h = bh & 15;
        if (cur == 0) continue;
        { const int n = tid >> 4, c4 = (tid & 15) * 4; f32x4 x = (f32x4){0.f, 0.f, 0.f, 0.f};
          if (n < cur) x = *(const f32x4*)(kmean + (size_t)(b * NBLK + n) * D + h * HD + c4);
          const unsigned h01 = cvtpk_s(x.x, x.y), h23 = cvtpk_s(x.z, x.w);
          const unsigned l01 = cvtpk_s(x.x - bflo(h01), x.y - bfhi(h01)), l23 = cvtpk_s(x.z - bflo(h23), x.w - bfhi(h23));
          const int off = (c4 >> 3) * 512 + n * 16 + (c4 & 7) * 2;
          typedef unsigned u32x2v __attribute__((ext_vector_type(2)));
          *(LAS u32x2v*)(himg + off) = (u32x2v){h01, h23}; *(LAS u32x2v*)(limg + off) = (u32x2v){l01, l23};
          if (tid < 32) cntL[tid] = 0u; }
        LDS_WAIT(); __syncthreads();
        const int tl = cur * MB + wid * 32 + r32;
        float g1 = -INFINITY, g2 = -INFINITY, g3 = -INFINITY; int i1 = 255, i2 = 255, i3 = 255;
        {
            const bf16* qp = Q + (size_t)(b * SEQ + tl) * D + h * HD + hi * 8;
            f32x16 g = f32x16{};
#pragma unroll
            for (int d0 = 0; d0 < 4; ++d0) { const bf16x8 qr = *(const bf16x8*)(qp + d0 * 16);
                const bf16x8 ah = *(const LAS bf16x8*)(himg + (2 * d0 + hi) * 512 + r32 * 16), al = *(const LAS bf16x8*)(limg + (2 * d0 + hi) * 512 + r32 * 16);
                g = MOBA_MFMA(ah, qr, g); g = MOBA_MFMA(al, qr, g); }
            int nb = 4 * hi; asm volatile("" : "+v"(nb));
#pragma unroll
            for (int r = 0; r < 16; ++r) { const int n = nb + (r & 3) + 8 * (r >> 2); const float gv = (n < cur) ? g[r] : -INFINITY; ins3(gv, (n < cur) ? n : 255, g1, i1, g2, i2, g3, i3); }
        }
        {
            const float og1 = __uint_as_float(__builtin_amdgcn_permlane32_swap(__float_as_uint(g1), __float_as_uint(g1), false, false)[hi ? 0 : 1]);
            const float og2 = __uint_as_float(__builtin_amdgcn_permlane32_swap(__float_as_uint(g2), __float_as_uint(g2), false, false)[hi ? 0 : 1]);
            const float og3 = __uint_as_float(__builtin_amdgcn_permlane32_swap(__float_as_uint(g3), __float_as_uint(g3), false, false)[hi ? 0 : 1]);
            const int oi1 = (int)__builtin_amdgcn_permlane32_swap((unsigned)i1, (unsigned)i1, false, false)[hi ? 0 : 1];
            const int oi2 = (int)__builtin_amdgcn_permlane32_swap((unsigned)i2, (unsigned)i2, false, false)[hi ? 0 : 1];
            const int oi3 = (int)__builtin_amdgcn_permlane32_swap((unsigned)i3, (unsigned)i3, false, false)[hi ? 0 : 1];
            if (oi1 != 255) ins3(og1, oi1, g1, i1, g2, i2, g3, i3);
            if (oi2 != 255) ins3(og2, oi2, g1, i1, g2, i2, g3, i3);
            if (oi3 != 255) ins3(og3, oi3, g1, i1, g2, i2, g3, i3);
        }
        unsigned ps1 = 0, ps2 = 0, ps3 = 0;
        if (hi == 0) {
            if (i1 != 255) ps1 = __hip_atomic_fetch_add(cntL + i1, 1u, __ATOMIC_RELAXED, __HIP_MEMORY_SCOPE_WORKGROUP);
            if (i2 != 255) ps2 = __hip_atomic_fetch_add(cntL + i2, 1u, __ATOMIC_RELAXED, __HIP_MEMORY_SCOPE_WORKGROUP);
            if (i3 != 255) ps3 = __hip_atomic_fetch_add(cntL + i3, 1u, __ATOMIC_RELAXED, __HIP_MEMORY_SCOPE_WORKGROUP);
        }
        LDS_WAIT(); __syncthreads();
        if (tid < cur) { const unsigned cn = cntL[tid]; cntL[32 + tid] = cn ? __hip_atomic_fetch_add(F.ctl + CW_TOT + bh * 32 + tid, cn, RLX_AGENT) : 0u; }
        LDS_WAIT(); __syncthreads();
        if (hi == 0) {
            if (i1 != 255) seglist[(size_t)(bh * 32 + i1) * LCAP + cntL[32 + i1] + ps1] = (unsigned short)tl;
            if (i2 != 255) seglist[(size_t)(bh * 32 + i2) * LCAP + cntL[32 + i2] + ps2] = (unsigned short)(tl | (1 << 13));
            if (i3 != 255) seglist[(size_t)(bh * 32 + i3) * LCAP + cntL[32 + i3] + ps3] = (unsigned short)(tl | (2 << 13));
        }
        LDS_WAIT(); __syncthreads();
    }
}

__device__ __forceinline__ void p3_gathered(Frame& F, const Ptrs& P, int pass = 0) {
    const int tid_l = ltid(), lane_l = tid_l & 63; (void)lane_l;
    using namespace moba;
    unsigned char* ws = P.ws;
    const bf16* Q = (const bf16*)(ws + WS_Q); const bf16* K = (const bf16*)(ws + WS_K); const bf16* V = (const bf16*)(ws + WS_V);
    const unsigned short* seglist = (const unsigned short*)(ws + WS_SEGLIST);
    float* plse = (float*)(ws + WS_PLSE);
    LAS unsigned short* ql = (LAS unsigned short*)(F.lds + L_QL); LAS unsigned* misc = (LAS unsigned*)(F.lds + L_MISC);
    LAS float* wsf = (LAS float*)(F.lds + L_WS) + F.wave * 256; LAS unsigned short* stg = (LAS unsigned short*)(F.lds + L_STG) + F.wave * 2048;
    const int tid = tid_l, lane = lane_l, wid = F.wave, r32 = lane & 31, hi = lane >> 5;
    if (tid == 0) misc[0] = __hip_atomic_fetch_add(F.ctl + CW_Q3 + 64 * pass, 1u, RLX_AGENT);
    LDS_WAIT(); __syncthreads();
    for (;;) {
        const int item = (int)misc[0];
        if (item >= 31 * 32) break;
        const int j = item >> 5, bh = item & 31, b = bh >> 4, h = bh & 15;
        const int n = (int)__hip_atomic_load(F.ctl + CW_TOT + bh * 32 + j, RLX_AGENT);
        unsigned nxt = 0; if (tid == 0) nxt = __hip_atomic_fetch_add(F.ctl + CW_Q3 + 64 * pass, 1u, RLX_AGENT);
        { const unsigned short* sp = seglist + (size_t)(bh * 32 + j) * LCAP; for (int i = tid; i < n; i += NWAVES * 64) ql[i] = sp[i]; }
        stage_kv(K, V, b, h, j, F.lds, wid, lane);
        const int ngroups = (n + 31) >> 5;
        bf16x8 qn[4];
        if (wid < ngroups) { const int idx = wid * 32 + r32; const unsigned e = ql[idx < n ? idx : n - 1]; const bf16* qp = Q + (size_t)(b * SEQ + (int)(e & 8191u)) * D + h * HD + hi * 8;
#pragma unroll
            for (int d0 = 0; d0 < 4; ++d0) qn[d0] = *(const bf16x8*)(qp + d0 * 16); }
        for (int g = wid; g < ngroups; g += NWAVES) {
            const int idx = g * 32 + r32; const unsigned e = ql[idx < n ? idx : n - 1]; const int tl = (int)(e & 8191u);
            bf16x8 qr[4];
#pragma unroll
            for (int d0 = 0; d0 < 4; ++d0) qr[d0] = qn[d0];
            if (g + NWAVES < ngroups) { const int ix = (g + NWAVES) * 32 + r32; const unsigned en = ql[ix < n ? ix : n - 1]; const bf16* qp = Q + (size_t)(b * SEQ + (int)(en & 8191u)) * D + h * HD + hi * 8;
#pragma unroll
                for (int d0 = 0; d0 < 4; ++d0) qn[d0] = *(const bf16x8*)(qp + d0 * 16); }
            f32x16 o0, o1; float mhat, lsum;
            wave_block<false>(qr, (lds_cptr)(F.lds + L_K), (lds_cptr)(F.lds + L_V), 4, 0, wsf, lane, o0, o1, mhat, lsum);
            stage_o(o0, o1, lsum, wsf, stg, lane);
            if (hi == 0 && idx < n) plse[((size_t)(e >> 13) * M + (size_t)(b * SEQ + tl)) * 16 + h] = mhat + __builtin_amdgcn_logf(lsum);
#pragma unroll
            for (int i = 0; i < 4; ++i) { const int row = i * 8 + (lane >> 3), ch = lane & 7, ix = g * 32 + row;
                if (ix < n) { const unsigned e2 = ql[ix]; const unsigned rk = e2 >> 13; const size_t t2 = (size_t)(b * SEQ) + (e2 & 8191u);
                    unsigned char* pb = (rk == 2u) ? (ws + WS_P2) : ((unsigned char*)P.out + (size_t)rk * PART_STRIDE);
                    *(u32x4*)(pb + (t2 * D + h * HD + ch * 8) * 2) = *(const LAS u32x4*)(stg + row * 64 + ch * 8); } }
            LDS_WAIT();
        }
        LDS_WAIT(); __syncthreads();
        if (tid == 0) misc[0] = nxt;
        LDS_WAIT(); __syncthreads();
    }
}

__device__ __forceinline__ void p4_own_combine(Frame& F, const Ptrs& P) {
    const int tid_l = ltid(), lane_l = tid_l & 63; (void)lane_l;
    using namespace moba;
    unsigned char* ws = P.ws; asm volatile("" : "+v"(ws));
    unsigned char* outp = (unsigned char*)P.out; asm volatile("" : "+v"(outp));
    const bf16* Q = (const bf16*)(ws + WS_Q); const bf16* K = (const bf16*)(ws + WS_K); const bf16* V = (const bf16*)(ws + WS_V); bf16* O = (bf16*)(ws + WS_AB);
    const float* plse = (const float*)(ws + WS_PLSE);
    const int lane = lane_l, wid = F.wave, r32 = lane & 31, hi = lane >> 5, widv = tid_l >> 6;
    LAS float* wsf = (LAS float*)(F.lds + L_WS) + widv * 256; LAS unsigned short* stg = (LAS unsigned short*)(F.lds + L_STG) + widv * 2048;
    for (int unit = F.vcu; unit < BATCH * NH * NBLK; unit += F.G) {
        const int bh = unit >> 5, cur = unit & 31, b = bh >> 4, h = bh & 15;
        stage_kv(K, V, b, h, cur, F.lds, wid, lane);
        const size_t t0 = (size_t)b * SEQ + (size_t)cur * MB + widv * 32;
        const bf16* qp = Q + (t0 + r32) * D + h * HD + hi * 8;
        bf16x8 qr[4];
#pragma unroll
        for (int d0 = 0; d0 < 4; ++d0) qr[d0] = *(const bf16x8*)(qp + d0 * 16);
        f32x16 o0, o1; float mhat, lsum;
        wave_block<true>(qr, (lds_cptr)(F.lds + L_K), (lds_cptr)(F.lds + L_V), (wid >> 1) + 1, widv * 32 + r32, wsf, lane, o0, o1, mhat, lsum);
        stage_o(o0, o1, lsum, wsf, stg, lane);
        const int nv = cur < 3 ? cur : 3;
        { const float l0 = mhat + __builtin_amdgcn_logf(lsum); float lr[3]; float mx = l0;
#pragma unroll
          for (int r = 0; r < 3; ++r) { lr[r] = (r < nv) ? plse[((size_t)r * M + t0 + r32) * 16 + h] : -INFINITY; mx = __builtin_fmaxf(mx, lr[r]); }
          const float w0 = __builtin_amdgcn_exp2f(l0 - mx); float wr[3]; float ws_ = w0;
#pragma unroll
          for (int r = 0; r < 3; ++r) { wr[r] = __builtin_amdgcn_exp2f(lr[r] - mx); ws_ += wr[r]; }
          const float inv = 1.0f / ws_;
          if (hi == 0) { wsf[64 + r32 * 4] = w0 * inv; wsf[64 + r32 * 4 + 1] = wr[0] * inv; wsf[64 + r32 * 4 + 2] = wr[1] * inv; wsf[64 + r32 * 4 + 3] = wr[2] * inv; } }
        LDS_WAIT();
#pragma unroll
        for (int i = 0; i < 4; ++i) { const int row = i * 8 + (lane >> 3), ch = lane & 7; const size_t off = (t0 + row) * D + h * HD + ch * 8;
            const u32x4 ow = *(const LAS u32x4*)(stg + row * 64 + ch * 8); const float w0 = wsf[64 + row * 4];
            float a[8] = {w0 * bflo(ow.x), w0 * bfhi(ow.x), w0 * bflo(ow.y), w0 * bfhi(ow.y), w0 * bflo(ow.z), w0 * bfhi(ow.z), w0 * bflo(ow.w), w0 * bfhi(ow.w)};
#pragma unroll
            for (int r = 0; r < 3; ++r) if (r < nv) { const unsigned char* pb = (r == 2) ? (ws + WS_P2) : (outp + (size_t)r * PART_STRIDE);
                const u32x4 pw = *(const u32x4*)(pb + off * 2); const float w = wsf[64 + row * 4 + 1 + r];
                a[0] += w * bflo(pw.x); a[1] += w * bfhi(pw.x); a[2] += w * bflo(pw.y); a[3] += w * bfhi(pw.y); a[4] += w * bflo(pw.z); a[5] += w * bfhi(pw.z); a[6] += w * bflo(pw.w); a[7] += w * bfhi(pw.w); }
            v4u w; w.x = pk2(a[0], a[1]); w.y = pk2(a[2], a[3]); w.z = pk2(a[4], a[5]); w.w = pk2(a[6], a[7]); *(v4u*)(O + off) = w; }
        LDS_WAIT(); __syncthreads();
    }
}

namespace mls {
using namespace moba;
typedef float f32x4v __attribute__((ext_vector_type(4)));
constexpr int XTRA_OFF = LDSCTL_OFF + 512;
__device__ __forceinline__ float softcap_f(float g) { const float x = g * (1.0f / SOFTCAP); const float e = fexp(2.0f * x); return SOFTCAP * (e - 1.0f) / (e + 1.0f); }
__device__ __forceinline__ float logsigmoid_f(float f) { return fminf(f, 0.f) - __builtin_amdgcn_logf(1.0f + fexp(-fabsf(f))) * 0.6931471805599453f; }
__device__ __forceinline__ float scan_add(float v, int lane) {
#pragma unroll
    for (int o = 1; o < 64; o <<= 1) { const float t = __shfl_up(v, o); if (lane >= o) v += t; }
    return v; }
__device__ __forceinline__ float scan_max(float v, int lane) {
#pragma unroll
    for (int o = 1; o < 64; o <<= 1) { const float t = __shfl_up(v, o); if (lane >= o) v = fmaxf(v, t); }
    return v; }
__device__ __forceinline__ bf16x8 trfrag(lds_cptr p, int ks) { const s16x4 lo = vtr(p + ks * 1024), hi = vtr(p + ks * 1024 + 512); return (bf16x8){lo[0], lo[1], lo[2], lo[3], hi[0], hi[1], hi[2], hi[3]}; }
__device__ __forceinline__ v4u scale8(const v4u w, float s) { v4u o; o.x = cvtpk_s(bflo(w.x) * s, bfhi(w.x) * s); o.y = cvtpk_s(bflo(w.y) * s, bfhi(w.y) * s); o.z = cvtpk_s(bflo(w.z) * s, bfhi(w.z) * s); o.w = cvtpk_s(bflo(w.w) * s, bfhi(w.w) * s); return o; }
}

__device__ __forceinline__ void pa_mlstm_local(Frame& F, const Ptrs& P) {
    const int tid_l = ltid(), lane_l = tid_l & 63; (void)lane_l;
    using namespace mls;
    unsigned char* ws = P.ws;
    const bf16* HB = (const bf16*)(ws + WS_AB); const bf16* MK = (const bf16*)(ws + WS_MK); const bf16* MV = (const bf16*)(ws + WS_MV);
    const bf16* WGb = (const bf16*)(ws + WS_WG); const float* ssq = (const float*)(ws + WS_SSQ) + (size_t)2 * M * 16;
    bf16* cloc = (bf16*)(ws + WS_CLOC); float* nloc = (float*)(ws + WS_NLOC); float* scal = (float*)(ws + WS_SCAL); float* BIG = (float*)(ws + WS_BIG);
    const int tid = tid_l, lane = tid & 63, wid = F.wave, r32 = lane & 31, hi = lane >> 5, fr = lane & 15, fq = lane >> 4;
    LAS float* gpart = (LAS float*)(F.lds + RING_OFF);
    LAS float* igA = (LAS float*)(F.lds + XTRA_OFF); LAS float* lfA = igA + 8 * 64;
    LAS unsigned char* kimg = F.lds + RING_OFF + wid * 16384; LAS unsigned char* vimg = kimg + 8192;
    const lds_cptr ktr = (lds_cptr)kimg + ((lane >> 4) & 1) * 32 + (lane & 3) * 8 + (4 * hi + ((lane & 15) >> 2)) * 64;
    const lds_cptr vtrp = ktr + 8192;
    for (int unit = F.vcu; unit < BATCH * NCH; unit += F.G) {
        const int b = unit >> 7, c = unit & 127; const size_t t0 = (size_t)b * SEQ + (size_t)c * LCH;
        {
            pg8::f32x4 acc[4];
#pragma unroll
            for (int m = 0; m < 4; ++m) acc[m] = (pg8::f32x4){0.f, 0.f, 0.f, 0.f};
#pragma unroll
            for (int ks = 0; ks < 4; ++ks) { const int k0 = wid * 128 + ks * 32 + fq * 8;
                const bf16x8 bw = *(const bf16x8*)(WGb + (size_t)fr * D + k0);
#pragma unroll
                for (int m = 0; m < 4; ++m) { const bf16x8 a = *(const bf16x8*)(HB + (t0 + m * 16 + fr) * D + k0); acc[m] = __builtin_amdgcn_mfma_f32_16x16x32_bf16(a, bw, acc[m], 0, 0, 0); } }
#pragma unroll
            for (int m = 0; m < 4; ++m)
#pragma unroll
                for (int r = 0; r < 4; ++r) gpart[(wid * 64 + m * 16 + 4 * fq + r) * 16 + fr] = acc[m][r];
        }
        LDS_WAIT(); __syncthreads();
#pragma unroll
        for (int e = 0; e < 2; ++e) { const int o = tid * 2 + e, row = o >> 4, col = o & 15; float s = 0.f;
#pragma unroll
            for (int w = 0; w < 8; ++w) s += gpart[(w * 64 + row) * 16 + col];
            const float val = softcap_f(s * pg8::row_rstd(ssq, (int)t0 + row) + P.b_gates[col]);
            if (col < 8) igA[col * 64 + row] = val; else lfA[(col - 8) * 64 + row] = logsigmoid_f(val); }
        LDS_WAIT(); __syncthreads();
        const int h = wid, mu = (b * MH + h) * NCH + c;
        const float ig = igA[h * 64 + lane], bcum = scan_add(lfA[h * 64 + lane], lane), bL = __shfl(bcum, 63);
        const float a = bL - bcum + ig, ml = wave_max(a), wgt = fexp(a - ml);
        BIG[(size_t)mu * 128 + lane] = bcum; BIG[(size_t)mu * 128 + 64 + lane] = ig;
        if (lane == 0) { scal[mu] = ml; scal[NUNIT + mu] = bL; }
        {
            const v4u* kp = (const v4u*)(MK + (t0 + lane) * 512 + h * DK);
#pragma unroll
            for (int ch = 0; ch < 8; ++ch) *(LAS v4u*)(kimg + (ch >> 2) * 4096 + lane * 64 + (ch & 3) * 16) = scale8(kp[ch], wgt);
        }
#pragma unroll 1
        for (int rv = 0; rv < 2; ++rv) {
            { const v4u* vp = (const v4u*)(MV + (t0 + lane) * 1024 + h * DV + rv * 64);
#pragma unroll
              for (int ch = 0; ch < 8; ++ch) *(LAS v4u*)(vimg + (ch >> 2) * 4096 + lane * 64 + (ch & 3) * 16) = vp[ch]; }
            LDS_WAIT();
#pragma unroll
            for (int kt = 0; kt < 2; ++kt) {
                bf16x8 af[4];
#pragma unroll
                for (int ks = 0; ks < 4; ++ks) af[ks] = trfrag(ktr + kt * 4096, ks);
#pragma unroll
                for (int vt = 0; vt < 2; ++vt) {
                    f32x16 d = f32x16{};
#pragma unroll
                    for (int ks = 0; ks < 4; ++ks) d = MOBA_MFMA(af[ks], trfrag(vtrp + vt * 4096, ks), d);
                    bf16* cp = cloc + (size_t)mu * 8192 + (size_t)(rv * 64 + vt * 32 + r32) * 64 + kt * 32 + 4 * hi;
#pragma unroll
                    for (int g = 0; g < 4; ++g) { uint2 w; w.x = cvtpk_s(d[4 * g], d[4 * g + 1]); w.y = cvtpk_s(d[4 * g + 2], d[4 * g + 3]); *(uint2*)(cp + 8 * g) = w; }
                }
                if (rv == 0) {
                    const bf16x8 ones = (bf16x8){0x3F80, 0x3F80, 0x3F80, 0x3F80, 0x3F80, 0x3F80, 0x3F80, 0x3F80};
                    f32x16 d = f32x16{};
#pragma unroll
                    for (int ks = 0; ks < 4; ++ks) d = MOBA_MFMA(af[ks], ones, d);
                    if (r32 == 0) {
#pragma unroll
                        for (int r = 0; r < 16; ++r) nloc[(size_t)mu * 64 + kt * 32 + crow(r, hi)] = d[r]; }
                }
            }
            LDS_WAIT();
        }
        LDS_WAIT(); __syncthreads();
    }
}
__device__ __forceinline__ void pb_mlstm_scan(Frame& F, const Ptrs& P, bool dry = false) {
    const int tid_l = ltid(), lane_l = tid_l & 63; (void)lane_l;
    unsigned char* ws = P.ws;
    bf16* cloc = (bf16*)(ws + WS_CLOC); float* nloc = (float*)(ws + WS_NLOC); float* scal = (float*)(ws + WS_SCAL);
    LAS float* dec = (LAS float*)(F.lds + RING_OFF); LAS float* scl = dec + NCH;
    const int tid = tid_l;
    for (int unit = F.vcu; unit < BATCH * MH * 16; unit += F.G) {
        const int bh = unit >> 4, sl = unit & 15;
        if (tid < 64) {
            float mp = 0.f;
            for (int c = 0; c < NCH; ++c) { const int mu = bh * NCH + c; const float ml = scal[mu], bl = scal[NUNIT + mu];
                const float mn = fmaxf(bl + mp, ml);
                if (tid == 0) { dec[c] = fexp(bl + mp - mn); scl[c] = fexp(ml - mn); if (sl == 0 && !dry) scal[2 * NUNIT + mu] = mp; }
                mp = mn; }
        }
        LDS_WAIT(); __syncthreads();
        { bf16* p = cloc + (size_t)bh * NCH * 8192 + sl * 512 + tid; bf16* pw = dry ? p + (size_t)32 * MiB / 2 : p; float st = 0.f;
#pragma unroll 1
          for (int c0 = 0; c0 < NCH; c0 += 16) { unsigned short x[16];
#pragma unroll
              for (int i = 0; i < 16; ++i) x[i] = p[(size_t)(c0 + i) * 8192];
#pragma unroll
              for (int i = 0; i < 16; ++i) { pw[(size_t)(c0 + i) * 8192] = (bf16)f2bf(st); st = dec[c0 + i] * st + scl[c0 + i] * bf2f(x[i]); } } }
        if (sl == 0 && tid < 64 && !dry) { float* p = nloc + (size_t)bh * NCH * 64 + tid; float st = 0.f;
#pragma unroll 1
            for (int c0 = 0; c0 < NCH; c0 += 16) { float x[16];
#pragma unroll
                for (int i = 0; i < 16; ++i) x[i] = p[(size_t)(c0 + i) * 64];
#pragma unroll
                for (int i = 0; i < 16; ++i) { p[(size_t)(c0 + i) * 64] = st; st = dec[c0 + i] * st + scl[c0 + i] * x[i]; } } }
        LDS_WAIT(); __syncthreads();
    }
}
__device__ __forceinline__ void pc_mlstm_out(Frame& F, const Ptrs& P) {
    const int tid_l = ltid(), lane_l = tid_l & 63; (void)lane_l;
    using namespace mls;
    unsigned char* ws = P.ws;
    const bf16* MQ = (const bf16*)(ws + WS_MQ); const bf16* MK = (const bf16*)(ws + WS_MK); const bf16* MV = (const bf16*)(ws + WS_MV); const bf16* OG = (const bf16*)(ws + WS_OG);
    const bf16* cin = (const bf16*)(ws + WS_CLOC); const float* nin = (const float*)(ws + WS_NLOC); const float* scal = (const float*)(ws + WS_SCAL); const float* BIG = (const float*)(ws + WS_BIG);
    bf16* Y = (bf16*)(ws + WS_Y);
    const int tid = tid_l, lane = tid & 63, wid = F.wave, r32 = lane & 31, hi = lane >> 5, qg = wid & 1, vt = wid >> 1;
    constexpr int LK = 0, LV = 8192, LH = 24576, HP = 132;
    LAS float* hst = (LAS float*)(F.lds + RING_OFF + LH);
    LAS float* garr = (LAS float*)(F.lds + mls::XTRA_OFF); LAS float* mmarr = garr + 64; LAS float* barr = mmarr + 64; LAS float* nn = barr + 64; LAS float* wsf = nn + 64 + wid * 64;
    const lds_cptr kp0 = (lds_cptr)(F.lds + RING_OFF + LK) + hi * 1024 + r32 * 16;
    const lds_cptr vp0 = (lds_cptr)(F.lds + RING_OFF + LV) + vt * 4096 + ((lane >> 4) & 1) * 32 + (lane & 3) * 8 + (4 * hi + ((lane & 15) >> 2)) * 64;
    for (int unit = F.vcu; unit < NUNIT; unit += F.G) {
        const int bh = unit >> 7, c = unit & 127, b = bh >> 3, h = bh & 7; const size_t t0 = (size_t)b * SEQ + (size_t)c * LCH;
        const float m_in = scal[2 * NUNIT + unit];
        {
            const unsigned lds0 = (unsigned)(uintptr_t)(F.lds + RING_OFF);
            glds16(MK + (t0 + lane) * 512 + h * DK + wid * 8, (unsigned)__builtin_amdgcn_readfirstlane(lds0 + LK + wid * 1024));
#pragma unroll
            for (int i = 0; i < 2; ++i) { const int p = wid + 8 * i;
                glds16(MV + (t0 + 16 * (p & 3) + (lane >> 2)) * 1024 + h * DV + (p >> 2) * 32 + (lane & 3) * 8, (unsigned)__builtin_amdgcn_readfirstlane(lds0 + LV + p * 1024)); }
        }
        if (wid == 0) {
            const float bc = BIG[(size_t)unit * 128 + lane], g = BIG[(size_t)unit * 128 + 64 + lane] - bc;
            garr[lane] = g; mmarr[lane] = fmaxf(m_in, scan_max(g, lane)); barr[lane] = bc; nn[lane] = nin[(size_t)unit * 64 + lane];
        }
        asm volatile("s_waitcnt vmcnt(0) lgkmcnt(0)\n\ts_barrier" ::: "memory");
        {
            const int l = qg * 32 + r32;
            const bf16* qp = MQ + (t0 + l) * 512 + h * DK + hi * 8;
            bf16x8 qr[4], cf[4];
#pragma unroll
            for (int d0 = 0; d0 < 4; ++d0) qr[d0] = *(const bf16x8*)(qp + d0 * 16);
            const bf16* cp = cin + (size_t)unit * 8192 + (size_t)(vt * 32 + r32) * 64 + hi * 8;
#pragma unroll
            for (int d0 = 0; d0 < 4; ++d0) cf[d0] = *(const bf16x8*)(cp + d0 * 16);
            bf16x8 kf[8];
#pragma unroll
            for (int d0 = 0; d0 < 4; ++d0) { kf[2 * d0] = *(const LAS bf16x8*)(kp0 + d0 * 2048); kf[2 * d0 + 1] = *(const LAS bf16x8*)(kp0 + d0 * 2048 + 512); }
            f32x16 c0 = f32x16{}, c1 = f32x16{};
#pragma unroll
            for (int d0 = 0; d0 < 4; ++d0) { c0 = MOBA_MFMA(kf[2 * d0], qr[d0], c0); c1 = MOBA_MFMA(kf[2 * d0 + 1], qr[d0], c1); }
            const float mml = mmarr[l];
            float rsum = 0.f; int lrel = l - 4 * hi; asm volatile("" : "+v"(lrel));
#pragma unroll
            for (int r = 0; r < 16; ++r) { const int s0 = crow(r, hi), s1 = s0 + 32, sr = (r & 3) + 8 * (r >> 2);
                const float e0 = __builtin_amdgcn_exp2f((garr[s0] - mml) * LOG2E), e1 = __builtin_amdgcn_exp2f((garr[s1] - mml) * LOG2E);
                c0[r] = __builtin_bit_cast(float, __builtin_bit_cast(unsigned, c0[r] * e0) & ~(unsigned)((lrel - sr) >> 31));
                c1[r] = __builtin_bit_cast(float, __builtin_bit_cast(unsigned, c1[r] * e1) & ~(unsigned)((lrel - sr - 32) >> 31)); rsum += c0[r] + c1[r]; }
            rsum = halves_sum(rsum);
            float qn = 0.f;
#pragma unroll
            for (int d0 = 0; d0 < 4; ++d0)
#pragma unroll
                for (int j = 0; j < 8; ++j) qn += bf2f((unsigned short)qr[d0][j]) * nn[d0 * 16 + hi * 8 + j];
            qn = halves_sum(qn);
            const float inter = fexp(m_in - mml), den = inter * qn + rsum, rd = 1.0f / fmaxf(fabsf(den), fexp(-(barr[l] + mml)));
            if (hi == 0) { wsf[r32] = inter; wsf[32 + r32] = rd; }
            f32x16 o = f32x16{};
#pragma unroll
            for (int d0 = 0; d0 < 4; ++d0) o = MOBA_MFMA(qr[d0], cf[d0], o);
            asm volatile("s_waitcnt lgkmcnt(0)" ::: "memory");
#pragma unroll
            for (int r = 0; r < 16; ++r) o[r] *= wsf[crow(r, hi)];
            u32x4 pw0, pw1, pw2, pw3;
            pw0 = (u32x4){cvtpk_s(c0[0], c0[1]), cvtpk_s(c0[2], c0[3]), cvtpk_s(c0[4], c0[5]), cvtpk_s(c0[6], c0[7])}; pw1 = (u32x4){cvtpk_s(c0[8], c0[9]), cvtpk_s(c0[10], c0[11]), cvtpk_s(c0[12], c0[13]), cvtpk_s(c0[14], c0[15])};
            pw2 = (u32x4){cvtpk_s(c1[0], c1[1]), cvtpk_s(c1[2], c1[3]), cvtpk_s(c1[4], c1[5]), cvtpk_s(c1[6], c1[7])}; pw3 = (u32x4){cvtpk_s(c1[8], c1[9]), cvtpk_s(c1[10], c1[11]), cvtpk_s(c1[12], c1[13]), cvtpk_s(c1[14], c1[15])};
            o = MOBA_MFMA(__builtin_bit_cast(bf16x8, pw0), trfrag(vp0, 0), o); o = MOBA_MFMA(__builtin_bit_cast(bf16x8, pw1), trfrag(vp0, 1), o);
            o = MOBA_MFMA(__builtin_bit_cast(bf16x8, pw2), trfrag(vp0, 2), o); o = MOBA_MFMA(__builtin_bit_cast(bf16x8, pw3), trfrag(vp0, 3), o);
#pragma unroll
            for (int r = 0; r < 16; ++r) hst[(qg * 32 + crow(r, hi)) * HP + vt * 32 + r32] = o[r] * wsf[32 + crow(r, hi)];
        }
        LDS_WAIT(); __syncthreads();
        {
            const int l = tid >> 3, vb = (tid & 7) * 16; float hv[16]; float ss = 0.f;
#pragma unroll
            for (int j = 0; j < 4; ++j) { const mls::f32x4v x = *(const LAS mls::f32x4v*)(hst + l * HP + vb + 4 * j); hv[4 * j] = x.x; hv[4 * j + 1] = x.y; hv[4 * j + 2] = x.z; hv[4 * j + 3] = x.w; ss += (x.x * x.x + x.y * x.y) + (x.z * x.z + x.w * x.w); }
            ss += __shfl_xor(ss, 1); ss += __shfl_xor(ss, 2); ss += __shfl_xor(ss, 4);
            const float r = __builtin_amdgcn_rsqf(ss * (1.0f / 128.0f) + RMS_EPS);
            const size_t off = (t0 + l) * D + h * DV + vb; const v4u* gp = (const v4u*)(OG + off); const f32x4* np = (const f32x4*)(P.head_norm + h * DV + vb);
            float y[16];
#pragma unroll
            for (int i = 0; i < 2; ++i) { const v4u u = gp[i]; const f32x4 n0 = np[2 * i], n1 = np[2 * i + 1];
                y[8 * i] = bflo(u.x) * hv[8 * i] * r * n0.x; y[8 * i + 1] = bfhi(u.x) * hv[8 * i + 1] * r * n0.y; y[8 * i + 2] = bflo(u.y) * hv[8 * i + 2] * r * n0.z; y[8 * i + 3] = bfhi(u.y) * hv[8 * i + 3] * r * n0.w;
                y[8 * i + 4] = bflo(u.z) * hv[8 * i + 4] * r * n1.x; y[8 * i + 5] = bfhi(u.z) * hv[8 * i + 5] * r * n1.y; y[8 * i + 6] = bflo(u.w) * hv[8 * i + 6] * r * n1.z; y[8 * i + 7] = bfhi(u.w) * hv[8 * i + 7] * r * n1.w; }
            v4u* yp = (v4u*)(Y + off);
#pragma unroll
            for (int i = 0; i < 2; ++i) { v4u o; o.x = pk2(y[8 * i], y[8 * i + 1]); o.y = pk2(y[8 * i + 2], y[8 * i + 3]); o.z = pk2(y[8 * i + 4], y[8 * i + 5]); o.w = pk2(y[8 * i + 6], y[8 * i + 7]); yp[i] = o; }
        }
        LDS_WAIT(); __syncthreads();
    }
}
__device__ __forceinline__ void p_final_norm(Frame& F, const Ptrs& P, bool dry = false) {
    const int tid_l = ltid(), lane_l = tid_l & 63; (void)lane_l;
    const int gw = F.vcu * NWAVES + F.wave, NGW = F.G * NWAVES;
    const f32x4* wn = (const f32x4*)P.final_norm + lane_l;
    for (int m = gw; m < M; m += NGW) {
        GAS f32x4* xr = (GAS f32x4*)(P.out + (size_t)m * D) + lane_l; f32x4 v[4]; float s = 0.f;
#pragma unroll
        for (int j = 0; j < 4; ++j) { v[j] = xr[64 * j]; s += (v[j].x * v[j].x + v[j].y * v[j].y) + (v[j].z * v[j].z + v[j].w * v[j].w); }
        const float r = __builtin_amdgcn_rsqf(wave_sum(s) * (1.0f / D) + RMS_EPS);
        { GAS f32x4* xw = dry ? (GAS f32x4*)((float*)(P.ws + WS_AB) + (size_t)m * D) + lane_l : xr;
#pragma unroll
        for (int j = 0; j < 4; ++j) xw[64 * j] = v[j] * r * wn[64 * j]; }
    }
}

struct Args { Ptrs p; };
__device__ __forceinline__ Ptrs load_ptrs() {
#if defined(__HIP_DEVICE_COMPILE__)
    typedef __attribute__((address_space(4))) const unsigned long long* kptr_t;
    kptr_t kp = (kptr_t)__builtin_amdgcn_kernarg_segment_ptr();
    asm volatile("" : "+s"(kp));
    Ptrs p;
    p.x = (const float*)kp[0]; p.attn_norm = (const float*)kp[1]; p.w_qkv = (const float*)kp[2]; p.w_o = (const float*)kp[3]; p.mlstm_norm = (const float*)kp[4]; p.w_in = (const float*)kp[5];
    p.b_gates = (const float*)kp[6]; p.head_norm = (const float*)kp[7]; p.w_out = (const float*)kp[8]; p.ffn_norm = (const float*)kp[9]; p.w_gu = (const float*)kp[10]; p.w_down = (const float*)kp[11];
    p.final_norm = (const float*)kp[12]; p.out = (float*)kp[13]; p.ws = (unsigned char*)kp[14];
    return p;
#else
    return Ptrs{};
#endif
}
__global__ void __launch_bounds__(NWAVES * 64, 2) mk_fwd(Args args) {
    extern __shared__ __attribute__((aligned(16))) unsigned char lds[];
    Frame F;
    F.lds = (LAS unsigned char*)lds;
    F.MISC = (volatile LAS unsigned*)(F.lds + MISC_OFF);
    F.wave = __builtin_amdgcn_readfirstlane((int)threadIdx.x >> 6);
    F.G = gridDim.x; { const int bx = blockIdx.x; F.vcu = (F.G % 8 == 0) ? (bx % 8) * (F.G / 8) + bx / 8 : bx; }
    F.ctl = (gu32*)(args.p.ws + WS_CTL);
    for (int u = ((int)threadIdx.x); u < (LDS_BYTES - LDSCTL_OFF) / 4; u += NWAVES * 64) ((LAS unsigned*)(F.lds + LDSCTL_OFF))[u] = 0u;
    __syncthreads();
    XcdBarrier bar = xcd_barrier_post((unsigned*)(F.ctl + CW_BAR), F.MISC + 8);
#define GRID_BAR() xcd_barrier(bar)
#ifndef PH_MASK
#define PH_MASK 0xFFFFF
#endif
#define PH(k) ((PH_MASK >> (k)) & 1)
#ifndef DUP_MASK
#define DUP_MASK 0
#endif
#ifndef EXTRA_BARS
#define EXTRA_BARS 0
#endif
#define REP(k) for (int rep_ = 0; rep_ <= ((DUP_MASK >> (k)) & 1); ++rep_)
#define PHASE_PTRS() const Ptrs P = load_ptrs(); unsigned char* const ws = P.ws; (void)ws
#define SSQ(i) ((float*)(ws + WS_SSQ) + (size_t)(i) * M * 16)

    REP(0) if (PH(0)) { PHASE_PTRS(); p0_prologue(F, P); } GRID_BAR();
    _Pragma("unroll 1") for (int xb_ = 0; xb_ < EXTRA_BARS; ++xb_) GRID_BAR();
    REP(1) if (PH(1)) { PHASE_PTRS(); pg8::Gemm g{(const bf16*)(ws + WS_AB), (const bf16*)(ws + WS_WQKV), M, 3 * D, D}; pg8::StaticOrder S; S.init(M, 3 * D, F.G, (int)blockIdx.x);
      pg8::EpiQKV E{(bf16*)(ws + WS_Q), (size_t)(WS_K - WS_Q) / 2, SSQ(0), (const float*)(ws + WS_ROPE), (float*)(ws + WS_KMEAN)};
      pg8::gemm_phase<pg8::EpiQKV, pg8::StaticOrder, PG8_ALIGN, PG8_SP2>(F.lds + RING_OFF, g, S, E); } GRID_BAR();
    REP(2) if (PH(2)) { PHASE_PTRS(); p2_gating(F, P); } GRID_BAR();
    REP(3) if (PH(3)) { PHASE_PTRS(); p3_gathered(F, P, rep_); } GRID_BAR();
    REP(15) if (PH(15)) { PHASE_PTRS(); p4_own_combine(F, P); } GRID_BAR();
    REP(4) if (PH(4)) { PHASE_PTRS(); pg8::Gemm g{(const bf16*)(ws + WS_AB), (const bf16*)(ws + WS_WO), M, D, D}; pg8::StaticOrder S; S.init(M, D, F.G, (int)blockIdx.x);
      pg8::EpiRes<true, false> E{P.x, ws + WS_HB1, SSQ(1)};
      pg8::gemm_phase<pg8::EpiRes<true, false>, pg8::StaticOrder, PG8_ALIGN, PG8_SP2>(F.lds + RING_OFF, g, S, E); } GRID_BAR();
    REP(5) if (PH(5)) { PHASE_PTRS(); pg8::Gemm g{(const bf16*)(ws + WS_HB1), (const bf16*)(ws + WS_WGU), M, NGU, D}; pg8::StaticOrder S; S.init(M, NGU, F.G, (int)blockIdx.x);
      pg8::EpiSwiGLU E{(bf16*)(ws + WS_ACT), SSQ(1)};
      pg8::gemm_phase<pg8::EpiSwiGLU, pg8::StaticOrder, PG8_ALIGN, PG8_SP2>(F.lds + RING_OFF, g, S, E); } GRID_BAR();
    REP(6) if (PH(6)) { PHASE_PTRS(); pg8::Gemm g{(const bf16*)(ws + WS_ACT), (const bf16*)(ws + WS_WD), M, D, DFF}; pg8::StaticOrder S; S.init(M, D, F.G, (int)blockIdx.x);
      pg8::EpiRes<false, false> E{ws + WS_HB1, ws + WS_AB, SSQ(2)};
      pg8::gemm_phase<pg8::EpiRes<false, false>, pg8::StaticOrder, PG8_ALIGN, PG8_SP2>(F.lds + RING_OFF, g, S, E); } GRID_BAR();
    REP(7) if (PH(7)) { PHASE_PTRS(); pg8::Gemm g{(const bf16*)(ws + WS_AB), (const bf16*)(ws + WS_WIN), M, NIN, D}; pg8::StaticOrder S; S.init(M, NIN, F.G, (int)blockIdx.x);
      pg8::EpiMlstmIn E{(bf16*)(ws + WS_MQ), (bf16*)(ws + WS_MK), (bf16*)(ws + WS_MV), (bf16*)(ws + WS_OG), SSQ(2)};
      pg8::gemm_phase<pg8::EpiMlstmIn, pg8::StaticOrder, PG8_ALIGN, PG8_SP2>(F.lds + RING_OFF, g, S, E); } GRID_BAR();
    REP(8) if (PH(8)) { PHASE_PTRS(); pa_mlstm_local(F, P); } GRID_BAR();
    REP(9) if (PH(9)) { PHASE_PTRS(); pb_mlstm_scan(F, P, rep_ < ((DUP_MASK >> 9) & 1)); } GRID_BAR();
    REP(10) if (PH(10)) { PHASE_PTRS(); pc_mlstm_out(F, P); } GRID_BAR();
    if (PH(11)) { PHASE_PTRS(); pg8::Gemm g{(const bf16*)(ws + WS_Y), (const bf16*)(ws + WS_WOUT), M, D, D}; pg8::StaticOrder S; S.init(M, D, F.G, (int)blockIdx.x);
      pg8::EpiRes<false, false> E{ws + WS_AB, ws + WS_HB1, SSQ(3)};
      pg8::gemm_phase<pg8::EpiRes<false, false>, pg8::StaticOrder, PG8_ALIGN, PG8_SP2>(F.lds + RING_OFF, g, S, E); } GRID_BAR();
    if (PH(12)) { PHASE_PTRS(); pg8::Gemm g{(const bf16*)(ws + WS_HB1), (const bf16*)(ws + WS_WGU) + (size_t)NGU * D, M, NGU, D}; pg8::StaticOrder S; S.init(M, NGU, F.G, (int)blockIdx.x);
      pg8::EpiSwiGLU E{(bf16*)(ws + WS_ACT), SSQ(3)};
      pg8::gemm_phase<pg8::EpiSwiGLU, pg8::StaticOrder, PG8_ALIGN, PG8_SP2>(F.lds + RING_OFF, g, S, E); } GRID_BAR();
    if (PH(13)) { PHASE_PTRS(); pg8::Gemm g{(const bf16*)(ws + WS_ACT), (const bf16*)(ws + WS_WD) + (size_t)D * DFF, M, D, DFF}; pg8::StaticOrder S; S.init(M, D, F.G, (int)blockIdx.x);
      pg8::EpiRes<false, true> E{ws + WS_HB1, P.out, nullptr};
      pg8::gemm_phase<pg8::EpiRes<false, true>, pg8::StaticOrder, PG8_ALIGN, PG8_SP2>(F.lds + RING_OFF, g, S, E); } GRID_BAR();
    REP(14) if (PH(14)) { PHASE_PTRS(); p_final_norm(F, P, rep_ < ((DUP_MASK >> 14) & 1)); }
}

extern "C" void kernel_launch(void* const* d_in, const int* in_sizes, int n_in, void* d_out, int out_size, void* d_ws, size_t ws_size, hipStream_t stream) {
    static int grid = 0;
    if (grid == 0) {
        if (n_in != 13 || in_sizes[0] != M * D || out_size != M * D || ws_size < WS_END) { fprintf(stderr, "kernel_launch: unexpected shapes (n_in %d, in0 %d, out %d, ws %zu); nothing launched\n", n_in, n_in > 0 ? in_sizes[0] : -1, out_size, ws_size); grid = -1; return; }
        int dev = 0, cus = 0, per_cu = 0;
        if (hipGetDevice(&dev) != hipSuccess || hipDeviceGetAttribute(&cus, hipDeviceAttributeMultiprocessorCount, dev) != hipSuccess) { grid = -1; return; }
        if (hipFuncSetAttribute((const void*)mk_fwd, hipFuncAttributeMaxDynamicSharedMemorySize, LDS_BYTES) != hipSuccess) { fprintf(stderr, "kernel_launch: hipFuncSetAttribute failed\n"); grid = -1; return; }
        if (hipOccupancyMaxActiveBlocksPerMultiprocessor(&per_cu, (const void*)mk_fwd, NWAVES * 64, LDS_BYTES) != hipSuccess || per_cu < 1) { fprintf(stderr, "kernel_launch: occupancy query reports %d blocks per CU\n", per_cu); }
        (void)hipGetLastError();
        grid = cus;
    }
    if (grid < 0) return;
    if (hipMemsetAsync((char*)d_ws + WS_CTL, 0, CTL_ZERO_BYTES, stream) != hipSuccess) { fprintf(stderr, "kernel_launch: hipMemsetAsync failed\n"); return; }
    Args a{};
    a.p.x = (const float*)d_in[0]; a.p.attn_norm = (const float*)d_in[1]; a.p.w_qkv = (const float*)d_in[2]; a.p.w_o = (const float*)d_in[3];
    a.p.mlstm_norm = (const float*)d_in[4]; a.p.w_in = (const float*)d_in[5]; a.p.b_gates = (const float*)d_in[6]; a.p.head_norm = (const float*)d_in[7]; a.p.w_out = (const float*)d_in[8];
    a.p.ffn_norm = (const float*)d_in[9]; a.p.w_gu = (const float*)d_in[10]; a.p.w_down = (const float*)d_in[11]; a.p.final_norm = (const float*)d_in[12];
    a.p.out = (float*)d_out; a.p.ws = (unsigned char*)d_ws;
    hipLaunchKernelGGL(mk_fwd, dim3(grid), dim3(NWAVES * 64), LDS_BYTES, stream, a);
    const hipError_t le = hipPeekAtLastError();
    if (le != hipSuccess) fprintf(stderr, "kernel_launch: launch failed: %s\n", hipGetErrorName(le));
}
```

```cpp
#include <hip/hip_runtime.h>
#include <cstdio>
#include <cstdint>
namespace pg8 {
#define PG8_LAS __attribute__((address_space(3)))
typedef unsigned short bf16_t;
typedef short bf16x8 __attribute__((ext_vector_type(8)));
typedef float f32x4 __attribute__((ext_vector_type(4)));
typedef unsigned u32x4 __attribute__((ext_vector_type(4)));
constexpr int BM = 256, BK = 64, HALF = 128, HTB = HALF * BK * 2  , STAGE_BYTES = 8 * HTB, NXCD = 8, WGM = 8;

__host__ __device__ __forceinline__ int lds_byte(int r, int c) { const int st = (r >> 4) * 2 + (c >> 5), rr = r & 15, cc = c & 31, ob = rr * 64 + cc * 2; return st * 1024 + (ob ^ (((ob >> 9) & 1) << 5)); }
__host__ __device__ __forceinline__ void stage_rc(int b, int& R, int& C) { const int st = b / 1024, sb = b % 1024, swz = sb ^ (((sb >> 9) & 1) << 5); R = (st >> 1) * 16 + swz / 64; C = (st & 1) * 32 + (swz % 64) / 2; }
__host__ __device__ __forceinline__ int perm32(int rho) { const int n = rho >> 4, i = rho & 15; return 8 * (i >> 2) + 4 * n + (i & 3); }

struct Unit { int pm, pn; };
struct Gemm { const bf16_t* A; const bf16_t* Bt; int M, N, K; };

struct StaticOrder {
    int nM, nN, nwg, G, c;
    __host__ __device__ void init(int M, int N, int G_, int c_) { nM = M / BM; nN = N / BM; nwg = nM * nN; G = G_; c = c_; }
    __host__ __device__ bool next(int i, Unit& u) const {
        const long L = (long)i * G + c; if (L >= nwg) return false;
        int wgid = (int)L; { const int q = nwg / NXCD, r = nwg % NXCD, xcd = wgid % NXCD, off = wgid / NXCD; wgid = (xcd < r ? xcd * (q + 1) : r * (q + 1) + (xcd - r) * q) + off; }
        const int nig = WGM * nN, gid = wgid / nig, fm = gid * WGM, gsz = (nM - fm) < WGM ? (nM - fm) : WGM;
        u.pm = fm + ((wgid % nig) % gsz); u.pn = (wgid % nig) / gsz; return true;
    }
    __device__ __forceinline__ void a_ready(const Unit&) const {}
    __device__ __forceinline__ void done(const Unit&) const {}
};
__device__ __forceinline__ unsigned cvt_pk_bf16(float lo, float hi) { unsigned r; asm volatile("v_cvt_pk_bf16_f32 %0, %1, %2" : "=v"(r) : "v"(lo), "v"(hi)); return r; }
typedef float f32x2 __attribute__((ext_vector_type(2)));
constexpr float RMS_EPS_F = 1e-6f;
constexpr float QSCALE_LOG2 = 0.18033688011112042f;
__device__ __forceinline__ float row_rstd(const float* ssq, int row) {
    const f32x4* p = (const f32x4*)(ssq + (size_t)row * 16);
    const f32x4 a = p[0], b = p[1], c = p[2], d = p[3];
    const float s = (((a[0] + a[1]) + (a[2] + a[3])) + ((b[0] + b[1]) + (b[2] + b[3]))) + (((c[0] + c[1]) + (c[2] + c[3])) + ((d[0] + d[1]) + (d[2] + d[3])));
    return __builtin_amdgcn_rsqf(s * (1.0f / 1024.0f) + RMS_EPS_F);
}
__device__ __forceinline__ void store16_wt(void* p, const u32x4& v) { asm volatile("global_store_dwordx4 %0, %1, off sc1\n\ts_nop 1" :: "v"(p), "v"(v) : "memory"); }
__device__ __forceinline__ u32x4 pack8(const f32x4& v0, const f32x4& v1) { u32x4 w; w.x = cvt_pk_bf16(v0[0], v0[1]); w.y = cvt_pk_bf16(v0[2], v0[3]); w.z = cvt_pk_bf16(v1[0], v1[1]); w.w = cvt_pk_bf16(v1[2], v1[3]); return w; }

struct EpiQKV {
    static constexpr bool PERM = true, AFTER_DRAIN = false;
    bf16_t* QKV; size_t tstride; const float* ssq; const float* rope; float* kmean;
    __device__ __forceinline__ void operator()(const f32x4 (&acc)[2][2][4][2], const Unit& u, int wr, int wc, int fr, int fq) const {
        const int t = u.pn >> 2;
        bf16_t* base = QKV + (size_t)t * tstride;
        const int col0 = (u.pn & 3) * BM + wc * 32 + 8 * fq;
        const bool rot = (t < 2) && ((wc & 1) == 0) && (fq < 2);
        const float sc = (t == 0) ? QSCALE_LOG2 : 1.0f;
        const int lane = fq * 16 + fr;
        float rv[2];
#pragma unroll
        for (int ai = 0; ai < 2; ++ai) rv[ai] = row_rstd(ssq, u.pm * BM + ai * HALF + wr * 64 + lane);
#pragma unroll
        for (int bj = 0; bj < 2; ++bj) {
            f32x4 ks0 = (f32x4){0.f, 0.f, 0.f, 0.f}, ks1 = ks0;
#pragma unroll
            for (int ai = 0; ai < 2; ++ai)
#pragma unroll
                for (int m = 0; m < 4; ++m) {
                    const int row = u.pm * BM + ai * HALF + wr * 64 + m * 16 + fr;
                    const float rs = __shfl(rv[ai], m * 16 + fr);
                    f32x4 v0 = acc[ai][bj][m][0] * rs, v1 = acc[ai][bj][m][1] * rs;
                    if (rot) { const f32x4* rp = (const f32x4*)(rope + (size_t)(row & 8191) * 16 + 8 * fq); const f32x4 cs0 = rp[0], cs1 = rp[1];
                        const f32x4 c = (f32x4){cs0[0], cs0[2], cs1[0], cs1[2]}, s = (f32x4){cs0[1], cs0[3], cs1[1], cs1[3]};
                        const f32x4 x1 = v0, x2 = v1; v0 = x1 * c - x2 * s; v1 = x2 * c + x1 * s; }
                    if (t == 1) { ks0 += v0; ks1 += v1; }
                    v0 = v0 * sc; v1 = v1 * sc;
                    store16_wt(base + (size_t)row * 1024 + col0 + bj * HALF, pack8(v0, v1));
                    asm volatile("" ::: "memory");
                }
            if (t == 1) {
                float* km = kmean + (size_t)u.pm * 1024 + col0 + bj * HALF;
#pragma unroll
                for (int j = 0; j < 4; ++j) {
                    float r0 = ks0[j]; r0 += __shfl_xor(r0, 1); r0 += __shfl_xor(r0, 2); r0 += __shfl_xor(r0, 4); r0 += __shfl_xor(r0, 8);
                    float r1 = ks1[j]; r1 += __shfl_xor(r1, 1); r1 += __shfl_xor(r1, 2); r1 += __shfl_xor(r1, 4); r1 += __shfl_xor(r1, 8);
                    if (fr == 0) { atomicAdd(km + j, r0 * (1.0f / 256.0f)); atomicAdd(km + 4 + j, r1 * (1.0f / 256.0f)); }
                }
            }
        }
    }
};

template <bool BASE_F32, bool OUT_F32> struct EpiRes {
    static constexpr bool PERM = true, AFTER_DRAIN = false;
    const void* base; void* out; float* ssq_out;
    __device__ __forceinline__ void operator()(const f32x4 (&acc)[2][2][4][2], const Unit& u, int wr, int wc, int fr, int fq) const {
        const int col0 = u.pn * BM + wc * 32 + 8 * fq;
#pragma unroll
        for (int ai = 0; ai < 2; ++ai)
#pragma unroll
            for (int m = 0; m < 4; ++m) {
                const int row = u.pm * BM + ai * HALF + wr * 64 + m * 16 + fr;
                float ss = 0.f;
#pragma unroll
                for (int bj = 0; bj < 2; ++bj) {
                    const size_t off = (size_t)row * 1024 + col0 + bj * HALF;
                    f32x4 b0, b1;
                    if (BASE_F32) { b0 = *(const f32x4*)((const float*)base + off); b1 = *(const f32x4*)((const float*)base + off + 4); }
                    else { const u32x4 w = *(const u32x4*)((const bf16_t*)base + off);
                        b0 = (f32x4){__builtin_bit_cast(float, w.x << 16), __builtin_bit_cast(float, w.x & 0xffff0000u), __builtin_bit_cast(float, w.y << 16), __builtin_bit_cast(float, w.y & 0xffff0000u)};
                        b1 = (f32x4){__builtin_bit_cast(float, w.z << 16), __builtin_bit_cast(float, w.z & 0xffff0000u), __builtin_bit_cast(float, w.w << 16), __builtin_bit_cast(float, w.w & 0xffff0000u)}; }
                    const f32x4 v0 = acc[ai][bj][m][0] + b0, v1 = acc[ai][bj][m][1] + b1;
                    if (OUT_F32) { *(f32x4*)((float*)out + off) = v0; *(f32x4*)((float*)out + off + 4) = v1; }
                    else { *(u32x4*)((bf16_t*)out + off) = pack8(v0, v1);
                        ss += ((v0[0] * v0[0] + v0[1] * v0[1]) + (v0[2] * v0[2] + v0[3] * v0[3])) + ((v1[0] * v1[0] + v1[1] * v1[1]) + (v1[2] * v1[2] + v1[3] * v1[3])); }
                }
                if (!OUT_F32) { ss += __shfl_xor(ss, 16); ss += __shfl_xor(ss, 32); if (fq == 0) ssq_out[(size_t)row * 16 + u.pn * 4 + wc] = ss; }
            }
    }
};

struct EpiSwiGLU {
    static constexpr bool PERM = true, AFTER_DRAIN = false;
    bf16_t* act; const float* ssq;
    __device__ __forceinline__ void operator()(const f32x4 (&acc)[2][2][4][2], const Unit& u, int wr, int wc, int fr, int fq) const {
        const int col0 = u.pn * HALF + wc * 32 + 8 * fq, lane = fq * 16 + fr;
        float rv[2];
#pragma unroll
        for (int ai = 0; ai < 2; ++ai) rv[ai] = row_rstd(ssq, u.pm * BM + ai * HALF + wr * 64 + lane);
#pragma unroll
        for (int ai = 0; ai < 2; ++ai)
#pragma unroll
            for (int m = 0; m < 4; ++m) {
                const int row = u.pm * BM + ai * HALF + wr * 64 + m * 16 + fr;
                const float rs = __shfl(rv[ai], m * 16 + fr);
                f32x4 o[2];
#pragma unroll
                for (int n = 0; n < 2; ++n) {
                    const f32x4 g = acc[ai][0][m][n] * rs, up = acc[ai][1][m][n] * rs;
#pragma unroll
                    for (int j = 0; j < 4; ++j) { const float e = __builtin_amdgcn_exp2f(g[j] * -1.4426950408889634f); o[n][j] = g[j] * up[j] * __builtin_amdgcn_rcpf(1.0f + e); }
                }
                store16_wt(act + (size_t)row * 2816 + col0, pack8(o[0], o[1]));
            }
    }
};

struct EpiMlstmIn {
    static constexpr bool PERM = true, AFTER_DRAIN = false;
    bf16_t* MQ; bf16_t* MK; bf16_t* MV; bf16_t* OG; const float* ssq;
    __device__ __forceinline__ void operator()(const f32x4 (&acc)[2][2][4][2], const Unit& u, int wr, int wc, int fr, int fq) const {
        bf16_t* base; int ld, colt; float sc = 1.0f; bool sig = false;
        if (u.pn < 2) { base = MQ; ld = 512; colt = u.pn * BM; sc = 0.125f; }
        else if (u.pn < 4) { base = MK; ld = 512; colt = (u.pn - 2) * BM; }
        else if (u.pn < 8) { base = MV; ld = 1024; colt = (u.pn - 4) * BM; }
        else { base = OG; ld = 1024; colt = (u.pn - 8) * BM; sig = true; }
        const int col0 = colt + wc * 32 + 8 * fq, lane = fq * 16 + fr;
        float rv[2];
#pragma unroll
        for (int ai = 0; ai < 2; ++ai) rv[ai] = row_rstd(ssq, u.pm * BM + ai * HALF + wr * 64 + lane) * sc;
#pragma unroll
        for (int ai = 0; ai < 2; ++ai)
#pragma unroll
            for (int m = 0; m < 4; ++m) {
                const int row = u.pm * BM + ai * HALF + wr * 64 + m * 16 + fr;
                const float rs = __shfl(rv[ai], m * 16 + fr);
#pragma unroll
                for (int bj = 0; bj < 2; ++bj) {
                    f32x4 v0 = acc[ai][bj][m][0] * rs, v1 = acc[ai][bj][m][1] * rs;
                    if (sig) {
#pragma unroll
                        for (int j = 0; j < 4; ++j) { v0[j] = __builtin_amdgcn_rcpf(1.0f + __builtin_amdgcn_exp2f(v0[j] * -1.4426950408889634f)); v1[j] = __builtin_amdgcn_rcpf(1.0f + __builtin_amdgcn_exp2f(v1[j] * -1.4426950408889634f)); }
                    }
                    store16_wt(base + (size_t)row * ld + col0 + bj * HALF, pack8(v0, v1));
                }
            }
    }
};
template <class Epi, class Sched, bool ALIGN_EPI = false, bool SP2 = false>
__device__ __forceinline__ void gemm_phase(PG8_LAS unsigned char* lds, const Gemm g, const Sched& S, const Epi& E) {
    int tid_ = threadIdx.x; asm volatile("" : "+v"(tid_));
    const int tid = tid_, wid = __builtin_amdgcn_readfirstlane(tid >> 6), lane = tid & 63, wr = wid >> 2, wc = wid & 3, fr = lane & 15, fq = lane >> 4;
    const int K = g.K, nt = K / BK;
    unsigned voffA[2], voffB[2];
#pragma unroll
    for (int i = 0; i < 2; ++i) { int R, C; stage_rc(tid * 16 + i * 8192, R, C); const int Rb = Epi::PERM ? ((R & ~31) + perm32(R & 31)) : R;
        voffA[i] = (unsigned)(R * K + C) * 2u; voffB[i] = (unsigned)(Rb * K + C) * 2u; }
    const size_t kstep = (size_t)(BK * 2);
    const size_t hstep = (size_t)HALF * K * 2;
    const size_t tstep = 2 * hstep;
    const unsigned ldsw = (unsigned)wid * 1024u;
    const int aoff = lds_byte(wr * 64 + fr, fq * 8), boff = lds_byte(wc * 32 + fr, fq * 8);
#define PG8_SA(b, h) (((b) * 2 + (h)) * HTB)
#define PG8_SB(b, h) ((4 + (b) * 2 + (h)) * HTB)
#define PG8_STAGE(bufoff, gbase, voff) do { _Pragma("unroll") for (int _i = 0; _i < 2; ++_i) \
        __builtin_amdgcn_global_load_lds((const unsigned*)((const char*)(gbase) + (voff)[_i]), (PG8_LAS unsigned*)(lds + (bufoff) + ldsw + _i * 8192), 16, 0, 0); } while (0)
#define PG8_LDA(dst, b, h) do { _Pragma("unroll") for (int m = 0; m < 4; ++m) _Pragma("unroll") for (int k = 0; k < 2; ++k) dst[m][k] = *(const PG8_LAS bf16x8*)(lds + PG8_SA(b, h) + aoff + m * 2048 + k * 1024); } while (0)
#define PG8_LDB(dst, b, h) do { _Pragma("unroll") for (int n = 0; n < 2; ++n) _Pragma("unroll") for (int k = 0; k < 2; ++k) dst[n][k] = *(const PG8_LAS bf16x8*)(lds + PG8_SB(b, h) + boff + n * 2048 + k * 1024); } while (0)
#define PG8_MMA(ai, bj, At, Bt) do { __builtin_amdgcn_s_setprio(1); _Pragma("unroll") for (int m = 0; m < 4; ++m) _Pragma("unroll") for (int n = 0; n < 2; ++n) _Pragma("unroll") for (int k = 0; k < 2; ++k) \
        acc[ai][bj][m][n] = __builtin_amdgcn_mfma_f32_16x16x32_bf16(Bt[n][k], At[m][k], acc[ai][bj][m][n], 0, 0, 0); __builtin_amdgcn_s_setprio(0); } while (0)
#define PG8_WAIT_V(n) asm volatile("s_waitcnt vmcnt(" #n ")" ::: "memory")
#define PG8_WAIT_L(n) asm volatile("s_waitcnt lgkmcnt(" #n ")" ::: "memory")
#define PG8_BAR __builtin_amdgcn_s_barrier()
#define PG8_SCHED __builtin_amdgcn_sched_barrier(0)
    Unit cur, nxt; int ui = 0;
    if (!S.next(0, cur)) return;
    f32x4 acc[2][2][4][2];
#pragma unroll
    for (int a = 0; a < 2; ++a)
#pragma unroll
        for (int b = 0; b < 2; ++b)
#pragma unroll
            for (int m = 0; m < 4; ++m)
#pragma unroll
                for (int n = 0; n < 2; ++n) acc[a][b][m][n] = (f32x4){0.f, 0.f, 0.f, 0.f};
    bf16x8 At[4][2], B0[2][2], B1[2][2];
    const char* cA = (const char*)g.A + (size_t)cur.pm * tstep; const char* cB = (const char*)g.Bt + (size_t)cur.pn * tstep;
    S.a_ready(cur);
    if constexpr (SP2) {
        PG8_STAGE(PG8_SB(0, 0), cB, voffB); PG8_STAGE(PG8_SB(0, 1), cB + hstep, voffB); PG8_STAGE(PG8_SA(0, 0), cA, voffA); PG8_STAGE(PG8_SA(0, 1), cA + hstep, voffA);
        if (wr == 1) PG8_BAR;
        PG8_WAIT_V(2); PG8_BAR;
        PG8_STAGE(PG8_SB(1, 0), cB + kstep, voffB); PG8_STAGE(PG8_SA(1, 0), cA + kstep, voffA); PG8_STAGE(PG8_SB(1, 1), cB + hstep + kstep, voffB);
        PG8_WAIT_V(6); PG8_BAR;
    } else {
        PG8_STAGE(PG8_SB(0, 0), cB, voffB); PG8_STAGE(PG8_SA(0, 0), cA, voffA); PG8_STAGE(PG8_SB(0, 1), cB + hstep, voffB); PG8_STAGE(PG8_SA(0, 1), cA + hstep, voffA);
        if (wr == 1) PG8_BAR;
        PG8_WAIT_V(4); PG8_BAR;
        PG8_STAGE(PG8_SB(1, 0), cB + kstep, voffB); PG8_STAGE(PG8_SA(1, 0), cA + kstep, voffA); PG8_STAGE(PG8_SB(1, 1), cB + hstep + kstep, voffB);
        PG8_WAIT_V(6); PG8_BAR;
    }
    for (;;) {
        const bool has_next = S.next(ui + 1, nxt);
        const char* nA = has_next ? (const char*)g.A + (size_t)nxt.pm * tstep : cA; const char* nB = has_next ? (const char*)g.Bt + (size_t)nxt.pn * tstep : cB;
        for (int t = 0; t < nt; t += 2) {
            const bool last = (t == nt - 2);
            const char* a1 = cA + (size_t)(t + 1) * kstep;
            const char* a2 = last ? nA : cA + (size_t)(t + 2) * kstep; const char* b2 = last ? nB : cB + (size_t)(t + 2) * kstep;
            const char* a3 = a2 + kstep; const char* b3 = b2 + kstep;
            if (last && has_next) S.a_ready(nxt);
            if constexpr (SP2) {
            PG8_LDB(B0, 0, 0); PG8_LDB(B1, 0, 1); PG8_SCHED; PG8_LDA(At, 0, 0); PG8_STAGE(PG8_SA(1, 1), a1 + hstep, voffA);
            PG8_WAIT_V(8); PG8_WAIT_L(0); PG8_BAR; PG8_MMA(0, 0, At, B0); PG8_MMA(0, 1, At, B1); PG8_BAR; PG8_SCHED;
            PG8_LDA(At, 0, 1); PG8_STAGE(PG8_SB(0, 0), b2, voffB); PG8_STAGE(PG8_SB(0, 1), b2 + hstep, voffB); PG8_STAGE(PG8_SA(0, 0), a2, voffA);
            PG8_WAIT_V(8); PG8_WAIT_L(0); PG8_BAR; PG8_MMA(1, 0, At, B0); PG8_MMA(1, 1, At, B1); PG8_BAR; PG8_SCHED;
            PG8_LDB(B0, 1, 0); PG8_LDB(B1, 1, 1); PG8_SCHED; PG8_LDA(At, 1, 0); PG8_STAGE(PG8_SA(0, 1), a2 + hstep, voffA);
            PG8_WAIT_V(8); PG8_WAIT_L(0); PG8_BAR; PG8_MMA(0, 0, At, B0); PG8_MMA(0, 1, At, B1); PG8_BAR; PG8_SCHED;
            PG8_LDA(At, 1, 1); PG8_STAGE(PG8_SB(1, 0), b3, voffB); PG8_STAGE(PG8_SB(1, 1), b3 + hstep, voffB); PG8_STAGE(PG8_SA(1, 0), a3, voffA);
            PG8_WAIT_V(8); PG8_WAIT_L(0); PG8_BAR; PG8_MMA(1, 0, At, B0); PG8_MMA(1, 1, At, B1); PG8_BAR; PG8_SCHED;
            } else {
            PG8_LDB(B0, 0, 0); PG8_SCHED; PG8_LDA(At, 0, 0); PG8_STAGE(PG8_SA(1, 1), a1 + hstep, voffA);
            PG8_WAIT_L(8); PG8_BAR; PG8_WAIT_L(0); PG8_MMA(0, 0, At, B0); PG8_BAR; PG8_SCHED;
            PG8_LDB(B1, 0, 1); PG8_STAGE(PG8_SB(0, 0), b2, voffB);
            PG8_BAR; PG8_WAIT_L(0); PG8_MMA(0, 1, At, B1); PG8_BAR;
            PG8_LDA(At, 0, 1); PG8_STAGE(PG8_SA(0, 0), a2, voffA);
            PG8_BAR; PG8_WAIT_L(0); PG8_MMA(1, 0, At, B0); PG8_BAR; PG8_SCHED;
            PG8_STAGE(PG8_SB(0, 1), b2 + hstep, voffB);
            PG8_WAIT_V(6); PG8_BAR; PG8_MMA(1, 1, At, B1); PG8_BAR;
            PG8_LDB(B0, 1, 0); PG8_SCHED; PG8_LDA(At, 1, 0); PG8_STAGE(PG8_SA(0, 1), a2 + hstep, voffA);
            PG8_WAIT_L(8); PG8_BAR; PG8_WAIT_L(0); PG8_MMA(0, 0, At, B0); PG8_BAR; PG8_SCHED;
            PG8_LDB(B1, 1, 1); PG8_STAGE(PG8_SB(1, 0), b3, voffB);
            PG8_BAR; PG8_WAIT_L(0); PG8_MMA(0, 1, At, B1); PG8_BAR;
            PG8_LDA(At, 1, 1); PG8_STAGE(PG8_SA(1, 0), a3, voffA);
            PG8_BAR; PG8_WAIT_L(0); PG8_MMA(1, 0, At, B0); PG8_BAR; PG8_SCHED;
            PG8_STAGE(PG8_SB(1, 1), b3 + hstep, voffB);
            PG8_WAIT_V(6); PG8_BAR; PG8_MMA(1, 1, At, B1); PG8_BAR;
            }
        }
        if constexpr (ALIGN_EPI) { if (wr == 0) PG8_BAR; }
        if constexpr (!Epi::AFTER_DRAIN) { E(acc, cur, wr, wc, fr, fq); S.done(cur); }
        if (!has_next) break;
#pragma unroll
        for (int a = 0; a < 2; ++a)
#pragma unroll
            for (int b = 0; b < 2; ++b)
#pragma unroll
                for (int m = 0; m < 4; ++m)
#pragma unroll
                    for (int n = 0; n < 2; ++n) acc[a][b][m][n] = (f32x4){0.f, 0.f, 0.f, 0.f};
        cur = nxt; cA = nA; cB = nB; ++ui;
        if constexpr (ALIGN_EPI) { if (wr == 1) PG8_BAR; }
    }
    PG8_WAIT_V(0);
    if constexpr (!ALIGN_EPI) { if (wr == 0) PG8_BAR; }
    PG8_BAR;
    if constexpr (Epi::AFTER_DRAIN) { E.fused(acc, cur, wr, wc, fr, fq, lds, wid, lane); S.done(cur); }
#undef PG8_SA
#undef PG8_SB
#undef PG8_STAGE
#undef PG8_LDA
#undef PG8_LDB
#undef PG8_MMA
#undef PG8_WAIT_V
#undef PG8_WAIT_L
#undef PG8_BAR
#undef PG8_SCHED
}
}

#ifndef PG8_SP2
#define PG8_SP2 true
#endif
#ifndef PG8_ALIGN
#define PG8_ALIGN true
#endif
#define GAS __attribute__((address_space(1)))
#define LAS __attribute__((address_space(3)))
typedef unsigned short bf16;
typedef unsigned v4u __attribute__((ext_vector_type(4)));
typedef float f32x4 __attribute__((ext_vector_type(4)));
typedef short bf16x8 __attribute__((ext_vector_type(8)));
typedef GAS unsigned gu32;
typedef GAS unsigned long long gu64;
#define RLX_AGENT __ATOMIC_RELAXED, __HIP_MEMORY_SCOPE_AGENT
#define LDS_WAIT() asm volatile("s_waitcnt lgkmcnt(0)" ::: "memory")
#define VM_WAIT() asm volatile("s_waitcnt vmcnt(0)" ::: "memory")
__device__ __forceinline__ unsigned long long rt() { return __builtin_amdgcn_s_memrealtime(); }
__device__ __forceinline__ unsigned f2bf(float f) { unsigned u = __builtin_bit_cast(unsigned, f); return (u + 0x7fffu + ((u >> 16) & 1u)) >> 16; }
__device__ __forceinline__ unsigned pk2(float lo, float hi) { return f2bf(lo) | (f2bf(hi) << 16); }

#define XB_TMO      128
#define XB_XCNT(j)  (256  + 64 * (j))
#define XB_XSUB(j)  (1280 + 64 * (j))
#define XB_XGEN(j)  (2304 + 64 * (j))
#define XB_TOP      3328
#define XB_TOPGEN   3392
#define XCD_BAR_WORDS 3456
#define XB_SPIN_CAP (1u << 18)

__device__ __forceinline__ unsigned xb_ld(unsigned* p)              { return __hip_atomic_load(p, __ATOMIC_RELAXED, __HIP_MEMORY_SCOPE_AGENT); }
__device__ __forceinline__ unsigned xb_add(unsigned* p, unsigned v) { return __hip_atomic_fetch_add(p, v, __ATOMIC_RELAXED, __HIP_MEMORY_SCOPE_AGENT); }
__device__ __forceinline__ unsigned xb_xcc_id() { return (unsigned)__builtin_amdgcn_s_getreg((3 << 11) | 20) & 0xFu; }
#define XB_SPIN(cond, bar) do { unsigned _sp = 0; while (cond) { __builtin_amdgcn_s_sleep(1); \
    if ((++_sp & 255u) == 0u) { if (xb_ld(&(bar)[XB_TMO])) break; if (_sp > XB_SPIN_CAP) { atomicAdd(&(bar)[XB_TMO], 1u); break; } } } } while (0)

struct XcdBarrier {
    unsigned* bar; unsigned x;
    volatile LAS unsigned* st;
};

__device__ __forceinline__ XcdBarrier xcd_barrier_post(unsigned* bar, volatile LAS unsigned* st) {
    XcdBarrier b; b.bar = bar; b.x = xb_xcc_id(); b.st = st;
    if (threadIdx.x == 0) (void)xb_add(&bar[XB_XCNT(b.x)], 1u);
    return b;
}
__device__ __forceinline__ void xcd_barrier_complete(unsigned* bar, unsigned x, unsigned& nloc, unsigned& nx) {
    const unsigned G = gridDim.x * gridDim.y * gridDim.z;
    unsigned sum, cnt, mine, sp = 0u;
    for (;;) {
        sum = 0u; cnt = 0u; mine = 0u;
#pragma unroll
        for (unsigned j = 0; j < 16; ++j) { const unsigned c = xb_ld(&bar[XB_XCNT(j)]); sum += c; cnt += (c > 0u) ? 1u : 0u; mine = (j == x) ? c : mine; }
        if (sum == G) break;
        __builtin_amdgcn_s_sleep(1);
        if ((++sp & 255u) == 0u) { if (xb_ld(&bar[XB_TMO])) break; if (sp > XB_SPIN_CAP) { atomicAdd(&bar[XB_TMO], 1u); break; } }
    }
    nloc = mine > 0u ? mine : 1u; nx = cnt > 0u ? cnt : 1u;
}

__device__ __forceinline__ void xcd_barrier(const XcdBarrier& b) {
    asm volatile("s_waitcnt vmcnt(0)" ::: "memory");
    __syncthreads();
    if (threadIdx.x == 0) {
        unsigned* bar = b.bar;
        __builtin_amdgcn_s_waitcnt(0);
        unsigned nloc = b.st[0], nx = b.st[1];
        if (nloc == 0u) { xcd_barrier_complete(bar, b.x, nloc, nx); b.st[0] = nloc; b.st[1] = nx; }
        const unsigned old = xb_add(&bar[XB_XSUB(b.x)], 1u);
        const unsigned gen = old / nloc;
        if (old + 1u == (gen + 1u) * nloc) {
            __builtin_amdgcn_fence(__ATOMIC_RELEASE, "agent");
            asm volatile("s_waitcnt vmcnt(0)" ::: "memory");
            const unsigned og = xb_add(&bar[XB_TOP], 1u);
            const unsigned tg = og / nx;
            if (og + 1u == (tg + 1u) * nx) xb_add(&bar[XB_TOPGEN], 1u);
            else XB_SPIN(xb_ld(&bar[XB_TOPGEN]) == tg, bar);
            __builtin_amdgcn_fence(__ATOMIC_ACQUIRE, "agent");
            xb_add(&bar[XB_XGEN(b.x)], 1u);
            asm volatile("s_waitcnt vmcnt(0)" ::: "memory");
        } else {
            XB_SPIN(xb_ld(&bar[XB_XGEN(b.x)]) == gen, bar);
            __builtin_amdgcn_fence(__ATOMIC_ACQUIRE, "agent");
            asm volatile("s_waitcnt vmcnt(0)" ::: "memory");
        }
    }
    __syncthreads();
}
constexpr int NWAVES = 8;
constexpr int BATCH = 2, SEQ = 8192, D = 1024, M = BATCH * SEQ, NH = 16, HD = 64, MB = 256, NBLK = SEQ / MB;
constexpr int DFF = 2816, NGU = 2 * DFF;
constexpr int MH = 8, DK = 64, DV = 128, LCH = 64, NCH = SEQ / LCH, NUNIT = BATCH * MH * NCH;
constexpr int NIN = 3072, NINW = 3088;
constexpr float RMS_EPS = 1e-6f, SOFTCAP = 15.0f, LOG2E = 1.4426950408889634f;

constexpr size_t MiB = 1u << 20;
constexpr size_t WS_CTL = 0, CTL_ZERO_BYTES = 1 * MiB;
constexpr size_t WS_KMEAN = 512 * 1024;
constexpr size_t WS_SSQ = 1 * MiB;
constexpr size_t WS_BIG = 5 * MiB;
constexpr size_t WS_SEL = 6 * MiB;
constexpr size_t WS_ROPE = 7 * MiB;
constexpr size_t WS_WG = 7 * MiB + 512 * 1024;
constexpr size_t WS_WQKV = 8 * MiB, WS_WO = 14 * MiB, WS_WIN = 16 * MiB, WS_WOUT = 22 * MiB, WS_WGU = 24 * MiB  , WS_WD = 46 * MiB  ;
constexpr size_t WS_NLOC = 57 * MiB;
constexpr size_t WS_SCAL = 57 * MiB + 512 * 1024;
constexpr size_t WS_AB = 64 * MiB;
constexpr size_t WS_Q = 96 * MiB, WS_K = 128 * MiB, WS_V = 160 * MiB;
constexpr size_t WS_HB1 = 96 * MiB;
constexpr size_t WS_ACT = 128 * MiB;
constexpr size_t WS_MQ = 96 * MiB, WS_MK = 112 * MiB, WS_MV = 128 * MiB, WS_OG = 160 * MiB, WS_CLOC = 192 * MiB;
constexpr size_t WS_Y = 224 * MiB;
constexpr size_t WS_END = 256 * MiB;
constexpr int CW_BAR = 4096;

constexpr int RING_OFF = 0, RING_BYTES = 131072;
constexpr int LDSCTL_OFF = RING_BYTES, MISC_OFF = LDSCTL_OFF + 320;
constexpr int LDS_BYTES = 163840;
static_assert(MISC_OFF + 128 <= LDS_BYTES, "LDS map");

__device__ __forceinline__ float bf2f(unsigned short h) { return __builtin_bit_cast(float, (unsigned)h << 16); }
__device__ __forceinline__ float bflo(unsigned w) { return __builtin_bit_cast(float, w << 16); }
__device__ __forceinline__ float bfhi(unsigned w) { return __builtin_bit_cast(float, w & 0xffff0000u); }
__device__ __forceinline__ float wave_sum(float v) {
#pragma unroll
    for (int o = 1; o < 64; o <<= 1) v += __shfl_xor(v, o);
    return v;
}
__device__ __forceinline__ float wave_max(float v) {
#pragma unroll
    for (int o = 1; o < 64; o <<= 1) v = fmaxf(v, __shfl_xor(v, o));
    return v;
}
__device__ __forceinline__ float fexp(float x) { return __builtin_amdgcn_exp2f(x * LOG2E); }

__device__ __forceinline__ int ltid() { int t = threadIdx.x; asm volatile("" : "+v"(t)); return t; }
struct Frame {
    LAS unsigned char* lds;
    volatile LAS unsigned* MISC;
    gu32* ctl;
    int wave, vcu, G;
};

template <int MODE> __device__ __forceinline__ int src_col(int n) {
    if (MODE == 1) {
        if (n >= 2048) return n;
        const int s = n & 63; int d = s;
        if (s < 16) d = (s & 3) | ((s & 4) << 1) | ((s & 8) >> 1);
        return (n & ~63) | d;
    }
    if (MODE == 2) { const int pn = n >> 8, r = n & 255; return (r < 128) ? pn * 128 + r : DFF + pn * 128 + (r - 128); }
    return n;
}
template <int MODE> __device__ __forceinline__ void p0_transpose_item(const float* W, int K, int Nsrc, int Nout, const float* kscale, bf16* WT, int item, int lane) {
    const int nblk = Nout / 64, kb = item / nblk, nb = item - kb * nblk, k0 = 32 * kb, n = 64 * nb + lane;
    const float* wp = W + (size_t)k0 * Nsrc + src_col<MODE>(n);
    float v[32];
#pragma unroll
    for (int i = 0; i < 32; ++i) v[i] = wp[(size_t)i * Nsrc];
    if (kscale) {
#pragma unroll
        for (int i = 0; i < 32; ++i) v[i] *= kscale[k0 + i]; }
    GAS v4u* op = (GAS v4u*)(WT + (size_t)n * K + k0);
#pragma unroll
    for (int c = 0; c < 4; ++c) { v4u o; o.x = pk2(v[8 * c], v[8 * c + 1]); o.y = pk2(v[8 * c + 2], v[8 * c + 3]); o.z = pk2(v[8 * c + 4], v[8 * c + 5]); o.w = pk2(v[8 * c + 6], v[8 * c + 7]); op[c] = o; }
}

struct Ptrs {
    const float *x, *attn_norm, *w_qkv, *w_o, *mlstm_norm, *w_in, *b_gates, *head_norm, *w_out, *ffn_norm, *w_gu, *w_down, *final_norm;
    float* out; unsigned char* ws;
};

__device__ __forceinline__ void p0_prologue(Frame& F, const Ptrs& P) {
    const int tid_l = ltid(), lane_l = tid_l & 63; (void)lane_l;
    unsigned char* ws = P.ws;
    const int gw = F.vcu * NWAVES + F.wave, NGW = F.G * NWAVES;
    constexpr int I_QKV = (D / 32) * (3 * D / 64), I_O = (D / 32) * (D / 64), I_IN = (D / 32) * (NIN / 64), I_GU = (D / 32) * (NGU / 64), I_DN = (DFF / 32) * (D / 64);
    constexpr int NITEMS = I_QKV + I_O + I_IN + I_O + 2 * I_GU + 2 * I_DN;
    for (int it = gw; it < NITEMS; it += NGW) {
        int r = it;
        if (r < I_QKV) { p0_transpose_item<1>(P.w_qkv, D, 3 * D, 3 * D, P.attn_norm, (bf16*)(ws + WS_WQKV), r, lane_l); continue; } r -= I_QKV;
        if (r < I_O) { p0_transpose_item<0>(P.w_o, D, D, D, nullptr, (bf16*)(ws + WS_WO), r, lane_l); continue; } r -= I_O;
        if (r < I_IN) { p0_transpose_item<0>(P.w_in, D, NINW, NIN, P.mlstm_norm, (bf16*)(ws + WS_WIN), r, lane_l); continue; } r -= I_IN;
        if (r < I_O) { p0_transpose_item<0>(P.w_out, D, D, D, nullptr, (bf16*)(ws + WS_WOUT), r, lane_l); continue; } r -= I_O;
        if (r < 2 * I_GU) { const int l = r / I_GU; p0_transpose_item<2>(P.w_gu + (size_t)l * D * NGU, D, NGU, NGU, P.ffn_norm + l * D, (bf16*)(ws + WS_WGU) + (size_t)l * NGU * D, r % I_GU, lane_l); continue; } r -= 2 * I_GU;
        { const int l = r / I_DN; p0_transpose_item<0>(P.w_down + (size_t)l * DFF * D, DFF, D, D, nullptr, (bf16*)(ws + WS_WD) + (size_t)l * D * DFF, r % I_DN, lane_l); }
    }
    const int gt = F.vcu * (NWAVES * 64) + tid_l, NGT = F.G * NWAVES * 64;
    { bf16* WG = (bf16*)(ws + WS_WG); for (int i = gt; i < 16 * D; i += NGT) { const int j = i >> 10, k = i & 1023; WG[i] = (bf16)f2bf(P.mlstm_norm[k] * P.w_in[(size_t)k * NINW + NIN + j]); } }
    { float* rope = (float*)(ws + WS_ROPE);
      for (int i = gt; i < SEQ * 8; i += NGT) { const int pos = i >> 3, j = i & 7;
          const float invf = j == 0 ? 1.0f : j == 1 ? 0.1939227432012558f : j == 2 ? 0.03760603070259094f : j == 3 ? 0.007292664609849453f : j == 4 ? 0.0014142135623842478f : j == 5 ? 0.00027424818836152554f : j == 6 ? 5.3182957344688475e-05f : 1.0313385246263351e-05f;
          const float ang = __fmul_rn((float)pos, invf);
          const double rev = (double)ang * 0.15915494309189533577; const float fr = (float)(rev - __builtin_rint(rev));
          rope[2 * i] = __builtin_amdgcn_cosf(fr); rope[2 * i + 1] = __builtin_amdgcn_sinf(fr); } }
    { bf16* xb = (bf16*)(ws + WS_AB); float* ssq0 = (float*)(ws + WS_SSQ);
      for (int m = gw; m < M; m += NGW) {
          const GAS f32x4* xr = (const GAS f32x4*)(P.x + (size_t)m * D) + lane_l; f32x4 v[4]; float s = 0.f;
#pragma unroll
          for (int j = 0; j < 4; ++j) { v[j] = xr[64 * j]; s += (v[j].x * v[j].x + v[j].y * v[j].y) + (v[j].z * v[j].z + v[j].w * v[j].w); }
          s = wave_sum(s);
          GAS unsigned long long* o8 = (GAS unsigned long long*)(xb + (size_t)m * D) + lane_l;
#pragma unroll
          for (int j = 0; j < 4; ++j) o8[64 * j] = (unsigned long long)pk2(v[j].x, v[j].y) | ((unsigned long long)pk2(v[j].z, v[j].w) << 32);
          if (lane_l < 16) ssq0[(size_t)m * 16 + lane_l] = (lane_l == 0) ? s : 0.f;
      } }
}

namespace moba {
typedef short bf16x8 __attribute__((ext_vector_type(8)));
typedef short s16x4 __attribute__((ext_vector_type(4)));
typedef float f32x16 __attribute__((ext_vector_type(16)));
typedef unsigned u32x4 __attribute__((ext_vector_type(4)));
typedef LAS const char* lds_cptr;
typedef short v4i16_t __attribute__((ext_vector_type(4)));
typedef float f32x2_t __attribute__((ext_vector_type(2))); typedef __bf16 bf16x2_t __attribute__((ext_vector_type(2)));
constexpr int THRL = 8;
constexpr int L_K = 0, L_V = 32768, L_WS = 65536  , L_STG = 73728  , L_QL = 106496  , L_MISC = 122880;
constexpr size_t WS_SEGCNT = 58 * MiB;
constexpr size_t WS_P2 = 192 * MiB;
constexpr size_t WS_PLSE = 224 * MiB;
constexpr size_t WS_SEGLIST = 232 * MiB;
constexpr int CW_TOT = 12288;
constexpr int LCAP = 8192;
constexpr int CW_Q3 = 8192;
constexpr size_t PART_STRIDE = (size_t)M * D * 2;

__device__ __forceinline__ int crow(int r, int hi) { return (r & 3) + 8 * (r >> 2) + 4 * hi; }
__device__ __forceinline__ void glds16(const void* gsrc, unsigned lds_dst) { unsigned keep;
    asm volatile("s_mov_b32 %0, m0\n\ts_mov_b32 m0, %2\n\ts_nop 0\n\tglobal_load_lds_dwordx4 %1, off\n\ts_mov_b32 m0, %0" : "=&s"(keep) : "v"(gsrc), "s"(lds_dst) : "memory"); }
__device__ __forceinline__ unsigned cvtpk_s(float lo, float hi) { f32x2_t v = {lo, hi}; bf16x2_t b = __builtin_convertvector(v, bf16x2_t); return __builtin_bit_cast(unsigned, b); }
__device__ __forceinline__ s16x4 vtr(lds_cptr p) { return __builtin_bit_cast(s16x4, __builtin_amdgcn_ds_read_tr16_b64_v4i16((LAS v4i16_t*)p)); }
#define MOBA_MX3(a, b, c) __builtin_fmaxf(__builtin_fmaxf((a), (b)), (c))
__device__ __forceinline__ float rowmax(const f32x16& p0, const f32x16& p1) {
    float a = MOBA_MX3(p0[0], p0[1], p1[0]), b = MOBA_MX3(p0[2], p0[3], p1[1]); a = MOBA_MX3(a, p1[2], p1[3]);
#pragma unroll
    for (int r = 4; r < 16; r += 4) { a = MOBA_MX3(a, p0[r], p0[r + 1]); b = MOBA_MX3(b, p0[r + 2], p0[r + 3]); a = MOBA_MX3(a, p1[r], p1[r + 1]); b = MOBA_MX3(b, p1[r + 2], p1[r + 3]); }
    float m = __builtin_fmaxf(a, b); auto rr = __builtin_amdgcn_permlane32_swap(__float_as_uint(m), __float_as_uint(m), false, false);
    return __builtin_fmaxf(__uint_as_float(rr[0]), __uint_as_float(rr[1])); }
__device__ __forceinline__ float halves_sum(float v) { auto rr = __builtin_amdgcn_permlane32_swap(__float_as_uint(v), __float_as_uint(v), false, false); return __uint_as_float(rr[0]) + __uint_as_float(rr[1]); }
#define MOBA_MFMA(a, b, c) __builtin_amdgcn_mfma_f32_32x32x16_bf16(a, b, c, 0, 0, 0)

__device__ __forceinline__ void stage_kv(const bf16* K, const bf16* V, int b, int h, int j, LAS unsigned char* lds, int wid, int lane) {
    const size_t row0 = (size_t)b * SEQ + (size_t)j * MB;
    const bf16* ksrc = K + (row0 + lane) * D + h * HD + wid * 8;
    const bf16* vsrc = V + (row0 + 16 * (wid & 3) + (lane >> 2)) * D + h * HD + (wid >> 2) * 32 + (lane & 3) * 8;
    const unsigned kdst = (unsigned)(uintptr_t)(lds + L_K) + wid * 1024, vdst = (unsigned)(uintptr_t)(lds + L_V) + wid * 1024;
#pragma unroll
    for (int t = 0; t < 4; ++t) { glds16(ksrc + (size_t)t * 64 * D, (unsigned)__builtin_amdgcn_readfirstlane(kdst + t * 8192)); glds16(vsrc + (size_t)t * 64 * D, (unsigned)__builtin_amdgcn_readfirstlane(vdst + t * 8192)); }
}
__device__ __forceinline__ void stage_wait() { asm volatile("s_waitcnt vmcnt(0) lgkmcnt(0)\n\ts_barrier" ::: "memory"); }

template <bool CAUSAL> __device__ __forceinline__ void wave_block(const bf16x8 (&qr)[4], lds_cptr kbase, lds_cptr vbase, int ntiles, int qrel, LAS float* wsf, int lane, f32x16& o0, f32x16& o1, float& mhat, float& lsum) {
    const int r32 = lane & 31, hi = lane >> 5;
    const lds_cptr kp0 = kbase + hi * 1024 + r32 * 16;
    const lds_cptr vp0 = vbase + ((lane >> 4) & 1) * 32 + (lane & 3) * 8 + (4 * hi + ((lane & 15) >> 2)) * 64;
    o0 = f32x16{}; o1 = f32x16{}; mhat = 0.f; lsum = 0.f;
    bf16x8 kf[8];
#define MOBA_KLOAD(kt_) do { const lds_cptr kp_ = kp0 + (kt_) * 8192; _Pragma("unroll") for (int d0 = 0; d0 < 4; ++d0) { kf[2 * d0] = *(const LAS bf16x8*)(kp_ + d0 * 2048); kf[2 * d0 + 1] = *(const LAS bf16x8*)(kp_ + d0 * 2048 + 512); } } while (0)
    MOBA_KLOAD(0);
#pragma unroll
    for (int kt = 0; kt < 4; ++kt) {
        if (kt < ntiles) {
            const lds_cptr vp = vp0 + kt * 8192;
            s16x4 vlo[8], vhi[8];
#pragma unroll
            for (int i = 0; i < 8; ++i) { vlo[i] = vtr(vp + ((i >> 2) * 4096 + (i & 3) * 1024)); vhi[i] = vtr(vp + ((i >> 2) * 4096 + (i & 3) * 1024 + 512)); }
            f32x16 negm;
#pragma unroll
            for (int r = 0; r < 16; ++r) negm[r] = 0.f - mhat;
            f32x16 c0 = MOBA_MFMA(kf[0], qr[0], negm), c1 = MOBA_MFMA(kf[1], qr[0], negm);
            c0 = MOBA_MFMA(kf[2], qr[1], c0); c1 = MOBA_MFMA(kf[3], qr[1], c1);
            c0 = MOBA_MFMA(kf[4], qr[2], c0); c1 = MOBA_MFMA(kf[5], qr[2], c1);
            c0 = MOBA_MFMA(kf[6], qr[3], c0); c1 = MOBA_MFMA(kf[7], qr[3], c1);
            __builtin_amdgcn_sched_barrier(0);
            if (kt + 1 < 4 && kt + 1 < ntiles) MOBA_KLOAD(kt + 1);
            if (CAUSAL && kt == ntiles - 1) { int rel = qrel - 64 * kt - 4 * hi; asm volatile("" : "+v"(rel));
#pragma unroll
                for (int r = 0; r < 16; ++r) { const int kv = (r & 3) + 8 * (r >> 2);
                    c0[r] = __builtin_fminf(c0[r], __builtin_bit_cast(float, 0x7F800000u | ((unsigned)((rel - kv) >> 31) & 0x80000000u)));
                    c1[r] = __builtin_fminf(c1[r], __builtin_bit_cast(float, 0x7F800000u | ((unsigned)((rel - kv - 32) >> 31) & 0x80000000u))); } }
            const float rm = rowmax(c0, c1);
            bool resc = false; float dl = 0.f;
            if (kt == 0) { dl = rm; mhat = rm; }
            else if (__any(rm > (float)THRL)) { dl = __builtin_fmaxf(rm, 0.f); mhat += dl; const float f = __builtin_amdgcn_exp2f(-dl); lsum *= f; if (hi == 0) wsf[r32] = f; resc = true; }
            float sacc = 0.f;
#pragma unroll
            for (int r = 0; r < 16; ++r) { c0[r] = __builtin_amdgcn_exp2f(c0[r] - dl); c1[r] = __builtin_amdgcn_exp2f(c1[r] - dl); sacc += c0[r] + c1[r]; }
            lsum += sacc;
            if (resc) { asm volatile("s_waitcnt lgkmcnt(0)" ::: "memory");
#pragma unroll
                for (int r = 0; r < 16; ++r) { const float f = wsf[crow(r, hi)]; o0[r] *= f; o1[r] *= f; } }
            u32x4 pw0, pw1, pw2, pw3;
            pw0 = (u32x4){cvtpk_s(c0[0], c0[1]), cvtpk_s(c0[2], c0[3]), cvtpk_s(c0[4], c0[5]), cvtpk_s(c0[6], c0[7])}; pw1 = (u32x4){cvtpk_s(c0[8], c0[9]), cvtpk_s(c0[10], c0[11]), cvtpk_s(c0[12], c0[13]), cvtpk_s(c0[14], c0[15])};
            pw2 = (u32x4){cvtpk_s(c1[0], c1[1]), cvtpk_s(c1[2], c1[3]), cvtpk_s(c1[4], c1[5]), cvtpk_s(c1[6], c1[7])}; pw3 = (u32x4){cvtpk_s(c1[8], c1[9]), cvtpk_s(c1[10], c1[11]), cvtpk_s(c1[12], c1[13]), cvtpk_s(c1[14], c1[15])};
            __builtin_amdgcn_sched_barrier(0);
#define MOBA_PAF(k) __builtin_bit_cast(bf16x8, pw##k)
#define MOBA_VFR(i) (bf16x8){vlo[i][0], vlo[i][1], vlo[i][2], vlo[i][3], vhi[i][0], vhi[i][1], vhi[i][2], vhi[i][3]}
            o0 = MOBA_MFMA(MOBA_PAF(0), MOBA_VFR(0), o0); o1 = MOBA_MFMA(MOBA_PAF(0), MOBA_VFR(4), o1); o0 = MOBA_MFMA(MOBA_PAF(1), MOBA_VFR(1), o0); o1 = MOBA_MFMA(MOBA_PAF(1), MOBA_VFR(5), o1);
            o0 = MOBA_MFMA(MOBA_PAF(2), MOBA_VFR(2), o0); o1 = MOBA_MFMA(MOBA_PAF(2), MOBA_VFR(6), o1); o0 = MOBA_MFMA(MOBA_PAF(3), MOBA_VFR(3), o0); o1 = MOBA_MFMA(MOBA_PAF(3), MOBA_VFR(7), o1);
#undef MOBA_PAF
#undef MOBA_VFR
            __builtin_amdgcn_sched_barrier(0);
        }
    }
#undef MOBA_KLOAD
    lsum = halves_sum(lsum);
}
__device__ __forceinline__ void stage_o(const f32x16& o0, const f32x16& o1, float lsum, LAS float* wsf, LAS unsigned short* stg, int lane) {
    const int r32 = lane & 31, hi = lane >> 5;
    if (hi == 0) wsf[32 + r32] = __builtin_amdgcn_rcpf(lsum);
    asm volatile("s_waitcnt lgkmcnt(0)" ::: "memory");
#pragma unroll
    for (int r = 0; r < 16; ++r) { const int orow = crow(r, hi); const float rl = wsf[32 + orow];
        stg[orow * 64 + r32] = (unsigned short)f2bf(o0[r] * rl); stg[orow * 64 + 32 + r32] = (unsigned short)f2bf(o1[r] * rl); }
    asm volatile("s_waitcnt lgkmcnt(0)" ::: "memory");
}

__device__ __forceinline__ bool better(float g, int n, float gk, int ik) { return g > gk || (g == gk && n < ik); }
__device__ __forceinline__ void ins3(float g, int n, float& g1, int& i1, float& g2, int& i2, float& g3, int& i3) {
    const bool b1 = better(g, n, g1, i1), b2 = better(g, n, g2, i2), b3 = better(g, n, g3, i3);
    const float n3 = b2 ? g2 : (b3 ? g : g3); const int m3 = b2 ? i2 : (b3 ? n : i3);
    const float n2 = b1 ? g1 : (b2 ? g : g2); const int m2 = b1 ? i1 : (b2 ? n : i2);
    g1 = b1 ? g : g1; i1 = b1 ? n : i1; g2 = n2; i2 = m2; g3 = n3; i3 = m3;
}
}

__device__ __forceinline__ void p2_gating(Frame& F, const Ptrs& P) {
    using namespace moba;
    const int tid_l = ltid(), lane_l = tid_l & 63; (void)lane_l;
    const bf16* Q = (const bf16*)(P.ws + WS_Q); const float* kmean = (const float*)(P.ws + WS_KMEAN);
    unsigned short* seglist = (unsigned short*)(P.ws + WS_SEGLIST);
    LAS unsigned char* himg = F.lds + RING_OFF; LAS unsigned char* limg = himg + 4096; LAS unsigned* cntL = (LAS unsigned*)(limg + 4096);
    const int tid = tid_l, lane = lane_l, r32 = lane & 31, hi = lane >> 5, wid = F.wave;
    for (int unit = F.vcu; unit < BATCH * NH * NBLK; unit += F.G) {
        const int bh = unit >> 5, cur = unit & 31, b = bh >> 4, h = bh & 15;
        if (cur == 0) continue;
        { const int n = tid >> 4, c4 = (tid & 15) * 4; f32x4 x = (f32x4){0.f, 0.f, 0.f, 0.f};
          if (n < cur) x = *(const f32x4*)(kmean + (size_t)(b * NBLK + n) * D + h * HD + c4);
          const unsigned h01 = cvtpk_s(x.x, x.y), h23 = cvtpk_s(x.z, x.w);
          const unsigned l01 = cvtpk_s(x.x - bflo(h01), x.y - bfhi(h01)), l23 = cvtpk_s(x.z - bflo(h23), x.w - bfhi(h23));
          const int off = (c4 >> 3) * 512 + n * 16 + (c4 & 7) * 2;
          typedef unsigned u32x2v __attribute__((ext_vector_type(2)));
          *(LAS u32x2v*)(himg + off) = (u32x2v){h01, h23}; *(LAS u32x2v*)(limg + off) = (u32x2v){l01, l23};
          if (tid < 32) cntL[tid] = 0u; }
        LDS_WAIT(); __syncthreads();
        const int tl = cur * MB + wid * 32 + r32;
        float g1 = -INFINITY, g2 = -INFINITY, g3 = -INFINITY; int i1 = 255, i2 = 255, i3 = 255;
        {
            const bf16* qp = Q + (size_t)(b * SEQ + tl) * D + h * HD + hi * 8;
            f32x16 g = f32x16{};
#pragma unroll
            for (int d0 = 0; d0 < 4; ++d0) { const bf16x8 qr = *(const bf16x8*)(qp + d0 * 16);
                const bf16x8 ah = *(const LAS bf16x8*)(himg + (2 * d0 + hi) * 512 + r32 * 16), al = *(const LAS bf16x8*)(limg + (2 * d0 + hi) * 512 + r32 * 16);
                g = MOBA_MFMA(ah, qr, g); g = MOBA_MFMA(al, qr, g); }
            int nb = 4 * hi; asm volatile("" : "+v"(nb));
#pragma unroll
            for (int r = 0; r < 16; ++r) { const int n = nb + (r & 3) + 8 * (r >> 2); const float gv = (n < cur) ? g[r] : -INFINITY; ins3(gv, (n < cur) ? n : 255, g1, i1, g2, i2, g3, i3); }
        }
        {
            const float og1 = __uint_as_float(__builtin_amdgcn_permlane32_swap(__float_as_uint(g1), __float_as_uint(g1), false, false)[hi ? 0 : 1]);
            const float og2 = __uint_as_float(__builtin_amdgcn_permlane32_swap(__float_as_uint(g2), __float_as_uint(g2), false, false)[hi ? 0 : 1]);
            const float og3 = __uint_as_float(__builtin_amdgcn_permlane32_swap(__float_as_uint(g3), __float_as_uint(g3), false, false)[hi ? 0 : 1]);
            const int oi1 = (int)__builtin_amdgcn_permlane32_swap((unsigned)i1, (unsigned)i1, false, false)[hi ? 0 : 1];
            const int oi2 = (int)__builtin_amdgcn_permlane32_swap((unsigned)i2, (unsigned)i2, false, false)[hi ? 0 : 1];
            const int oi3 = (int)__builtin_amdgcn_permlane32_swap((unsigned)i3, (unsigned)i3, false, false)[hi ? 0 : 1];
            if (oi1 != 255) ins3(og1, oi1, g1, i1, g2, i2, g3, i3);
            if (oi2 != 255) ins3(og2, oi2, g1, i1, g2, i2, g3, i3);
            if (oi3 != 255) ins3(og3, oi3, g1, i1, g2, i2, g3, i3);
        }
        unsigned ps1 = 0, ps2 = 0, ps3 = 0;
        if (hi == 0) {
            if (i1 != 255) ps1 = __hip_atomic_fetch_add(cntL + i1, 1u, __ATOMIC_RELAXED, __HIP_MEMORY_SCOPE_WORKGROUP);
            if (i2 != 255) ps2 = __hip_atomic_fetch_add(cntL + i2, 1u, __ATOMIC_RELAXED, __HIP_MEMORY_SCOPE_WORKGROUP);
            if (i3 != 255) ps3 = __hip_atomic_fetch_add(cntL + i3, 1u, __ATOMIC_RELAXED, __HIP_MEMORY_SCOPE_WORKGROUP);
        }
        LDS_WAIT(); __syncthreads();
        if (tid < cur) { const unsigned cn = cntL[tid]; cntL[32 + tid] = cn ? __hip_atomic_fetch_add(F.ctl + CW_TOT + bh * 32 + tid, cn, RLX_AGENT) : 0u; }
        LDS_WAIT(); __syncthreads();
        if (hi == 0) {
            if (i1 != 255) seglist[(size_t)(bh * 32 + i1) * LCAP + cntL[32 + i1] + ps1] = (unsigned short)tl;
            if (i2 != 255) seglist[(size_t)(bh * 32 + i2) * LCAP + cntL[32 + i2] + ps2] = (unsigned short)(tl | (1 << 13));
            if (i3 != 255) seglist[(size_t)(bh * 32 + i3) * LCAP + cntL[32 + i3] + ps3] = (unsigned short)(tl | (2 << 13));
        }
        LDS_WAIT(); __syncthreads();
    }
}

__device__ __forceinline__ void p3_gathered(Frame& F, const Ptrs& P, int pass = 0) {
    const int tid_l = ltid(), lane_l = tid_l & 63; (void)lane_l;
    using namespace moba;
    unsigned char* ws = P.ws;
    const bf16* Q = (const bf16*)(ws + WS_Q); const bf16* K = (const bf16*)(ws + WS_K); const bf16* V = (const bf16*)(ws + WS_V);
    const unsigned short* seglist = (const unsigned short*)(ws + WS_SEGLIST);
    float* plse = (float*)(ws + WS_PLSE);
    LAS unsigned short* ql = (LAS unsigned short*)(F.lds + L_QL); LAS unsigned* misc = (LAS unsigned*)(F.lds + L_MISC);
    LAS float* wsf = (LAS float*)(F.lds + L_WS) + F.wave * 256; LAS unsigned short* stg = (LAS unsigned short*)(F.lds + L_STG) + F.wave * 2048;
    const int tid = tid_l, lane = lane_l, wid = F.wave, r32 = lane & 31, hi = lane >> 5;
    if (tid == 0) misc[0] = __hip_atomic_fetch_add(F.ctl + CW_Q3 + 64 * pass, 1u, RLX_AGENT);
    LDS_WAIT(); __syncthreads();
    for (;;) {
        const int item = (int)misc[0];
        if (item >= 31 * 32) break;
        const int j = item >> 5, bh = item & 31, b = bh >> 4, h = bh & 15;
        stage_kv(K, V, b, h, j, F.lds, wid, lane);
        const int n = (int)__hip_atomic_load(F.ctl + CW_TOT + bh * 32 + j, RLX_AGENT);
        unsigned nxt = 0; if (tid == 0) nxt = __hip_atomic_fetch_add(F.ctl + CW_Q3 + 64 * pass, 1u, RLX_AGENT);
        const unsigned short* sp = seglist + (size_t)(bh * 32 + j) * LCAP;
        const int ngroups = (n + 31) >> 5;
        bf16x8 qn[4];
        if (wid < ngroups) { const int idx = wid * 32 + r32; const unsigned e = sp[idx < n ? idx : n - 1]; const bf16* qp = Q + (size_t)(b * SEQ + (int)(e & 8191u)) * D + h * HD + hi * 8;
#pragma unroll
            for (int d0 = 0; d0 < 4; ++d0) qn[d0] = *(const bf16x8*)(qp + d0 * 16); }
        for (int i = tid; i < n; i += NWAVES * 64) ql[i] = sp[i];
        stage_wait();
        for (int g = wid; g < ngroups; g += NWAVES) {
            const int idx = g * 32 + r32; const unsigned e = ql[idx < n ? idx : n - 1]; const int tl = (int)(e & 8191u);
            bf16x8 qr[4];
#pragma unroll
            for (int d0 = 0; d0 < 4; ++d0) qr[d0] = qn[d0];
            if (g + NWAVES < ngroups) { const int ix = (g + NWAVES) * 32 + r32; const unsigned en = ql[ix < n ? ix : n - 1]; const bf16* qp = Q + (size_t)(b * SEQ + (int)(en & 8191u)) * D + h * HD + hi * 8;
#pragma unroll
                for (int d0 = 0; d0 < 4; ++d0) qn[d0] = *(const bf16x8*)(qp + d0 * 16); }
            f32x16 o0, o1; float mhat, lsum;
            wave_block<false>(qr, (lds_cptr)(F.lds + L_K), (lds_cptr)(F.lds + L_V), 4, 0, wsf, lane, o0, o1, mhat, lsum);
#if defined(PROBE3_EPI2)
            _Pragma("unroll 1") for (int rep3_ = 0; rep3_ < 2; ++rep3_) {
#else
            {
#endif
            stage_o(o0, o1, lsum, wsf, stg, lane);
            if (hi == 0 && idx < n) plse[((size_t)(e >> 13) * M + (size_t)(b * SEQ + tl)) * 16 + h] = mhat + __builtin_amdgcn_logf(lsum);
#pragma unroll
            for (int i = 0; i < 4; ++i) { const int row = i * 8 + (lane >> 3), ch = lane & 7, ix = g * 32 + row;
                if (ix < n) { const unsigned e2 = ql[ix]; const unsigned rk = e2 >> 13; const size_t t2 = (size_t)(b * SEQ) + (e2 & 8191u);
                    unsigned char* pb = (rk == 2u) ? (ws + WS_P2) : ((unsigned char*)P.out + (size_t)rk * PART_STRIDE);
                    *(u32x4*)(pb + (t2 * D + h * HD + ch * 8) * 2) = *(const LAS u32x4*)(stg + row * 64 + ch * 8); } }
            LDS_WAIT();
            }
        }
        LDS_WAIT(); __syncthreads();
        if (tid == 0) misc[0] = nxt;
        LDS_WAIT(); __syncthreads();
    }
}

__device__ __forceinline__ void p4_own_combine(Frame& F, const Ptrs& P) {
    const int tid_l = ltid(), lane_l = tid_l & 63; (void)lane_l;
    using namespace moba;
    unsigned char* ws = P.ws; asm volatile("" : "+v"(ws));
    unsigned char* outp = (unsigned char*)P.out; asm volatile("" : "+v"(outp));
    const bf16* Q = (const bf16*)(ws + WS_Q); const bf16* K = (const bf16*)(ws + WS_K); const bf16* V = (const bf16*)(ws + WS_V); bf16* O = (bf16*)(ws + WS_AB);
    const float* plse = (const float*)(ws + WS_PLSE);
    const int lane = lane_l, wid = F.wave, r32 = lane & 31, hi = lane >> 5, widv = tid_l >> 6;
    LAS float* wsf = (LAS float*)(F.lds + L_WS) + widv * 256; LAS unsigned short* stg = (LAS unsigned short*)(F.lds + L_STG) + widv * 2048;
    for (int unit = F.vcu; unit < BATCH * NH * NBLK; unit += F.G) {
        const int bh = unit >> 5, cur = unit & 31, b = bh >> 4, h = bh & 15;
        stage_kv(K, V, b, h, cur, F.lds, wid, lane);
        const size_t t0 = (size_t)b * SEQ + (size_t)cur * MB + widv * 32;
        const bf16* qp = Q + (t0 + r32) * D + h * HD + hi * 8;
        bf16x8 qr[4];
#pragma unroll
        for (int d0 = 0; d0 < 4; ++d0) qr[d0] = *(const bf16x8*)(qp + d0 * 16);
        const int nv = cur < 3 ? cur : 3;
        float lr[3];
#pragma unroll
        for (int r = 0; r < 3; ++r) lr[r] = (r < nv) ? plse[((size_t)r * M + t0 + r32) * 16 + h] : -INFINITY;
        stage_wait();
#if defined(PROBE4_STAGE2)
        stage_kv(K, V, b, h, cur, F.lds, wid, lane); stage_wait();
#endif
        f32x16 o0, o1; float mhat, lsum;
        wave_block<true>(qr, (lds_cptr)(F.lds + L_K), (lds_cptr)(F.lds + L_V), (wid >> 1) + 1, widv * 32 + r32, wsf, lane, o0, o1, mhat, lsum);
#if defined(PROBE4_COMP2)
        asm volatile("" : "+v"(o0), "+v"(o1), "+v"(mhat), "+v"(lsum)); wave_block<true>(qr, (lds_cptr)(F.lds + L_K), (lds_cptr)(F.lds + L_V), (wid >> 1) + 1, widv * 32 + r32, wsf, lane, o0, o1, mhat, lsum);
#endif
        stage_o(o0, o1, lsum, wsf, stg, lane);
        { const float l0 = mhat + __builtin_amdgcn_logf(lsum); float mx = l0;
#pragma unroll
          for (int r = 0; r < 3; ++r) mx = __builtin_fmaxf(mx, lr[r]);
          const float w0 = __builtin_amdgcn_exp2f(l0 - mx); float wr[3]; float ws_ = w0;
#pragma unroll
          for (int r = 0; r < 3; ++r) { wr[r] = __builtin_amdgcn_exp2f(lr[r] - mx); ws_ += wr[r]; }
          const float inv = 1.0f / ws_;
          if (hi == 0) { wsf[64 + r32 * 4] = w0 * inv; wsf[64 + r32 * 4 + 1] = wr[0] * inv; wsf[64 + r32 * 4 + 2] = wr[1] * inv; wsf[64 + r32 * 4 + 3] = wr[2] * inv; } }
        LDS_WAIT();
#if defined(PROBE4_COMB2)
        _Pragma("unroll 1") for (int rep2_ = 0; rep2_ < 2; ++rep2_) {
#else
        {
#endif
        u32x4 pwv[4][3];
#pragma unroll
        for (int i = 0; i < 4; ++i) { const size_t off = (t0 + i * 8 + (lane >> 3)) * D + h * HD + (lane & 7) * 8;
#pragma unroll
            for (int r = 0; r < 3; ++r) { const int rr = (r < nv) ? r : 0; const unsigned char* pb = (rr == 2) ? (ws + WS_P2) : (outp + (size_t)rr * PART_STRIDE); pwv[i][r] = *(const u32x4*)(pb + off * 2); } }
#pragma unroll
        for (int i = 0; i < 4; ++i) { const int row = i * 8 + (lane >> 3), ch = lane & 7; const size_t off = (t0 + row) * D + h * HD + ch * 8;
            const u32x4 ow = *(const LAS u32x4*)(stg + row * 64 + ch * 8); const float w0 = wsf[64 + row * 4];
            float a[8] = {w0 * bflo(ow.x), w0 * bfhi(ow.x), w0 * bflo(ow.y), w0 * bfhi(ow.y), w0 * bflo(ow.z), w0 * bfhi(ow.z), w0 * bflo(ow.w), w0 * bfhi(ow.w)};
#pragma unroll
            for (int r = 0; r < 3; ++r) { const u32x4 pw = pwv[i][r]; const float w = (r < nv) ? wsf[64 + row * 4 + 1 + r] : 0.f; const bool ok = r < nv;
                a[0] += ok ? w * bflo(pw.x) : 0.f; a[1] += ok ? w * bfhi(pw.x) : 0.f; a[2] += ok ? w * bflo(pw.y) : 0.f; a[3] += ok ? w * bfhi(pw.y) : 0.f;
                a[4] += ok ? w * bflo(pw.z) : 0.f; a[5] += ok ? w * bfhi(pw.z) : 0.f; a[6] += ok ? w * bflo(pw.w) : 0.f; a[7] += ok ? w * bfhi(pw.w) : 0.f; }
            v4u w; w.x = pk2(a[0], a[1]); w.y = pk2(a[2], a[3]); w.z = pk2(a[4], a[5]); w.w = pk2(a[6], a[7]); *(v4u*)(O + off) = w; }
        }
        LDS_WAIT(); __syncthreads();
    }
}

namespace mls {
using namespace moba;
typedef float f32x4v __attribute__((ext_vector_type(4)));
constexpr int XTRA_OFF = LDSCTL_OFF + 512;
__device__ __forceinline__ float softcap_f(float g) { const float x = g * (1.0f / SOFTCAP); const float e = fexp(2.0f * x); return SOFTCAP * (e - 1.0f) / (e + 1.0f); }
__device__ __forceinline__ float logsigmoid_f(float f) { return fminf(f, 0.f) - __builtin_amdgcn_logf(1.0f + fexp(-fabsf(f))) * 0.6931471805599453f; }
__device__ __forceinline__ float scan_add(float v, int lane) {
#pragma unroll
    for (int o = 1; o < 64; o <<= 1) { const float t = __shfl_up(v, o); if (lane >= o) v += t; }
    return v; }
__device__ __forceinline__ float scan_max(float v, int lane) {
#pragma unroll
    for (int o = 1; o < 64; o <<= 1) { const float t = __shfl_up(v, o); if (lane >= o) v = fmaxf(v, t); }
    return v; }
__device__ __forceinline__ bf16x8 trfrag(lds_cptr p, int ks) { const s16x4 lo = vtr(p + ks * 1024), hi = vtr(p + ks * 1024 + 512); return (bf16x8){lo[0], lo[1], lo[2], lo[3], hi[0], hi[1], hi[2], hi[3]}; }
__device__ __forceinline__ v4u scale8(const v4u w, float s) { v4u o; o.x = cvtpk_s(bflo(w.x) * s, bfhi(w.x) * s); o.y = cvtpk_s(bflo(w.y) * s, bfhi(w.y) * s); o.z = cvtpk_s(bflo(w.z) * s, bfhi(w.z) * s); o.w = cvtpk_s(bflo(w.w) * s, bfhi(w.w) * s); return o; }
}

__device__ __forceinline__ void pa_mlstm_local(Frame& F, const Ptrs& P) {
    const int tid_l = ltid(), lane_l = tid_l & 63; (void)lane_l;
    using namespace mls;
    unsigned char* ws = P.ws;
    const bf16* HB = (const bf16*)(ws + WS_AB); const bf16* MK = (const bf16*)(ws + WS_MK); const bf16* MV = (const bf16*)(ws + WS_MV);
    const bf16* WGb = (const bf16*)(ws + WS_WG); const float* ssq = (const float*)(ws + WS_SSQ) + (size_t)2 * M * 16;
    bf16* cloc = (bf16*)(ws + WS_CLOC); float* nloc = (float*)(ws + WS_NLOC); float* scal = (float*)(ws + WS_SCAL); float* BIG = (float*)(ws + WS_BIG);
    const int tid = tid_l, lane = tid & 63, wid = F.wave, r32 = lane & 31, hi = lane >> 5, fr = lane & 15, fq = lane >> 4;
    LAS float* gpart = (LAS float*)(F.lds + RING_OFF);
    LAS float* igA = (LAS float*)(F.lds + XTRA_OFF); LAS float* lfA = igA + 8 * 64;
    LAS unsigned char* kimg = F.lds + RING_OFF + wid * 16384; LAS unsigned char* vimg = kimg + 8192;
    const lds_cptr ktr = (lds_cptr)kimg + ((lane >> 4) & 1) * 32 + (lane & 3) * 8 + (4 * hi + ((lane & 15) >> 2)) * 64;
    const lds_cptr vtrp = ktr + 8192;
    for (int unit = F.vcu; unit < BATCH * NCH; unit += F.G) {
        const int b = unit >> 7, c = unit & 127; const size_t t0 = (size_t)b * SEQ + (size_t)c * LCH;
        {
            pg8::f32x4 acc[4];
#pragma unroll
            for (int m = 0; m < 4; ++m) acc[m] = (pg8::f32x4){0.f, 0.f, 0.f, 0.f};
#pragma unroll
            for (int ks = 0; ks < 4; ++ks) { const int k0 = wid * 128 + ks * 32 + fq * 8;
                const bf16x8 bw = *(const bf16x8*)(WGb + (size_t)fr * D + k0);
#pragma unroll
                for (int m = 0; m < 4; ++m) { const bf16x8 a = *(const bf16x8*)(HB + (t0 + m * 16 + fr) * D + k0); acc[m] = __builtin_amdgcn_mfma_f32_16x16x32_bf16(a, bw, acc[m], 0, 0, 0); } }
#pragma unroll
            for (int m = 0; m < 4; ++m)
#pragma unroll
                for (int r = 0; r < 4; ++r) gpart[(wid * 64 + m * 16 + 4 * fq + r) * 16 + fr] = acc[m][r];
        }
        LDS_WAIT(); __syncthreads();
#pragma unroll
        for (int e = 0; e < 2; ++e) { const int o = tid * 2 + e, row = o >> 4, col = o & 15; float s = 0.f;
#pragma unroll
            for (int w = 0; w < 8; ++w) s += gpart[(w * 64 + row) * 16 + col];
            const float val = softcap_f(s * pg8::row_rstd(ssq, (int)t0 + row) + P.b_gates[col]);
            if (col < 8) igA[col * 64 + row] = val; else lfA[(col - 8) * 64 + row] = logsigmoid_f(val); }
        LDS_WAIT(); __syncthreads();
        const int h = wid, mu = (b * MH + h) * NCH + c;
        const float ig = igA[h * 64 + lane], bcum = scan_add(lfA[h * 64 + lane], lane), bL = __shfl(bcum, 63);
        const float a = bL - bcum + ig, ml = wave_max(a), wgt = fexp(a - ml);
        BIG[(size_t)mu * 128 + lane] = bcum; BIG[(size_t)mu * 128 + 64 + lane] = ig;
        if (lane == 0) { scal[mu] = ml; scal[NUNIT + mu] = bL; }
        const int lr = lane >> 3, lc = lane & 7;
        {
            const v4u* kp = (const v4u*)(MK + (t0 + lr) * 512 + h * DK) + lc; v4u kx[8];
#pragma unroll
            for (int i = 0; i < 8; ++i) kx[i] = kp[(size_t)i * 8 * 64];
#pragma unroll
            for (int i = 0; i < 8; ++i) *(LAS v4u*)(kimg + (lc >> 2) * 4096 + (8 * i + lr) * 64 + (lc & 3) * 16) = scale8(kx[i], __shfl(wgt, 8 * i + lr));
        }
#pragma unroll 1
        for (int rv = 0; rv < 2; ++rv) {
            { const v4u* vp = (const v4u*)(MV + (t0 + lr) * 1024 + h * DV + rv * 64) + lc; v4u vx[8];
#pragma unroll
              for (int i = 0; i < 8; ++i) vx[i] = vp[(size_t)i * 8 * 128];
#pragma unroll
              for (int i = 0; i < 8; ++i) *(LAS v4u*)(vimg + (lc >> 2) * 4096 + (8 * i + lr) * 64 + (lc & 3) * 16) = vx[i]; }
            LDS_WAIT();
#pragma unroll
            for (int kt = 0; kt < 2; ++kt) {
                bf16x8 af[4];
#pragma unroll
                for (int ks = 0; ks < 4; ++ks) af[ks] = trfrag(ktr + kt * 4096, ks);
#pragma unroll
                for (int vt = 0; vt < 2; ++vt) {
                    f32x16 d = f32x16{};
#pragma unroll
                    for (int ks = 0; ks < 4; ++ks) d = MOBA_MFMA(af[ks], trfrag(vtrp + vt * 4096, ks), d);
                    bf16* cp = cloc + (size_t)mu * 8192 + (size_t)(rv * 64 + vt * 32 + r32) * 64 + kt * 32 + 4 * hi;
#pragma unroll
                    for (int g = 0; g < 4; ++g) { uint2 w; w.x = cvtpk_s(d[4 * g], d[4 * g + 1]); w.y = cvtpk_s(d[4 * g + 2], d[4 * g + 3]); *(uint2*)(cp + 8 * g) = w; }
                }
                if (rv == 0) {
                    const bf16x8 ones = (bf16x8){0x3F80, 0x3F80, 0x3F80, 0x3F80, 0x3F80, 0x3F80, 0x3F80, 0x3F80};
                    f32x16 d = f32x16{};
#pragma unroll
                    for (int ks = 0; ks < 4; ++ks) d = MOBA_MFMA(af[ks], ones, d);
                    if (r32 == 0) {
#pragma unroll
                        for (int r = 0; r < 16; ++r) nloc[(size_t)mu * 64 + kt * 32 + crow(r, hi)] = d[r]; }
                }
            }
            LDS_WAIT();
        }
        LDS_WAIT(); __syncthreads();
    }
}
__device__ __forceinline__ void pb_mlstm_scan(Frame& F, const Ptrs& P, bool dry = false) {
    const int tid_l = ltid(), lane_l = tid_l & 63; (void)lane_l;
    unsigned char* ws = P.ws;
    bf16* cloc = (bf16*)(ws + WS_CLOC); float* nloc = (float*)(ws + WS_NLOC); float* scal = (float*)(ws + WS_SCAL);
    LAS float* dec = (LAS float*)(F.lds + RING_OFF); LAS float* scl = dec + NCH;
    const int tid = tid_l;
    for (int unit = F.vcu; unit < BATCH * MH * 16; unit += F.G) {
        const int bh = unit >> 4, sl = unit & 15;
        if (tid < 64) {
            float mp = 0.f;
            for (int c = 0; c < NCH; ++c) { const int mu = bh * NCH + c; const float ml = scal[mu], bl = scal[NUNIT + mu];
                const float mn = fmaxf(bl + mp, ml);
                if (tid == 0) { dec[c] = fexp(bl + mp - mn); scl[c] = fexp(ml - mn); if (sl == 0 && !dry) scal[2 * NUNIT + mu] = mp; }
                mp = mn; }
        }
        LDS_WAIT(); __syncthreads();
        { bf16* p = cloc + (size_t)bh * NCH * 8192 + sl * 512 + tid; bf16* pw = dry ? p + (size_t)32 * MiB / 2 : p; float st = 0.f;
#pragma unroll 1
          for (int c0 = 0; c0 < NCH; c0 += 32) { unsigned short x[32];
#pragma unroll
              for (int i = 0; i < 32; ++i) x[i] = p[(size_t)(c0 + i) * 8192];
#pragma unroll
              for (int i = 0; i < 32; ++i) { pw[(size_t)(c0 + i) * 8192] = (bf16)f2bf(st); st = dec[c0 + i] * st + scl[c0 + i] * bf2f(x[i]); } } }
        if (sl == 0 && tid < 64 && !dry) { float* p = nloc + (size_t)bh * NCH * 64 + tid; float st = 0.f;
#pragma unroll 1
            for (int c0 = 0; c0 < NCH; c0 += 16) { float x[16];
#pragma unroll
                for (int i = 0; i < 16; ++i) x[i] = p[(size_t)(c0 + i) * 64];
#pragma unroll
                for (int i = 0; i < 16; ++i) { p[(size_t)(c0 + i) * 64] = st; st = dec[c0 + i] * st + scl[c0 + i] * x[i]; } } }
        LDS_WAIT(); __syncthreads();
    }
}
__device__ __forceinline__ void pc_mlstm_out(Frame& F, const Ptrs& P) {
    const int tid_l = ltid(), lane_l = tid_l & 63; (void)lane_l;
    using namespace mls;
    unsigned char* ws = P.ws;
    const bf16* MQ = (const bf16*)(ws + WS_MQ); const bf16* MK = (const bf16*)(ws + WS_MK); const bf16* MV = (const bf16*)(ws + WS_MV); const bf16* OG = (const bf16*)(ws + WS_OG);
    const bf16* cin = (const bf16*)(ws + WS_CLOC); const float* nin = (const float*)(ws + WS_NLOC); const float* scal = (const float*)(ws + WS_SCAL); const float* BIG = (const float*)(ws + WS_BIG);
    bf16* Y = (bf16*)(ws + WS_Y);
    const int tid = tid_l, lane = tid & 63, wid = F.wave, r32 = lane & 31, hi = lane >> 5, qg = wid & 1, vt = wid >> 1;
    constexpr int LBUF = 24576, LK = 0, LV = 8192, LH = 2 * LBUF, HP = 132;
    LAS float* hst = (LAS float*)(F.lds + RING_OFF + LH);
    LAS float* arrs = (LAS float*)(F.lds + mls::XTRA_OFF); LAS float* wsf = arrs + 2 * 256 + wid * 64;
    const int l = qg * 32 + r32, rl = tid >> 3, rvb = (tid & 7) * 16;
    bf16x8 qn[4], cn[4]; v4u ogn[2]; f32x4 hnn[4]; float m_in_n = 0.f;
#define PC_ISSUE(unit_, par_) do { const int u_ = (unit_), bh_ = u_ >> 7, c_ = u_ & 127, b_ = bh_ >> 3, h_ = bh_ & 7; const size_t t_ = (size_t)b_ * SEQ + (size_t)c_ * LCH; \
        const unsigned lds0_ = (unsigned)(uintptr_t)(F.lds + RING_OFF) + (par_) * LBUF; \
        glds16(MK + (t_ + lane) * 512 + h_ * DK + wid * 8, (unsigned)__builtin_amdgcn_readfirstlane(lds0_ + LK + wid * 1024)); \
        _Pragma("unroll") for (int i_ = 0; i_ < 2; ++i_) { const int p_ = wid + 8 * i_; \
            glds16(MV + (t_ + 16 * (p_ & 3) + (lane >> 2)) * 1024 + h_ * DV + (p_ >> 2) * 32 + (lane & 3) * 8, (unsigned)__builtin_amdgcn_readfirstlane(lds0_ + LV + p_ * 1024)); } \
        { const bf16* qp_ = MQ + (t_ + l) * 512 + h_ * DK + hi * 8; _Pragma("unroll") for (int d0 = 0; d0 < 4; ++d0) qn[d0] = *(const bf16x8*)(qp_ + d0 * 16); \
          const bf16* cp_ = cin + (size_t)u_ * 8192 + (size_t)(vt * 32 + r32) * 64 + hi * 8; _Pragma("unroll") for (int d0 = 0; d0 < 4; ++d0) cn[d0] = *(const bf16x8*)(cp_ + d0 * 16); } \
        { const v4u* gp_ = (const v4u*)(OG + (t_ + rl) * D + h_ * DV + rvb); ogn[0] = gp_[0]; ogn[1] = gp_[1]; const f32x4* np_ = (const f32x4*)(P.head_norm + h_ * DV + rvb); hnn[0] = np_[0]; hnn[1] = np_[1]; hnn[2] = np_[2]; hnn[3] = np_[3]; } \
        m_in_n = scal[2 * NUNIT + u_]; \
        if (wid == 0) { LAS float* a_ = arrs + (par_) * 256; const float bc_ = BIG[(size_t)u_ * 128 + lane], g_ = BIG[(size_t)u_ * 128 + 64 + lane] - bc_; \
            a_[lane] = g_; a_[64 + lane] = fmaxf(m_in_n, scan_max(g_, lane)); a_[128 + lane] = bc_; a_[192 + lane] = nin[(size_t)u_ * 64 + lane]; } } while (0)
    int it = 0;
    if (F.vcu < NUNIT) PC_ISSUE(F.vcu, 0);
    for (int unit = F.vcu; unit < NUNIT; unit += F.G, ++it) {
        const int par = it & 1, bh = unit >> 7, c = unit & 127, b = bh >> 3, h = bh & 7; const size_t t0 = (size_t)b * SEQ + (size_t)c * LCH;
        asm volatile("s_waitcnt vmcnt(0) lgkmcnt(0)\n\ts_barrier" ::: "memory");
        bf16x8 qr[4], cf[4]; v4u ogv[2]; f32x4 hnv[4];
#pragma unroll
        for (int d0 = 0; d0 < 4; ++d0) { qr[d0] = qn[d0]; cf[d0] = cn[d0]; hnv[d0] = hnn[d0]; }
        ogv[0] = ogn[0]; ogv[1] = ogn[1];
        const float m_in = m_in_n; const size_t roff = (t0 + rl) * D + h * DV + rvb;
        if (unit + F.G < NUNIT) PC_ISSUE(unit + F.G, par ^ 1);
        LAS float* garr = arrs + par * 256; LAS float* mmarr = garr + 64; LAS float* barr = garr + 128; LAS float* nn = garr + 192;
        const lds_cptr kp0 = (lds_cptr)(F.lds + RING_OFF + par * LBUF + LK) + hi * 1024 + r32 * 16;
        const lds_cptr vp0 = (lds_cptr)(F.lds + RING_OFF + par * LBUF + LV) + vt * 4096 + ((lane >> 4) & 1) * 32 + (lane & 3) * 8 + (4 * hi + ((lane & 15) >> 2)) * 64;
        {
            bf16x8 kf[8];
#pragma unroll
            for (int d0 = 0; d0 < 4; ++d0) { kf[2 * d0] = *(const LAS bf16x8*)(kp0 + d0 * 2048); kf[2 * d0 + 1] = *(const LAS bf16x8*)(kp0 + d0 * 2048 + 512); }
            f32x16 c0 = f32x16{}, c1 = f32x16{};
#pragma unroll
            for (int d0 = 0; d0 < 4; ++d0) { c0 = MOBA_MFMA(kf[2 * d0], qr[d0], c0); c1 = MOBA_MFMA(kf[2 * d0 + 1], qr[d0], c1); }
            const float mml = mmarr[l];
            float rsum = 0.f; int lrel = l - 4 * hi; asm volatile("" : "+v"(lrel));
#pragma unroll
            for (int r = 0; r < 16; ++r) { const int s0 = crow(r, hi), s1 = s0 + 32, sr = (r & 3) + 8 * (r >> 2);
                const float e0 = __builtin_amdgcn_exp2f((garr[s0] - mml) * LOG2E), e1 = __builtin_amdgcn_exp2f((garr[s1] - mml) * LOG2E);
                c0[r] = __builtin_bit_cast(float, __builtin_bit_cast(unsigned, c0[r] * e0) & ~(unsigned)((lrel - sr) >> 31));
                c1[r] = __builtin_bit_cast(float, __builtin_bit_cast(unsigned, c1[r] * e1) & ~(unsigned)((lrel - sr - 32) >> 31)); rsum += c0[r] + c1[r]; }
            rsum = halves_sum(rsum);
            float qn = 0.f;
#pragma unroll
            for (int d0 = 0; d0 < 4; ++d0)
#pragma unroll
                for (int j = 0; j < 8; ++j) qn += bf2f((unsigned short)qr[d0][j]) * nn[d0 * 16 + hi * 8 + j];
            qn = halves_sum(qn);
            const float inter = fexp(m_in - mml), den = inter * qn + rsum, rd = 1.0f / fmaxf(fabsf(den), fexp(-(barr[l] + mml)));
            if (hi == 0) { wsf[r32] = inter; wsf[32 + r32] = rd; }
            f32x16 o = f32x16{};
#pragma unroll
            for (int d0 = 0; d0 < 4; ++d0) o = MOBA_MFMA(qr[d0], cf[d0], o);
            asm volatile("s_waitcnt lgkmcnt(0)" ::: "memory");
#pragma unroll
            for (int r = 0; r < 16; ++r) o[r] *= wsf[crow(r, hi)];
            u32x4 pw0, pw1, pw2, pw3;
            pw0 = (u32x4){cvtpk_s(c0[0], c0[1]), cvtpk_s(c0[2], c0[3]), cvtpk_s(c0[4], c0[5]), cvtpk_s(c0[6], c0[7])}; pw1 = (u32x4){cvtpk_s(c0[8], c0[9]), cvtpk_s(c0[10], c0[11]), cvtpk_s(c0[12], c0[13]), cvtpk_s(c0[14], c0[15])};
            pw2 = (u32x4){cvtpk_s(c1[0], c1[1]), cvtpk_s(c1[2], c1[3]), cvtpk_s(c1[4], c1[5]), cvtpk_s(c1[6], c1[7])}; pw3 = (u32x4){cvtpk_s(c1[8], c1[9]), cvtpk_s(c1[10], c1[11]), cvtpk_s(c1[12], c1[13]), cvtpk_s(c1[14], c1[15])};
            o = MOBA_MFMA(__builtin_bit_cast(bf16x8, pw0), trfrag(vp0, 0), o); o = MOBA_MFMA(__builtin_bit_cast(bf16x8, pw1), trfrag(vp0, 1), o);
            o = MOBA_MFMA(__builtin_bit_cast(bf16x8, pw2), trfrag(vp0, 2), o); o = MOBA_MFMA(__builtin_bit_cast(bf16x8, pw3), trfrag(vp0, 3), o);
#pragma unroll
            for (int r = 0; r < 16; ++r) hst[(qg * 32 + crow(r, hi)) * HP + vt * 32 + r32] = o[r] * wsf[32 + crow(r, hi)];
        }
        LDS_WAIT(); __syncthreads();
        {
            float hv[16]; float ss = 0.f;
#pragma unroll
            for (int j = 0; j < 4; ++j) { const mls::f32x4v x = *(const LAS mls::f32x4v*)(hst + rl * HP + rvb + 4 * j); hv[4 * j] = x.x; hv[4 * j + 1] = x.y; hv[4 * j + 2] = x.z; hv[4 * j + 3] = x.w; ss += (x.x * x.x + x.y * x.y) + (x.z * x.z + x.w * x.w); }
            ss += __shfl_xor(ss, 1); ss += __shfl_xor(ss, 2); ss += __shfl_xor(ss, 4);
            const float r = __builtin_amdgcn_rsqf(ss * (1.0f / 128.0f) + RMS_EPS);
            float y[16];
#pragma unroll
            for (int i = 0; i < 2; ++i) { const v4u u = ogv[i]; const f32x4 n0 = hnv[2 * i], n1 = hnv[2 * i + 1];
                y[8 * i] = bflo(u.x) * hv[8 * i] * r * n0.x; y[8 * i + 1] = bfhi(u.x) * hv[8 * i + 1] * r * n0.y; y[8 * i + 2] = bflo(u.y) * hv[8 * i + 2] * r * n0.z; y[8 * i + 3] = bfhi(u.y) * hv[8 * i + 3] * r * n0.w;
                y[8 * i + 4] = bflo(u.z) * hv[8 * i + 4] * r * n1.x; y[8 * i + 5] = bfhi(u.z) * hv[8 * i + 5] * r * n1.y; y[8 * i + 6] = bflo(u.w) * hv[8 * i + 6] * r * n1.z; y[8 * i + 7] = bfhi(u.w) * hv[8 * i + 7] * r * n1.w; }
            v4u* yp = (v4u*)(Y + roff);
#pragma unroll
            for (int i = 0; i < 2; ++i) { v4u o; o.x = pk2(y[8 * i], y[8 * i + 1]); o.y = pk2(y[8 * i + 2], y[8 * i + 3]); o.z = pk2(y[8 * i + 4], y[8 * i + 5]); o.w = pk2(y[8 * i + 6], y[8 * i + 7]); yp[i] = o; }
        }
    }
#undef PC_ISSUE
    LDS_WAIT(); __syncthreads();
}
__device__ __forceinline__ void p_final_norm(Frame& F, const Ptrs& P, bool dry = false) {
    const int tid_l = ltid(), lane_l = tid_l & 63; (void)lane_l;
    const int gw = F.vcu * NWAVES + F.wave, NGW = F.G * NWAVES;
    const bf16* hb = (const bf16*)(P.ws + WS_AB); const float* ssq = (const float*)(P.ws + WS_SSQ);
    f32x4 wn[4];
#pragma unroll
    for (int j = 0; j < 4; ++j) wn[j] = ((const f32x4*)P.final_norm)[lane_l * 4 + j];
    for (int m = gw; m < M; m += NGW) {
        const v4u* hr = (const v4u*)(hb + (size_t)m * D) + lane_l * 2;
        const v4u a = hr[0], b = hr[1];
        const float r = pg8::row_rstd(ssq, m);
        float* orow = (dry ? (float*)(P.ws + WS_Q) : P.out) + (size_t)m * D + lane_l * 16;
        f32x4 o0 = (f32x4){bflo(a.x), bfhi(a.x), bflo(a.y), bfhi(a.y)} * r * wn[0], o1 = (f32x4){bflo(a.z), bfhi(a.z), bflo(a.w), bfhi(a.w)} * r * wn[1];
        f32x4 o2 = (f32x4){bflo(b.x), bfhi(b.x), bflo(b.y), bfhi(b.y)} * r * wn[2], o3 = (f32x4){bflo(b.z), bfhi(b.z), bflo(b.w), bfhi(b.w)} * r * wn[3];
        ((f32x4*)orow)[0] = o0; ((f32x4*)orow)[1] = o1; ((f32x4*)orow)[2] = o2; ((f32x4*)orow)[3] = o3;
    }
}

struct Args { Ptrs p; };
__device__ __forceinline__ Ptrs load_ptrs() {
#if defined(__HIP_DEVICE_COMPILE__)
    typedef __attribute__((address_space(4))) const unsigned long long* kptr_t;
    kptr_t kp = (kptr_t)__builtin_amdgcn_kernarg_segment_ptr();
    asm volatile("" : "+s"(kp));
    Ptrs p;
    p.x = (const float*)kp[0]; p.attn_norm = (const float*)kp[1]; p.w_qkv = (const float*)kp[2]; p.w_o = (const float*)kp[3]; p.mlstm_norm = (const float*)kp[4]; p.w_in = (const float*)kp[5];
    p.b_gates = (const float*)kp[6]; p.head_norm = (const float*)kp[7]; p.w_out = (const float*)kp[8]; p.ffn_norm = (const float*)kp[9]; p.w_gu = (const float*)kp[10]; p.w_down = (const float*)kp[11];
    p.final_norm = (const float*)kp[12]; p.out = (float*)kp[13]; p.ws = (unsigned char*)kp[14];
    return p;
#else
    return Ptrs{};
#endif
}
__global__ void __launch_bounds__(NWAVES * 64, 2) mk_fwd(Args args) {
    extern __shared__ __attribute__((aligned(16))) unsigned char lds[];
    Frame F;
    F.lds = (LAS unsigned char*)lds;
    F.MISC = (volatile LAS unsigned*)(F.lds + MISC_OFF);
    F.wave = __builtin_amdgcn_readfirstlane((int)threadIdx.x >> 6);
    F.G = gridDim.x; { const int bx = blockIdx.x; F.vcu = (F.G % 8 == 0) ? (bx % 8) * (F.G / 8) + bx / 8 : bx; }
    F.ctl = (gu32*)(args.p.ws + WS_CTL);
    for (int u = ((int)threadIdx.x); u < (LDS_BYTES - LDSCTL_OFF) / 4; u += NWAVES * 64) ((LAS unsigned*)(F.lds + LDSCTL_OFF))[u] = 0u;
    __syncthreads();
    XcdBarrier bar = xcd_barrier_post((unsigned*)(F.ctl + CW_BAR), F.MISC + 8);
#define GRID_BAR() xcd_barrier(bar)
#ifndef PH_MASK
#define PH_MASK 0xFFFFF
#endif
#define PH(k) ((PH_MASK >> (k)) & 1)
#ifndef DUP_MASK
#define DUP_MASK 0
#endif
#ifndef EXTRA_BARS
#define EXTRA_BARS 0
#endif
#define REP(k) for (int rep_ = 0; rep_ <= ((DUP_MASK >> (k)) & 1); ++rep_)
#define PHASE_PTRS() const Ptrs P = load_ptrs(); unsigned char* const ws = P.ws; (void)ws
#define SSQ(i) ((float*)(ws + WS_SSQ) + (size_t)(i) * M * 16)

    REP(0) if (PH(0)) { PHASE_PTRS(); p0_prologue(F, P); } GRID_BAR();
    _Pragma("unroll 1") for (int xb_ = 0; xb_ < EXTRA_BARS; ++xb_) GRID_BAR();
    REP(1) if (PH(1)) { PHASE_PTRS(); pg8::Gemm g{(const bf16*)(ws + WS_AB), (const bf16*)(ws + WS_WQKV), M, 3 * D, D}; pg8::StaticOrder S; S.init(M, 3 * D, F.G, (int)blockIdx.x);
      pg8::EpiQKV E{(bf16*)(ws + WS_Q), (size_t)(WS_K - WS_Q) / 2, SSQ(0), (const float*)(ws + WS_ROPE), (float*)(ws + WS_KMEAN)};
      pg8::gemm_phase<pg8::EpiQKV, pg8::StaticOrder, PG8_ALIGN, PG8_SP2>(F.lds + RING_OFF, g, S, E); } GRID_BAR();
    REP(2) if (PH(2)) { PHASE_PTRS(); p2_gating(F, P); } GRID_BAR();
    REP(3) if (PH(3)) { PHASE_PTRS(); p3_gathered(F, P, rep_); } GRID_BAR();
    REP(15) if (PH(15)) { PHASE_PTRS(); p4_own_combine(F, P); } GRID_BAR();
    REP(4) if (PH(4)) { PHASE_PTRS(); pg8::Gemm g{(const bf16*)(ws + WS_AB), (const bf16*)(ws + WS_WO), M, D, D}; pg8::StaticOrder S; S.init(M, D, F.G, (int)blockIdx.x);
      pg8::EpiRes<true, false> E{P.x, ws + WS_HB1, SSQ(1)};
      pg8::gemm_phase<pg8::EpiRes<true, false>, pg8::StaticOrder, PG8_ALIGN, PG8_SP2>(F.lds + RING_OFF, g, S, E); } GRID_BAR();
    REP(5) if (PH(5)) { PHASE_PTRS(); pg8::Gemm g{(const bf16*)(ws + WS_HB1), (const bf16*)(ws + WS_WGU), M, NGU, D}; pg8::StaticOrder S; S.init(M, NGU, F.G, (int)blockIdx.x);
      pg8::EpiSwiGLU E{(bf16*)(ws + WS_ACT), SSQ(1)};
      pg8::gemm_phase<pg8::EpiSwiGLU, pg8::StaticOrder, PG8_ALIGN, PG8_SP2>(F.lds + RING_OFF, g, S, E); } GRID_BAR();
    REP(6) if (PH(6)) { PHASE_PTRS(); pg8::Gemm g{(const bf16*)(ws + WS_ACT), (const bf16*)(ws + WS_WD), M, D, DFF}; pg8::StaticOrder S; S.init(M, D, F.G, (int)blockIdx.x);
      pg8::EpiRes<false, false> E{ws + WS_HB1, ws + WS_AB, SSQ(2)};
      pg8::gemm_phase<pg8::EpiRes<false, false>, pg8::StaticOrder, PG8_ALIGN, PG8_SP2>(F.lds + RING_OFF, g, S, E); } GRID_BAR();
    REP(7) if (PH(7)) { PHASE_PTRS(); pg8::Gemm g{(const bf16*)(ws + WS_AB), (const bf16*)(ws + WS_WIN), M, NIN, D}; pg8::StaticOrder S; S.init(M, NIN, F.G, (int)blockIdx.x);
      pg8::EpiMlstmIn E{(bf16*)(ws + WS_MQ), (bf16*)(ws + WS_MK), (bf16*)(ws + WS_MV), (bf16*)(ws + WS_OG), SSQ(2)};
      pg8::gemm_phase<pg8::EpiMlstmIn, pg8::StaticOrder, PG8_ALIGN, PG8_SP2>(F.lds + RING_OFF, g, S, E); } GRID_BAR();
    REP(8) if (PH(8)) { PHASE_PTRS(); pa_mlstm_local(F, P); } GRID_BAR();
    REP(9) if (PH(9)) { PHASE_PTRS(); pb_mlstm_scan(F, P, rep_ < ((DUP_MASK >> 9) & 1)); } GRID_BAR();
    REP(10) if (PH(10)) { PHASE_PTRS(); pc_mlstm_out(F, P); } GRID_BAR();
    if (PH(11)) { PHASE_PTRS(); pg8::Gemm g{(const bf16*)(ws + WS_Y), (const bf16*)(ws + WS_WOUT), M, D, D}; pg8::StaticOrder S; S.init(M, D, F.G, (int)blockIdx.x);
      pg8::EpiRes<false, false> E{ws + WS_AB, ws + WS_HB1, SSQ(3)};
      pg8::gemm_phase<pg8::EpiRes<false, false>, pg8::StaticOrder, PG8_ALIGN, PG8_SP2>(F.lds + RING_OFF, g, S, E); } GRID_BAR();
    if (PH(12)) { PHASE_PTRS(); pg8::Gemm g{(const bf16*)(ws + WS_HB1), (const bf16*)(ws + WS_WGU) + (size_t)NGU * D, M, NGU, D}; pg8::StaticOrder S; S.init(M, NGU, F.G, (int)blockIdx.x);
      pg8::EpiSwiGLU E{(bf16*)(ws + WS_ACT), SSQ(3)};
      pg8::gemm_phase<pg8::EpiSwiGLU, pg8::StaticOrder, PG8_ALIGN, PG8_SP2>(F.lds + RING_OFF, g, S, E); } GRID_BAR();
    if (PH(13)) { PHASE_PTRS(); pg8::Gemm g{(const bf16*)(ws + WS_ACT), (const bf16*)(ws + WS_WD) + (size_t)D * DFF, M, D, DFF}; pg8::StaticOrder S; S.init(M, D, F.G, (int)blockIdx.x);
      pg8::EpiRes<false, false> E{ws + WS_HB1, ws + WS_AB, SSQ(0)};
      pg8::gemm_phase<pg8::EpiRes<false, false>, pg8::StaticOrder, PG8_ALIGN, PG8_SP2>(F.lds + RING_OFF, g, S, E); } GRID_BAR();
    REP(14) if (PH(14)) { PHASE_PTRS(); p_final_norm(F, P, rep_ < ((DUP_MASK >> 14) & 1)); }
}

extern "C" void kernel_launch(void* const* d_in, const int* in_sizes, int n_in, void* d_out, int out_size, void* d_ws, size_t ws_size, hipStream_t stream) {
    static int grid = 0;
    if (grid == 0) {
        if (n_in != 13 || in_sizes[0] != M * D || out_size != M * D || ws_size < WS_END) { fprintf(stderr, "kernel_launch: unexpected shapes (n_in %d, in0 %d, out %d, ws %zu); nothing launched\n", n_in, n_in > 0 ? in_sizes[0] : -1, out_size, ws_size); grid = -1; return; }
        int dev = 0, cus = 0, per_cu = 0;
        if (hipGetDevice(&dev) != hipSuccess || hipDeviceGetAttribute(&cus, hipDeviceAttributeMultiprocessorCount, dev) != hipSuccess) { grid = -1; return; }
        if (hipFuncSetAttribute((const void*)mk_fwd, hipFuncAttributeMaxDynamicSharedMemorySize, LDS_BYTES) != hipSuccess) { fprintf(stderr, "kernel_launch: hipFuncSetAttribute failed\n"); grid = -1; return; }
        if (hipOccupancyMaxActiveBlocksPerMultiprocessor(&per_cu, (const void*)mk_fwd, NWAVES * 64, LDS_BYTES) != hipSuccess || per_cu < 1) { fprintf(stderr, "kernel_launch: occupancy query reports %d blocks per CU\n", per_cu); }
        (void)hipGetLastError();
        grid = cus;
    }
    if (grid < 0) return;
    if (hipMemsetAsync((char*)d_ws + WS_CTL, 0, CTL_ZERO_BYTES, stream) != hipSuccess) { fprintf(stderr, "kernel_launch: hipMemsetAsync failed\n"); return; }
    Args a{};
    a.p.x = (const float*)d_in[0]; a.p.attn_norm = (const float*)d_in[1]; a.p.w_qkv = (const float*)d_in[2]; a.p.w_o = (const float*)d_in[3];
    a.p.mlstm_norm = (const float*)d_in[4]; a.p.w_in = (const float*)d_in[5]; a.p.b_gates = (const float*)d_in[6]; a.p.head_norm = (const float*)d_in[7]; a.p.w_out = (const float*)d_in[8];
    a.p.ffn_norm = (const float*)d_in[9]; a.p.w_gu = (const float*)d_in[10]; a.p.w_down = (const float*)d_in[11]; a.p.final_norm = (const float*)d_in[12];
    a.p.out = (float*)d_out; a.p.ws = (unsigned char*)d_ws;
    hipLaunchKernelGGL(mk_fwd, dim3(grid), dim3(NWAVES * 64), LDS_BYTES, stream, a);
    const hipError_t le = hipPeekAtLastError();
    if (le != hipSuccess) fprintf(stderr, "kernel_launch: launch failed: %s\n", hipGetErrorName(le));
}
```

```cpp
#include <hip/hip_runtime.h>
#include <cstdio>
#include <cstdint>
namespace pg8 {
#define PG8_LAS __attribute__((address_space(3)))
typedef unsigned short bf16_t;
typedef short bf16x8 __attribute__((ext_vector_type(8)));
typedef float f32x4 __attribute__((ext_vector_type(4)));
typedef unsigned u32x4 __attribute__((ext_vector_type(4)));
constexpr int BM = 256, BK = 64, HALF = 128, HTB = HALF * BK * 2  , STAGE_BYTES = 8 * HTB, NXCD = 8, WGM = 8;

__host__ __device__ __forceinline__ int lds_byte(int r, int c) { const int st = (r >> 4) * 2 + (c >> 5), rr = r & 15, cc = c & 31, ob = rr * 64 + cc * 2; return st * 1024 + (ob ^ (((ob >> 9) & 1) << 5)); }
__host__ __device__ __forceinline__ void stage_rc(int b, int& R, int& C) { const int st = b / 1024, sb = b % 1024, swz = sb ^ (((sb >> 9) & 1) << 5); R = (st >> 1) * 16 + swz / 64; C = (st & 1) * 32 + (swz % 64) / 2; }
__host__ __device__ __forceinline__ int perm32(int rho) { const int n = rho >> 4, i = rho & 15; return 8 * (i >> 2) + 4 * n + (i & 3); }

struct Unit { int pm, pn; };
struct Gemm { const bf16_t* A; const bf16_t* Bt; int M, N, K; };

struct StaticOrder {
    int nM, nN, nwg, G, c;
    __host__ __device__ void init(int M, int N, int G_, int c_) { nM = M / BM; nN = N / BM; nwg = nM * nN; G = G_; c = c_; }
    __host__ __device__ bool next(int i, Unit& u) const {
        const long L = (long)i * G + c; if (L >= nwg) return false;
        int wgid = (int)L; { const int q = nwg / NXCD, r = nwg % NXCD, xcd = wgid % NXCD, off = wgid / NXCD; wgid = (xcd < r ? xcd * (q + 1) : r * (q + 1) + (xcd - r) * q) + off; }
        const int nig = WGM * nN, gid = wgid / nig, fm = gid * WGM, gsz = (nM - fm) < WGM ? (nM - fm) : WGM;
        u.pm = fm + ((wgid % nig) % gsz); u.pn = (wgid % nig) / gsz; return true;
    }
    __device__ __forceinline__ void a_ready(const Unit&) const {}
    __device__ __forceinline__ void done(const Unit&) const {}
};
__device__ __forceinline__ unsigned cvt_pk_bf16(float lo, float hi) { unsigned r; asm volatile("v_cvt_pk_bf16_f32 %0, %1, %2" : "=v"(r) : "v"(lo), "v"(hi)); return r; }
typedef float f32x2 __attribute__((ext_vector_type(2)));
constexpr float RMS_EPS_F = 1e-6f;
constexpr float QSCALE_LOG2 = 0.18033688011112042f;
__device__ __forceinline__ float row_rstd(const float* ssq, int row) {
    const f32x4* p = (const f32x4*)(ssq + (size_t)row * 16);
    const f32x4 a = p[0], b = p[1], c = p[2], d = p[3];
    const float s = (((a[0] + a[1]) + (a[2] + a[3])) + ((b[0] + b[1]) + (b[2] + b[3]))) + (((c[0] + c[1]) + (c[2] + c[3])) + ((d[0] + d[1]) + (d[2] + d[3])));
    return __builtin_amdgcn_rsqf(s * (1.0f / 1024.0f) + RMS_EPS_F);
}
__device__ __forceinline__ void store16_wt(void* p, const u32x4& v) { asm volatile("global_store_dwordx4 %0, %1, off sc1\n\ts_nop 1" :: "v"(p), "v"(v) : "memory"); }
__device__ __forceinline__ u32x4 pack8(const f32x4& v0, const f32x4& v1) { u32x4 w; w.x = cvt_pk_bf16(v0[0], v0[1]); w.y = cvt_pk_bf16(v0[2], v0[3]); w.z = cvt_pk_bf16(v1[0], v1[1]); w.w = cvt_pk_bf16(v1[2], v1[3]); return w; }

struct EpiQKV {
    static constexpr bool PERM = true, AFTER_DRAIN = false;
    bf16_t* QKV; size_t tstride; const float* ssq; const float* rope; float* kmean;
    __device__ __forceinline__ void operator()(const f32x4 (&acc)[2][2][4][2], const Unit& u, int wr, int wc, int fr, int fq) const {
        const int t = u.pn >> 2;
        bf16_t* base = QKV + (size_t)t * tstride;
        const int col0 = (u.pn & 3) * BM + wc * 32 + 8 * fq;
        const bool rot = (t < 2) && ((wc & 1) == 0) && (fq < 2);
        f32x4 ivf;
        ivf = (fq & 1) ? (f32x4){0.0014142135623842478f, 0.00027424818836152554f, 5.3182957344688475e-05f, 1.0313385246263351e-05f} : (f32x4){1.0f, 0.1939227432012558f, 0.03760603070259094f, 0.007292664609849453f};
        const float sc = (t == 0) ? QSCALE_LOG2 : 1.0f;
        const int lane = fq * 16 + fr;
        float rv[2];
#pragma unroll
        for (int ai = 0; ai < 2; ++ai) rv[ai] = row_rstd(ssq, u.pm * BM + ai * HALF + wr * 64 + lane);
#pragma unroll
        for (int bj = 0; bj < 2; ++bj) {
            f32x4 ks0 = (f32x4){0.f, 0.f, 0.f, 0.f}, ks1 = ks0;
#pragma unroll
            for (int ai = 0; ai < 2; ++ai)
#pragma unroll
                for (int m = 0; m < 4; ++m) {
                    const int row = u.pm * BM + ai * HALF + wr * 64 + m * 16 + fr;
                    const float rs = __shfl(rv[ai], m * 16 + fr);
                    f32x4 v0 = acc[ai][bj][m][0] * rs, v1 = acc[ai][bj][m][1] * rs;
                    if (rot) {
                        const float pos = (float)(row & 8191); f32x4 c, s;
#pragma unroll
                        for (int j = 0; j < 4; ++j) { const float rev = __fmul_rn(pos, ivf[j]) * 0.15915494309189535f, fr_ = rev - __builtin_rintf(rev); c[j] = __builtin_amdgcn_cosf(fr_); s[j] = __builtin_amdgcn_sinf(fr_); }
                        const f32x4 x1 = v0, x2 = v1; v0 = x1 * c - x2 * s; v1 = x2 * c + x1 * s; }
                    if (t == 1) { ks0 += v0; ks1 += v1; }
                    v0 = v0 * sc; v1 = v1 * sc;
                    store16_wt(base + ((size_t)((row >> 13) * 16 + (u.pn & 3) * 4 + bj * 2 + (wc >> 1)) * 8192 + (row & 8191)) * 64 + (wc & 1) * 32 + 8 * fq, pack8(v0, v1));
                    asm volatile("" ::: "memory");
                }
            if (t == 1) {
                float* km = kmean + (size_t)u.pm * 1024 + col0 + bj * HALF;
#pragma unroll
                for (int j = 0; j < 4; ++j) {
                    float r0 = ks0[j]; r0 += __shfl_xor(r0, 1); r0 += __shfl_xor(r0, 2); r0 += __shfl_xor(r0, 4); r0 += __shfl_xor(r0, 8);
                    float r1 = ks1[j]; r1 += __shfl_xor(r1, 1); r1 += __shfl_xor(r1, 2); r1 += __shfl_xor(r1, 4); r1 += __shfl_xor(r1, 8);
                    if (fr == 0) { atomicAdd(km + j, r0 * (1.0f / 256.0f)); atomicAdd(km + 4 + j, r1 * (1.0f / 256.0f)); }
                }
            }
        }
    }
};

template <bool BASE_F32, bool OUT_F32> struct EpiRes {
    static constexpr bool PERM = true, AFTER_DRAIN = false;
    const void* base; void* out; float* ssq_out;
    __device__ __forceinline__ void operator()(const f32x4 (&acc)[2][2][4][2], const Unit& u, int wr, int wc, int fr, int fq) const {
        const int col0 = u.pn * BM + wc * 32 + 8 * fq;
#pragma unroll
        for (int ai = 0; ai < 2; ++ai)
#pragma unroll
            for (int m = 0; m < 4; ++m) {
                const int row = u.pm * BM + ai * HALF + wr * 64 + m * 16 + fr;
                float ss = 0.f;
#pragma unroll
                for (int bj = 0; bj < 2; ++bj) {
                    const size_t off = (size_t)row * 1024 + col0 + bj * HALF;
                    f32x4 b0, b1;
                    if (BASE_F32) { b0 = *(const f32x4*)((const float*)base + off); b1 = *(const f32x4*)((const float*)base + off + 4); }
                    else { const u32x4 w = *(const u32x4*)((const bf16_t*)base + off);
                        b0 = (f32x4){__builtin_bit_cast(float, w.x << 16), __builtin_bit_cast(float, w.x & 0xffff0000u), __builtin_bit_cast(float, w.y << 16), __builtin_bit_cast(float, w.y & 0xffff0000u)};
                        b1 = (f32x4){__builtin_bit_cast(float, w.z << 16), __builtin_bit_cast(float, w.z & 0xffff0000u), __builtin_bit_cast(float, w.w << 16), __builtin_bit_cast(float, w.w & 0xffff0000u)}; }
                    const f32x4 v0 = acc[ai][bj][m][0] + b0, v1 = acc[ai][bj][m][1] + b1;
                    if (OUT_F32) { *(f32x4*)((float*)out + off) = v0; *(f32x4*)((float*)out + off + 4) = v1; }
                    else { *(u32x4*)((bf16_t*)out + off) = pack8(v0, v1);
                        ss += ((v0[0] * v0[0] + v0[1] * v0[1]) + (v0[2] * v0[2] + v0[3] * v0[3])) + ((v1[0] * v1[0] + v1[1] * v1[1]) + (v1[2] * v1[2] + v1[3] * v1[3])); }
                }
                if (!OUT_F32) { ss += __shfl_xor(ss, 16); ss += __shfl_xor(ss, 32); if (fq == 0) ssq_out[(size_t)row * 16 + u.pn * 4 + wc] = ss; }
            }
    }
};

struct EpiSwiGLU {
    static constexpr bool PERM = true, AFTER_DRAIN = false;
    bf16_t* act; const float* ssq;
    __device__ __forceinline__ void operator()(const f32x4 (&acc)[2][2][4][2], const Unit& u, int wr, int wc, int fr, int fq) const {
        const int col0 = u.pn * HALF + wc * 32 + 8 * fq, lane = fq * 16 + fr;
        float rv[2];
#pragma unroll
        for (int ai = 0; ai < 2; ++ai) rv[ai] = row_rstd(ssq, u.pm * BM + ai * HALF + wr * 64 + lane);
#pragma unroll
        for (int ai = 0; ai < 2; ++ai)
#pragma unroll
            for (int m = 0; m < 4; ++m) {
                const int row = u.pm * BM + ai * HALF + wr * 64 + m * 16 + fr;
                const float rs = __shfl(rv[ai], m * 16 + fr);
                f32x4 o[2];
#pragma unroll
                for (int n = 0; n < 2; ++n) {
                    const f32x4 g = acc[ai][0][m][n] * rs, up = acc[ai][1][m][n] * rs;
#pragma unroll
                    for (int j = 0; j < 4; ++j) { const float e = __builtin_amdgcn_exp2f(g[j] * -1.4426950408889634f); o[n][j] = g[j] * up[j] * __builtin_amdgcn_rcpf(1.0f + e); }
                }
                store16_wt(act + (size_t)row * 2816 + col0, pack8(o[0], o[1]));
            }
    }
};

struct EpiMlstmIn {
    static constexpr bool PERM = true, AFTER_DRAIN = false;
    bf16_t* MQ; bf16_t* MK; bf16_t* MV; bf16_t* OG; const float* ssq;
    __device__ __forceinline__ void operator()(const f32x4 (&acc)[2][2][4][2], const Unit& u, int wr, int wc, int fr, int fq) const {
        bf16_t* base; float sc = 1.0f; bool sig = false; bool wide;
        int pt;
        if (u.pn < 2) { base = MQ; pt = u.pn; sc = 0.125f; wide = false; }
        else if (u.pn < 4) { base = MK; pt = u.pn - 2; wide = false; }
        else if (u.pn < 8) { base = MV; pt = u.pn - 4; wide = true; }
        else { base = OG; pt = u.pn - 8; wide = true; sig = true; }
        const int lane = fq * 16 + fr;
        float rv[2];
#pragma unroll
        for (int ai = 0; ai < 2; ++ai) rv[ai] = row_rstd(ssq, u.pm * BM + ai * HALF + wr * 64 + lane) * sc;
#pragma unroll
        for (int ai = 0; ai < 2; ++ai)
#pragma unroll
            for (int m = 0; m < 4; ++m) {
                const int row = u.pm * BM + ai * HALF + wr * 64 + m * 16 + fr;
                const float rs = __shfl(rv[ai], m * 16 + fr);
#pragma unroll
                for (int bj = 0; bj < 2; ++bj) {
                    f32x4 v0 = acc[ai][bj][m][0] * rs, v1 = acc[ai][bj][m][1] * rs;
                    if (sig) {
#pragma unroll
                        for (int j = 0; j < 4; ++j) { v0[j] = __builtin_amdgcn_rcpf(1.0f + __builtin_amdgcn_exp2f(v0[j] * -1.4426950408889634f)); v1[j] = __builtin_amdgcn_rcpf(1.0f + __builtin_amdgcn_exp2f(v1[j] * -1.4426950408889634f)); }
                    }
                    const size_t off = wide ? ((size_t)((row >> 13) * 8 + pt * 2 + bj) * 8192 + (row & 8191)) * 128 + wc * 32 + 8 * fq
                                            : ((size_t)((row >> 13) * 8 + pt * 4 + bj * 2 + (wc >> 1)) * 8192 + (row & 8191)) * 64 + (wc & 1) * 32 + 8 * fq;
                    store16_wt(base + off, pack8(v0, v1));
                }
            }
    }
};
template <class Epi, class Sched, bool ALIGN_EPI = false, bool SP2 = false>
__device__ __forceinline__ void gemm_phase(PG8_LAS unsigned char* lds, const Gemm g, const Sched& S, const Epi& E) {
    int tid_ = threadIdx.x; asm volatile("" : "+v"(tid_));
    const int tid = tid_, wid = __builtin_amdgcn_readfirstlane(tid >> 6), lane = tid & 63, wr = wid >> 2, wc = wid & 3, fr = lane & 15, fq = lane >> 4;
    const int K = g.K, nt = K / BK;
    unsigned voffA[2], voffB[2];
#pragma unroll
    for (int i = 0; i < 2; ++i) { int R, C; stage_rc(tid * 16 + i * 8192, R, C); const int Rb = Epi::PERM ? ((R & ~31) + perm32(R & 31)) : R;
        voffA[i] = (unsigned)(R * K + C) * 2u; voffB[i] = (unsigned)(Rb * K + C) * 2u; }
    const size_t kstep = (size_t)(BK * 2);
    const size_t hstep = (size_t)HALF * K * 2;
    const size_t tstep = 2 * hstep;
    const unsigned ldsw = (unsigned)wid * 1024u;
    const int aoff = lds_byte(wr * 64 + fr, fq * 8), boff = lds_byte(wc * 32 + fr, fq * 8);
#define PG8_SA(b, h) (((b) * 2 + (h)) * HTB)
#define PG8_SB(b, h) ((4 + (b) * 2 + (h)) * HTB)
#define PG8_STAGE(bufoff, gbase, voff) do { _Pragma("unroll") for (int _i = 0; _i < 2; ++_i) \
        __builtin_amdgcn_global_load_lds((const unsigned*)((const char*)(gbase) + (voff)[_i]), (PG8_LAS unsigned*)(lds + (bufoff) + ldsw + _i * 8192), 16, 0, 0); } while (0)
#define PG8_LDA(dst, b, h) do { _Pragma("unroll") for (int m = 0; m < 4; ++m) _Pragma("unroll") for (int k = 0; k < 2; ++k) dst[m][k] = *(const PG8_LAS bf16x8*)(lds + PG8_SA(b, h) + aoff + m * 2048 + k * 1024); } while (0)
#define PG8_LDB(dst, b, h) do { _Pragma("unroll") for (int n = 0; n < 2; ++n) _Pragma("unroll") for (int k = 0; k < 2; ++k) dst[n][k] = *(const PG8_LAS bf16x8*)(lds + PG8_SB(b, h) + boff + n * 2048 + k * 1024); } while (0)
#define PG8_MMA(ai, bj, At, Bt) do { __builtin_amdgcn_s_setprio(1); _Pragma("unroll") for (int m = 0; m < 4; ++m) _Pragma("unroll") for (int n = 0; n < 2; ++n) _Pragma("unroll") for (int k = 0; k < 2; ++k) \
        acc[ai][bj][m][n] = __builtin_amdgcn_mfma_f32_16x16x32_bf16(Bt[n][k], At[m][k], acc[ai][bj][m][n], 0, 0, 0); __builtin_amdgcn_s_setprio(0); } while (0)
#define PG8_WAIT_V(n) asm volatile("s_waitcnt vmcnt(" #n ")" ::: "memory")
#define PG8_WAIT_L(n) asm volatile("s_waitcnt lgkmcnt(" #n ")" ::: "memory")
#define PG8_BAR __builtin_amdgcn_s_barrier()
#define PG8_SCHED __builtin_amdgcn_sched_barrier(0)
    Unit cur, nxt; int ui = 0;
    if (!S.next(0, cur)) return;
    f32x4 acc[2][2][4][2];
#pragma unroll
    for (int a = 0; a < 2; ++a)
#pragma unroll
        for (int b = 0; b < 2; ++b)
#pragma unroll
            for (int m = 0; m < 4; ++m)
#pragma unroll
                for (int n = 0; n < 2; ++n) acc[a][b][m][n] = (f32x4){0.f, 0.f, 0.f, 0.f};
    bf16x8 At[4][2], B0[2][2], B1[2][2];
    const char* cA = (const char*)g.A + (size_t)cur.pm * tstep; const char* cB = (const char*)g.Bt + (size_t)cur.pn * tstep;
    S.a_ready(cur);
    if constexpr (SP2) {
        PG8_STAGE(PG8_SB(0, 0), cB, voffB); PG8_STAGE(PG8_SB(0, 1), cB + hstep, voffB); PG8_STAGE(PG8_SA(0, 0), cA, voffA); PG8_STAGE(PG8_SA(0, 1), cA + hstep, voffA);
        if (wr == 1) PG8_BAR;
        PG8_WAIT_V(2); PG8_BAR;
        PG8_STAGE(PG8_SB(1, 0), cB + kstep, voffB); PG8_STAGE(PG8_SA(1, 0), cA + kstep, voffA); PG8_STAGE(PG8_SB(1, 1), cB + hstep + kstep, voffB);
        PG8_WAIT_V(6); PG8_BAR;
    } else {
        PG8_STAGE(PG8_SB(0, 0), cB, voffB); PG8_STAGE(PG8_SA(0, 0), cA, voffA); PG8_STAGE(PG8_SB(0, 1), cB + hstep, voffB); PG8_STAGE(PG8_SA(0, 1), cA + hstep, voffA);
        if (wr == 1) PG8_BAR;
        PG8_WAIT_V(4); PG8_BAR;
        PG8_STAGE(PG8_SB(1, 0), cB + kstep, voffB); PG8_STAGE(PG8_SA(1, 0), cA + kstep, voffA); PG8_STAGE(PG8_SB(1, 1), cB + hstep + kstep, voffB);
        PG8_WAIT_V(6); PG8_BAR;
    }
    for (;;) {
        const bool has_next = S.next(ui + 1, nxt);
        const char* nA = has_next ? (const char*)g.A + (size_t)nxt.pm * tstep : cA; const char* nB = has_next ? (const char*)g.Bt + (size_t)nxt.pn * tstep : cB;
        for (int t = 0; t < nt; t += 2) {
            const bool last = (t == nt - 2);
            const char* a1 = cA + (size_t)(t + 1) * kstep;
            const char* a2 = last ? nA : cA + (size_t)(t + 2) * kstep; const char* b2 = last ? nB : cB + (size_t)(t + 2) * kstep;
            const char* a3 = a2 + kstep; const char* b3 = b2 + kstep;
            if (last && has_next) S.a_ready(nxt);
            if constexpr (SP2) {
            PG8_LDB(B0, 0, 0); PG8_LDB(B1, 0, 1); PG8_SCHED; PG8_LDA(At, 0, 0); PG8_STAGE(PG8_SA(1, 1), a1 + hstep, voffA);
            PG8_WAIT_V(8); PG8_WAIT_L(0); PG8_BAR; PG8_MMA(0, 0, At, B0); PG8_MMA(0, 1, At, B1); PG8_BAR; PG8_SCHED;
            PG8_LDA(At, 0, 1); PG8_STAGE(PG8_SB(0, 0), b2, voffB); PG8_STAGE(PG8_SB(0, 1), b2 + hstep, voffB); PG8_STAGE(PG8_SA(0, 0), a2, voffA);
            PG8_WAIT_V(8); PG8_WAIT_L(0); PG8_BAR; PG8_MMA(1, 0, At, B0); PG8_MMA(1, 1, At, B1); PG8_BAR; PG8_SCHED;
            PG8_LDB(B0, 1, 0); PG8_LDB(B1, 1, 1); PG8_SCHED; PG8_LDA(At, 1, 0); PG8_STAGE(PG8_SA(0, 1), a2 + hstep, voffA);
            PG8_WAIT_V(8); PG8_WAIT_L(0); PG8_BAR; PG8_MMA(0, 0, At, B0); PG8_MMA(0, 1, At, B1); PG8_BAR; PG8_SCHED;
            PG8_LDA(At, 1, 1); PG8_STAGE(PG8_SB(1, 0), b3, voffB); PG8_STAGE(PG8_SB(1, 1), b3 + hstep, voffB); PG8_STAGE(PG8_SA(1, 0), a3, voffA);
            PG8_WAIT_V(8); PG8_WAIT_L(0); PG8_BAR; PG8_MMA(1, 0, At, B0); PG8_MMA(1, 1, At, B1); PG8_BAR; PG8_SCHED;
            } else {
            PG8_LDB(B0, 0, 0); PG8_SCHED; PG8_LDA(At, 0, 0); PG8_STAGE(PG8_SA(1, 1), a1 + hstep, voffA);
            PG8_WAIT_L(8); PG8_BAR; PG8_WAIT_L(0); PG8_MMA(0, 0, At, B0); PG8_BAR; PG8_SCHED;
            PG8_LDB(B1, 0, 1); PG8_STAGE(PG8_SB(0, 0), b2, voffB);
            PG8_BAR; PG8_WAIT_L(0); PG8_MMA(0, 1, At, B1); PG8_BAR;
            PG8_LDA(At, 0, 1); PG8_STAGE(PG8_SA(0, 0), a2, voffA);
            PG8_BAR; PG8_WAIT_L(0); PG8_MMA(1, 0, At, B0); PG8_BAR; PG8_SCHED;
            PG8_STAGE(PG8_SB(0, 1), b2 + hstep, voffB);
            PG8_WAIT_V(6); PG8_BAR; PG8_MMA(1, 1, At, B1); PG8_BAR;
            PG8_LDB(B0, 1, 0); PG8_SCHED; PG8_LDA(At, 1, 0); PG8_STAGE(PG8_SA(0, 1), a2 + hstep, voffA);
            PG8_WAIT_L(8); PG8_BAR; PG8_WAIT_L(0); PG8_MMA(0, 0, At, B0); PG8_BAR; PG8_SCHED;
            PG8_LDB(B1, 1, 1); PG8_STAGE(PG8_SB(1, 0), b3, voffB);
            PG8_BAR; PG8_WAIT_L(0); PG8_MMA(0, 1, At, B1); PG8_BAR;
            PG8_LDA(At, 1, 1); PG8_STAGE(PG8_SA(1, 0), a3, voffA);
            PG8_BAR; PG8_WAIT_L(0); PG8_MMA(1, 0, At, B0); PG8_BAR; PG8_SCHED;
            PG8_STAGE(PG8_SB(1, 1), b3 + hstep, voffB);
            PG8_WAIT_V(6); PG8_BAR; PG8_MMA(1, 1, At, B1); PG8_BAR;
            }
        }
        if constexpr (ALIGN_EPI) { if (wr == 0) PG8_BAR; }
        if constexpr (!Epi::AFTER_DRAIN) { E(acc, cur, wr, wc, fr, fq); S.done(cur); }
        if (!has_next) break;
#pragma unroll
        for (int a = 0; a < 2; ++a)
#pragma unroll
            for (int b = 0; b < 2; ++b)
#pragma unroll
                for (int m = 0; m < 4; ++m)
#pragma unroll
                    for (int n = 0; n < 2; ++n) acc[a][b][m][n] = (f32x4){0.f, 0.f, 0.f, 0.f};
        cur = nxt; cA = nA; cB = nB; ++ui;
        if constexpr (ALIGN_EPI) { if (wr == 1) PG8_BAR; }
    }
    PG8_WAIT_V(0);
    if constexpr (!ALIGN_EPI) { if (wr == 0) PG8_BAR; }
    PG8_BAR;
    if constexpr (Epi::AFTER_DRAIN) { E.fused(acc, cur, wr, wc, fr, fq, lds, wid, lane); S.done(cur); }
#undef PG8_SA
#undef PG8_SB
#undef PG8_STAGE
#undef PG8_LDA
#undef PG8_LDB
#undef PG8_MMA
#undef PG8_WAIT_V
#undef PG8_WAIT_L
#undef PG8_BAR
#undef PG8_SCHED
}
}

#ifndef PG8_SP2
#define PG8_SP2 true
#endif
#ifndef PG8_ALIGN
#define PG8_ALIGN true
#endif
#define GAS __attribute__((address_space(1)))
#define LAS __attribute__((address_space(3)))
typedef unsigned short bf16;
typedef unsigned v4u __attribute__((ext_vector_type(4)));
typedef float f32x4 __attribute__((ext_vector_type(4)));
typedef short bf16x8 __attribute__((ext_vector_type(8)));
typedef GAS unsigned gu32;
typedef GAS unsigned long long gu64;
#define RLX_AGENT __ATOMIC_RELAXED, __HIP_MEMORY_SCOPE_AGENT
#define LDS_WAIT() asm volatile("s_waitcnt lgkmcnt(0)" ::: "memory")
#define VM_WAIT() asm volatile("s_waitcnt vmcnt(0)" ::: "memory")
__device__ __forceinline__ unsigned long long rt() { return __builtin_amdgcn_s_memrealtime(); }
__device__ __forceinline__ unsigned f2bf(float f) { unsigned u = __builtin_bit_cast(unsigned, f); return (u + 0x7fffu + ((u >> 16) & 1u)) >> 16; }
__device__ __forceinline__ unsigned pk2(float lo, float hi) { return f2bf(lo) | (f2bf(hi) << 16); }

#define XB_TMO      128
#define XB_XCNT(j)  (256  + 64 * (j))
#define XB_XSUB(j)  (1280 + 64 * (j))
#define XB_XGEN(j)  (2304 + 64 * (j))
#define XB_TOP      3328
#define XB_TOPGEN   3392
#define XCD_BAR_WORDS 3456
#define XB_SPIN_CAP (1u << 18)

__device__ __forceinline__ unsigned xb_ld(unsigned* p)              { return __hip_atomic_load(p, __ATOMIC_RELAXED, __HIP_MEMORY_SCOPE_AGENT); }
__device__ __forceinline__ unsigned xb_add(unsigned* p, unsigned v) { return __hip_atomic_fetch_add(p, v, __ATOMIC_RELAXED, __HIP_MEMORY_SCOPE_AGENT); }
__device__ __forceinline__ unsigned xb_xcc_id() { return (unsigned)__builtin_amdgcn_s_getreg((3 << 11) | 20) & 0xFu; }
#define XB_SPIN(cond, bar) do { unsigned _sp = 0; while (cond) { __builtin_amdgcn_s_sleep(1); \
    if ((++_sp & 255u) == 0u) { if (xb_ld(&(bar)[XB_TMO])) break; if (_sp > XB_SPIN_CAP) { atomicAdd(&(bar)[XB_TMO], 1u); break; } } } } while (0)

struct XcdBarrier {
    unsigned* bar; unsigned x;
    volatile LAS unsigned* st;
};

__device__ __forceinline__ XcdBarrier xcd_barrier_post(unsigned* bar, volatile LAS unsigned* st) {
    XcdBarrier b; b.bar = bar; b.x = xb_xcc_id(); b.st = st;
    if (threadIdx.x == 0) (void)xb_add(&bar[XB_XCNT(b.x)], 1u);
    return b;
}
__device__ __forceinline__ void xcd_barrier_complete(unsigned* bar, unsigned x, unsigned& nloc, unsigned& nx) {
    const unsigned G = gridDim.x * gridDim.y * gridDim.z;
    unsigned sum, cnt, mine, sp = 0u;
    for (;;) {
        sum = 0u; cnt = 0u; mine = 0u;
#pragma unroll
        for (unsigned j = 0; j < 16; ++j) { const unsigned c = xb_ld(&bar[XB_XCNT(j)]); sum += c; cnt += (c > 0u) ? 1u : 0u; mine = (j == x) ? c : mine; }
        if (sum == G) break;
        __builtin_amdgcn_s_sleep(1);
        if ((++sp & 255u) == 0u) { if (xb_ld(&bar[XB_TMO])) break; if (sp > XB_SPIN_CAP) { atomicAdd(&bar[XB_TMO], 1u); break; } }
    }
    nloc = mine > 0u ? mine : 1u; nx = cnt > 0u ? cnt : 1u;
}

__device__ __forceinline__ void xcd_barrier(const XcdBarrier& b) {
    asm volatile("s_waitcnt vmcnt(0)" ::: "memory");
    __syncthreads();
    if (threadIdx.x == 0) {
        unsigned* bar = b.bar;
        __builtin_amdgcn_s_waitcnt(0);
        unsigned nloc = b.st[0], nx = b.st[1];
        if (nloc == 0u) { xcd_barrier_complete(bar, b.x, nloc, nx); b.st[0] = nloc; b.st[1] = nx; }
        const unsigned old = xb_add(&bar[XB_XSUB(b.x)], 1u);
        const unsigned gen = old / nloc;
        if (old + 1u == (gen + 1u) * nloc) {
            __builtin_amdgcn_fence(__ATOMIC_RELEASE, "agent");
            asm volatile("s_waitcnt vmcnt(0)" ::: "memory");
            const unsigned og = xb_add(&bar[XB_TOP], 1u);
            const unsigned tg = og / nx;
            if (og + 1u == (tg + 1u) * nx) xb_add(&bar[XB_TOPGEN], 1u);
            else XB_SPIN(xb_ld(&bar[XB_TOPGEN]) == tg, bar);
            __builtin_amdgcn_fence(__ATOMIC_ACQUIRE, "agent");
            xb_add(&bar[XB_XGEN(b.x)], 1u);
            asm volatile("s_waitcnt vmcnt(0)" ::: "memory");
        } else {
            XB_SPIN(xb_ld(&bar[XB_XGEN(b.x)]) == gen, bar);
            __builtin_amdgcn_fence(__ATOMIC_ACQUIRE, "agent");
            asm volatile("s_waitcnt vmcnt(0)" ::: "memory");
        }
    }
    __syncthreads();
}
constexpr int NWAVES = 8;
constexpr int BATCH = 2, SEQ = 8192, D = 1024, M = BATCH * SEQ, NH = 16, HD = 64, MB = 256, NBLK = SEQ / MB;
constexpr int DFF = 2816, NGU = 2 * DFF;
constexpr int MH = 8, DK = 64, DV = 128, LCH = 64, NCH = SEQ / LCH, NUNIT = BATCH * MH * NCH;
constexpr int NIN = 3072, NINW = 3088;
constexpr float RMS_EPS = 1e-6f, SOFTCAP = 15.0f, LOG2E = 1.4426950408889634f;

constexpr size_t MiB = 1u << 20;
constexpr size_t WS_CTL = 0, CTL_ZERO_BYTES = 1 * MiB;
constexpr size_t WS_KMEAN = 512 * 1024;
constexpr size_t WS_SSQ = 1 * MiB;
constexpr size_t WS_BIG = 5 * MiB;
constexpr size_t WS_SEL = 6 * MiB;
constexpr size_t WS_ROPE = 7 * MiB;
constexpr size_t WS_WG = 7 * MiB + 512 * 1024;
constexpr size_t WS_WQKV = 8 * MiB, WS_WO = 14 * MiB, WS_WIN = 16 * MiB, WS_WOUT = 22 * MiB, WS_WGU = 24 * MiB  , WS_WD = 46 * MiB  ;
constexpr size_t WS_NLOC = 57 * MiB;
constexpr size_t WS_SCAL = 57 * MiB + 512 * 1024;
constexpr size_t WS_AB = 64 * MiB;
constexpr size_t WS_Q = 96 * MiB, WS_K = 128 * MiB, WS_V = 160 * MiB;
constexpr size_t WS_HB1 = 96 * MiB;
constexpr size_t WS_ACT = 128 * MiB;
constexpr size_t WS_MQ = 96 * MiB, WS_MK = 112 * MiB, WS_MV = 128 * MiB, WS_OG = 160 * MiB, WS_CLOC = 192 * MiB;
constexpr size_t WS_Y = 224 * MiB;
constexpr size_t WS_END = 256 * MiB;
constexpr int CW_BAR = 4096;

constexpr int RING_OFF = 0, RING_BYTES = 131072;
constexpr int LDSCTL_OFF = RING_BYTES, MISC_OFF = LDSCTL_OFF + 320;
constexpr int LDS_BYTES = 163840;
static_assert(MISC_OFF + 128 <= LDS_BYTES, "LDS map");

__device__ __forceinline__ float bf2f(unsigned short h) { return __builtin_bit_cast(float, (unsigned)h << 16); }
__device__ __forceinline__ float bflo(unsigned w) { return __builtin_bit_cast(float, w << 16); }
__device__ __forceinline__ float bfhi(unsigned w) { return __builtin_bit_cast(float, w & 0xffff0000u); }
__device__ __forceinline__ float wave_sum(float v) {
#pragma unroll
    for (int o = 1; o < 64; o <<= 1) v += __shfl_xor(v, o);
    return v;
}
__device__ __forceinline__ float wave_max(float v) {
#pragma unroll
    for (int o = 1; o < 64; o <<= 1) v = fmaxf(v, __shfl_xor(v, o));
    return v;
}
__device__ __forceinline__ float fexp(float x) { return __builtin_amdgcn_exp2f(x * LOG2E); }

__device__ __forceinline__ int ltid() { int t = threadIdx.x; asm volatile("" : "+v"(t)); return t; }
struct Frame {
    LAS unsigned char* lds;
    volatile LAS unsigned* MISC;
    gu32* ctl;
    int wave, vcu, G;
};

template <int MODE> __device__ __forceinline__ int src_col(int n) {
    if (MODE == 1) {
        if (n >= 2048) return n;
        const int s = n & 63; int d = s;
        if (s < 16) d = (s & 3) | ((s & 4) << 1) | ((s & 8) >> 1);
        return (n & ~63) | d;
    }
    if (MODE == 2) { const int pn = n >> 8, r = n & 255; return (r < 128) ? pn * 128 + r : DFF + pn * 128 + (r - 128); }
    return n;
}
template <int MODE> __device__ __forceinline__ void p0_transpose_item(const float* W, int K, int Nsrc, int Nout, const float* kscale, bf16* WT, int item, int lane) {
    const int nblk = Nout / 64, kb = item / nblk, nb = item - kb * nblk, k0 = 32 * kb, n = 64 * nb + lane;
    const float* wp = W + (size_t)k0 * Nsrc + src_col<MODE>(n);
    float v[32];
#pragma unroll
    for (int i = 0; i < 32; ++i) v[i] = __builtin_nontemporal_load(wp + (size_t)i * Nsrc);
    if (kscale) {
#pragma unroll
        for (int i = 0; i < 32; ++i) v[i] *= kscale[k0 + i]; }
    GAS v4u* op = (GAS v4u*)(WT + (size_t)n * K + k0);
#pragma unroll
    for (int c = 0; c < 4; ++c) { v4u o; o.x = pk2(v[8 * c], v[8 * c + 1]); o.y = pk2(v[8 * c + 2], v[8 * c + 3]); o.z = pk2(v[8 * c + 4], v[8 * c + 5]); o.w = pk2(v[8 * c + 6], v[8 * c + 7]); op[c] = o; }
}

struct Ptrs {
    const float *x, *attn_norm, *w_qkv, *w_o, *mlstm_norm, *w_in, *b_gates, *head_norm, *w_out, *ffn_norm, *w_gu, *w_down, *final_norm;
    float* out; unsigned char* ws;
};

__device__ __forceinline__ void p0_prologue(Frame& F, const Ptrs& P) {
    const int tid_l = ltid(), lane_l = tid_l & 63; (void)lane_l;
    unsigned char* ws = P.ws;
    const int gw = F.vcu * NWAVES + F.wave, NGW = F.G * NWAVES;
    constexpr int I_QKV = (D / 32) * (3 * D / 64), I_O = (D / 32) * (D / 64), I_IN = (D / 32) * (NIN / 64), I_GU = (D / 32) * (NGU / 64), I_DN = (DFF / 32) * (D / 64);
    constexpr int NITEMS = I_QKV + I_O + I_IN + I_O + 2 * I_GU + 2 * I_DN;
    for (int it = gw; it < NITEMS; it += NGW) {
        int r = it;
        if (r < I_QKV) { p0_transpose_item<1>(P.w_qkv, D, 3 * D, 3 * D, P.attn_norm, (bf16*)(ws + WS_WQKV), r, lane_l); continue; } r -= I_QKV;
        if (r < I_O) { p0_transpose_item<0>(P.w_o, D, D, D, nullptr, (bf16*)(ws + WS_WO), r, lane_l); continue; } r -= I_O;
        if (r < I_IN) { p0_transpose_item<0>(P.w_in, D, NINW, NIN, P.mlstm_norm, (bf16*)(ws + WS_WIN), r, lane_l); continue; } r -= I_IN;
        if (r < I_O) { p0_transpose_item<0>(P.w_out, D, D, D, nullptr, (bf16*)(ws + WS_WOUT), r, lane_l); continue; } r -= I_O;
        if (r < 2 * I_GU) { const int l = r / I_GU; p0_transpose_item<2>(P.w_gu + (size_t)l * D * NGU, D, NGU, NGU, P.ffn_norm + l * D, (bf16*)(ws + WS_WGU) + (size_t)l * NGU * D, r % I_GU, lane_l); continue; } r -= 2 * I_GU;
        { const int l = r / I_DN; p0_transpose_item<0>(P.w_down + (size_t)l * DFF * D, DFF, D, D, nullptr, (bf16*)(ws + WS_WD) + (size_t)l * D * DFF, r % I_DN, lane_l); }
    }
    const int gt = F.vcu * (NWAVES * 64) + tid_l, NGT = F.G * NWAVES * 64;
    { bf16* WG = (bf16*)(ws + WS_WG); for (int i = gt; i < 16 * D; i += NGT) { const int j = i >> 10, k = i & 1023; WG[i] = (bf16)f2bf(P.mlstm_norm[k] * P.w_in[(size_t)k * NINW + NIN + j]); } }
    { float* rope = (float*)(ws + WS_ROPE);
      for (int i = gt; i < SEQ * 8; i += NGT) { const int pos = i >> 3, j = i & 7;
          const float invf = j == 0 ? 1.0f : j == 1 ? 0.1939227432012558f : j == 2 ? 0.03760603070259094f : j == 3 ? 0.007292664609849453f : j == 4 ? 0.0014142135623842478f : j == 5 ? 0.00027424818836152554f : j == 6 ? 5.3182957344688475e-05f : 1.0313385246263351e-05f;
          const float ang = __fmul_rn((float)pos, invf);
          const double rev = (double)ang * 0.15915494309189533577; const float fr = (float)(rev - __builtin_rint(rev));
          rope[2 * i] = __builtin_amdgcn_cosf(fr); rope[2 * i + 1] = __builtin_amdgcn_sinf(fr); } }
    { bf16* xb = (bf16*)(ws + WS_AB); float* ssq0 = (float*)(ws + WS_SSQ);
      for (int m = gw; m < M; m += NGW) {
          const GAS f32x4* xr = (const GAS f32x4*)(P.x + (size_t)m * D) + lane_l; f32x4 v[4]; float s = 0.f;
#pragma unroll
          for (int j = 0; j < 4; ++j) { v[j] = __builtin_nontemporal_load(xr + 64 * j); s += (v[j].x * v[j].x + v[j].y * v[j].y) + (v[j].z * v[j].z + v[j].w * v[j].w); }
          s = wave_sum(s);
          GAS unsigned long long* o8 = (GAS unsigned long long*)(xb + (size_t)m * D) + lane_l;
#pragma unroll
          for (int j = 0; j < 4; ++j) o8[64 * j] = (unsigned long long)pk2(v[j].x, v[j].y) | ((unsigned long long)pk2(v[j].z, v[j].w) << 32);
          if (lane_l < 16) ssq0[(size_t)m * 16 + lane_l] = (lane_l == 0) ? s : 0.f;
      } }
}

namespace moba {
typedef short bf16x8 __attribute__((ext_vector_type(8)));
typedef short s16x4 __attribute__((ext_vector_type(4)));
typedef float f32x16 __attribute__((ext_vector_type(16)));
typedef unsigned u32x4 __attribute__((ext_vector_type(4)));
typedef LAS const char* lds_cptr;
typedef short v4i16_t __attribute__((ext_vector_type(4)));
typedef float f32x2_t __attribute__((ext_vector_type(2))); typedef __bf16 bf16x2_t __attribute__((ext_vector_type(2)));
constexpr int THRL = 8;
constexpr int L_K = 0, L_V = 32768, L_WS = 65536  , L_STG = 73728  , L_QL = 106496  , L_MISC = 122880;
constexpr size_t WS_SEGCNT = 58 * MiB;
constexpr size_t WS_P2 = 192 * MiB;
constexpr size_t WS_PLSE = 224 * MiB;
constexpr size_t WS_SEGLIST = 232 * MiB;
constexpr int CW_TOT = 12288;
constexpr int LCAP = 8192;
constexpr int CW_Q3 = 8192;
constexpr size_t PART_STRIDE = (size_t)M * D * 2;

__device__ __forceinline__ int crow(int r, int hi) { return (r & 3) + 8 * (r >> 2) + 4 * hi; }
__device__ __forceinline__ void glds16(const void* gsrc, unsigned lds_dst) { unsigned keep;
    asm volatile("s_mov_b32 %0, m0\n\ts_mov_b32 m0, %2\n\ts_nop 0\n\tglobal_load_lds_dwordx4 %1, off\n\ts_mov_b32 m0, %0" : "=&s"(keep) : "v"(gsrc), "s"(lds_dst) : "memory"); }
__device__ __forceinline__ unsigned cvtpk_s(float lo, float hi) { f32x2_t v = {lo, hi}; bf16x2_t b = __builtin_convertvector(v, bf16x2_t); return __builtin_bit_cast(unsigned, b); }
__device__ __forceinline__ s16x4 vtr(lds_cptr p) { return __builtin_bit_cast(s16x4, __builtin_amdgcn_ds_read_tr16_b64_v4i16((LAS v4i16_t*)p)); }
#define MOBA_MX3(a, b, c) __builtin_fmaxf(__builtin_fmaxf((a), (b)), (c))
__device__ __forceinline__ float rowmax(const f32x16& p0, const f32x16& p1) {
    float a = MOBA_MX3(p0[0], p0[1], p1[0]), b = MOBA_MX3(p0[2], p0[3], p1[1]); a = MOBA_MX3(a, p1[2], p1[3]);
#pragma unroll
    for (int r = 4; r < 16; r += 4) { a = MOBA_MX3(a, p0[r], p0[r + 1]); b = MOBA_MX3(b, p0[r + 2], p0[r + 3]); a = MOBA_MX3(a, p1[r], p1[r + 1]); b = MOBA_MX3(b, p1[r + 2], p1[r + 3]); }
    float m = __builtin_fmaxf(a, b); auto rr = __builtin_amdgcn_permlane32_swap(__float_as_uint(m), __float_as_uint(m), false, false);
    return __builtin_fmaxf(__uint_as_float(rr[0]), __uint_as_float(rr[1])); }
__device__ __forceinline__ float halves_sum(float v) { auto rr = __builtin_amdgcn_permlane32_swap(__float_as_uint(v), __float_as_uint(v), false, false); return __uint_as_float(rr[0]) + __uint_as_float(rr[1]); }
#define MOBA_MFMA(a, b, c) __builtin_amdgcn_mfma_f32_32x32x16_bf16(a, b, c, 0, 0, 0)

__device__ __forceinline__ void stage_kv(const bf16* K, const bf16* V, int b, int h, int j, LAS unsigned char* lds, int wid, int lane) {
    const size_t row0 = (size_t)(b * NH + h) * SEQ + (size_t)j * MB;
    const bf16* ksrc = K + (row0 + lane) * HD + wid * 8;
    const bf16* vsrc = V + (row0 + 16 * (wid & 3) + (lane >> 2)) * HD + (wid >> 2) * 32 + (lane & 3) * 8;
    const unsigned kdst = (unsigned)(uintptr_t)(lds + L_K) + wid * 1024, vdst = (unsigned)(uintptr_t)(lds + L_V) + wid * 1024;
#pragma unroll
    for (int t = 0; t < 4; ++t) { glds16(ksrc + (size_t)t * 64 * HD, (unsigned)__builtin_amdgcn_readfirstlane(kdst + t * 8192)); glds16(vsrc + (size_t)t * 64 * HD, (unsigned)__builtin_amdgcn_readfirstlane(vdst + t * 8192)); }
}
__device__ __forceinline__ void stage_wait() { asm volatile("s_waitcnt vmcnt(0) lgkmcnt(0)\n\ts_barrier" ::: "memory"); }

template <bool CAUSAL> __device__ __forceinline__ void wave_block(const bf16x8 (&qr)[4], lds_cptr kbase, lds_cptr vbase, int ntiles, int qrel, LAS float* wsf, int lane, f32x16& o0, f32x16& o1, float& mhat, float& lsum) {
    const int r32 = lane & 31, hi = lane >> 5;
    const lds_cptr kp0 = kbase + hi * 1024 + r32 * 16;
    const lds_cptr vp0 = vbase + ((lane >> 4) & 1) * 32 + (lane & 3) * 8 + (4 * hi + ((lane & 15) >> 2)) * 64;
    o0 = f32x16{}; o1 = f32x16{}; mhat = 0.f; lsum = 0.f;
    bf16x8 kf[8];
#define MOBA_KLOAD(kt_) do { const lds_cptr kp_ = kp0 + (kt_) * 8192; _Pragma("unroll") for (int d0 = 0; d0 < 4; ++d0) { kf[2 * d0] = *(const LAS bf16x8*)(kp_ + d0 * 2048); kf[2 * d0 + 1] = *(const LAS bf16x8*)(kp_ + d0 * 2048 + 512); } } while (0)
    MOBA_KLOAD(0);
#pragma unroll
    for (int kt = 0; kt < 4; ++kt) {
        if (kt < ntiles) {
            const lds_cptr vp = vp0 + kt * 8192;
            s16x4 vlo[8], vhi[8];
#pragma unroll
            for (int i = 0; i < 8; ++i) { vlo[i] = vtr(vp + ((i >> 2) * 4096 + (i & 3) * 1024)); vhi[i] = vtr(vp + ((i >> 2) * 4096 + (i & 3) * 1024 + 512)); }
            f32x16 negm;
#pragma unroll
            for (int r = 0; r < 16; ++r) negm[r] = 0.f - mhat;
            f32x16 c0 = MOBA_MFMA(kf[0], qr[0], negm), c1 = MOBA_MFMA(kf[1], qr[0], negm);
            c0 = MOBA_MFMA(kf[2], qr[1], c0); c1 = MOBA_MFMA(kf[3], qr[1], c1);
            c0 = MOBA_MFMA(kf[4], qr[2], c0); c1 = MOBA_MFMA(kf[5], qr[2], c1);
            c0 = MOBA_MFMA(kf[6], qr[3], c0); c1 = MOBA_MFMA(kf[7], qr[3], c1);
            __builtin_amdgcn_sched_barrier(0);
            if (kt + 1 < 4 && kt + 1 < ntiles) MOBA_KLOAD(kt + 1);
            if (CAUSAL && kt == ntiles - 1) { int rel = qrel - 64 * kt - 4 * hi; asm volatile("" : "+v"(rel));
#pragma unroll
                for (int r = 0; r < 16; ++r) { const int kv = (r & 3) + 8 * (r >> 2);
                    c0[r] = __builtin_fminf(c0[r], __builtin_bit_cast(float, 0x7F800000u | ((unsigned)((rel - kv) >> 31) & 0x80000000u)));
                    c1[r] = __builtin_fminf(c1[r], __builtin_bit_cast(float, 0x7F800000u | ((unsigned)((rel - kv - 32) >> 31) & 0x80000000u))); } }
            const float rm = rowmax(c0, c1);
            bool resc = false; float dl = 0.f;
            if (kt == 0) { dl = rm; mhat = rm; }
            else if (__any(rm > (float)THRL)) { dl = __builtin_fmaxf(rm, 0.f); mhat += dl; const float f = __builtin_amdgcn_exp2f(-dl); lsum *= f; if (hi == 0) wsf[r32] = f; resc = true; }
            float sacc = 0.f;
#pragma unroll
            for (int r = 0; r < 16; ++r) { c0[r] = __builtin_amdgcn_exp2f(c0[r] - dl); c1[r] = __builtin_amdgcn_exp2f(c1[r] - dl); sacc += c0[r] + c1[r]; }
            lsum += sacc;
            if (resc) { asm volatile("s_waitcnt lgkmcnt(0)" ::: "memory");
#pragma unroll
                for (int r = 0; r < 16; ++r) { const float f = wsf[crow(r, hi)]; o0[r] *= f; o1[r] *= f; } }
            u32x4 pw0, pw1, pw2, pw3;
            pw0 = (u32x4){cvtpk_s(c0[0], c0[1]), cvtpk_s(c0[2], c0[3]), cvtpk_s(c0[4], c0[5]), cvtpk_s(c0[6], c0[7])}; pw1 = (u32x4){cvtpk_s(c0[8], c0[9]), cvtpk_s(c0[10], c0[11]), cvtpk_s(c0[12], c0[13]), cvtpk_s(c0[14], c0[15])};
            pw2 = (u32x4){cvtpk_s(c1[0], c1[1]), cvtpk_s(c1[2], c1[3]), cvtpk_s(c1[4], c1[5]), cvtpk_s(c1[6], c1[7])}; pw3 = (u32x4){cvtpk_s(c1[8], c1[9]), cvtpk_s(c1[10], c1[11]), cvtpk_s(c1[12], c1[13]), cvtpk_s(c1[14], c1[15])};
            __builtin_amdgcn_sched_barrier(0);
#define MOBA_PAF(k) __builtin_bit_cast(bf16x8, pw##k)
#define MOBA_VFR(i) (bf16x8){vlo[i][0], vlo[i][1], vlo[i][2], vlo[i][3], vhi[i][0], vhi[i][1], vhi[i][2], vhi[i][3]}
            o0 = MOBA_MFMA(MOBA_PAF(0), MOBA_VFR(0), o0); o1 = MOBA_MFMA(MOBA_PAF(0), MOBA_VFR(4), o1); o0 = MOBA_MFMA(MOBA_PAF(1), MOBA_VFR(1), o0); o1 = MOBA_MFMA(MOBA_PAF(1), MOBA_VFR(5), o1);
            o0 = MOBA_MFMA(MOBA_PAF(2), MOBA_VFR(2), o0); o1 = MOBA_MFMA(MOBA_PAF(2), MOBA_VFR(6), o1); o0 = MOBA_MFMA(MOBA_PAF(3), MOBA_VFR(3), o0); o1 = MOBA_MFMA(MOBA_PAF(3), MOBA_VFR(7), o1);
#undef MOBA_PAF
#undef MOBA_VFR
            __builtin_amdgcn_sched_barrier(0);
        }
    }
#undef MOBA_KLOAD
    lsum = halves_sum(lsum);
}
__device__ __forceinline__ void stage_o(const f32x16& o0, const f32x16& o1, float lsum, LAS float* wsf, LAS unsigned short* stg, int lane) {
    const int r32 = lane & 31, hi = lane >> 5;
    if (hi == 0) wsf[32 + r32] = __builtin_amdgcn_rcpf(lsum);
    asm volatile("s_waitcnt lgkmcnt(0)" ::: "memory");
#pragma unroll
    for (int r = 0; r < 16; ++r) { const int orow = crow(r, hi); const float rl = wsf[32 + orow];
        stg[orow * 64 + r32] = (unsigned short)f2bf(o0[r] * rl); stg[orow * 64 + 32 + r32] = (unsigned short)f2bf(o1[r] * rl); }
    asm volatile("s_waitcnt lgkmcnt(0)" ::: "memory");
}

__device__ __forceinline__ bool better(float g, int n, float gk, int ik) { return g > gk || (g == gk && n < ik); }
__device__ __forceinline__ void ins3(float g, int n, float& g1, int& i1, float& g2, int& i2, float& g3, int& i3) {
    const bool b1 = better(g, n, g1, i1), b2 = better(g, n, g2, i2), b3 = better(g, n, g3, i3);
    const float n3 = b2 ? g2 : (b3 ? g : g3); const int m3 = b2 ? i2 : (b3 ? n : i3);
    const float n2 = b1 ? g1 : (b2 ? g : g2); const int m2 = b1 ? i1 : (b2 ? n : i2);
    g1 = b1 ? g : g1; i1 = b1 ? n : i1; g2 = n2; i2 = m2; g3 = n3; i3 = m3;
}
}

__device__ __forceinline__ void p2_gating(Frame& F, const Ptrs& P) {
    using namespace moba;
    const int tid_l = ltid(), lane_l = tid_l & 63; (void)lane_l;
    const bf16* Q = (const bf16*)(P.ws + WS_Q); const float* kmean = (const float*)(P.ws + WS_KMEAN);
    unsigned short* seglist = (unsigned short*)(P.ws + WS_SEGLIST);
    LAS unsigned char* himg = F.lds + RING_OFF; LAS unsigned char* limg = himg + 4096; LAS unsigned* cntL = (LAS unsigned*)(limg + 4096);
    const int tid = tid_l, lane = lane_l, r32 = lane & 31, hi = lane >> 5, wid = F.wave;
    for (int unit = F.vcu; unit < BATCH * NH * NBLK; unit += F.G) {
        const int bh = unit >> 5, cur = unit & 31, b = bh >> 4, h = bh & 15;
        if (cur == 0) continue;
        { const int n = tid >> 4, c4 = (tid & 15) * 4; f32x4 x = (f32x4){0.f, 0.f, 0.f, 0.f};
          if (n < cur) x = *(const f32x4*)(kmean + (size_t)(b * NBLK + n) * D + h * HD + c4);
          const unsigned h01 = cvtpk_s(x.x, x.y), h23 = cvtpk_s(x.z, x.w);
          const unsigned l01 = cvtpk_s(x.x - bflo(h01), x.y - bfhi(h01)), l23 = cvtpk_s(x.z - bflo(h23), x.w - bfhi(h23));
          const int off = (c4 >> 3) * 512 + n * 16 + (c4 & 7) * 2;
          typedef unsigned u32x2v __attribute__((ext_vector_type(2)));
          *(LAS u32x2v*)(himg + off) = (u32x2v){h01, h23}; *(LAS u32x2v*)(limg + off) = (u32x2v){l01, l23};
          if (tid < 32) cntL[tid] = 0u; }
        LDS_WAIT(); __syncthreads();
        const int tl = cur * MB + wid * 32 + r32;
        float g1 = -INFINITY, g2 = -INFINITY, g3 = -INFINITY; int i1 = 255, i2 = 255, i3 = 255;
        {
            const bf16* qp = Q + ((size_t)(b * NH + h) * SEQ + tl) * HD + hi * 8;
            f32x16 g = f32x16{};
#pragma unroll
            for (int d0 = 0; d0 < 4; ++d0) { const bf16x8 qr = *(const bf16x8*)(qp + d0 * 16);
                const bf16x8 ah = *(const LAS bf16x8*)(himg + (2 * d0 + hi) * 512 + r32 * 16), al = *(const LAS bf16x8*)(limg + (2 * d0 + hi) * 512 + r32 * 16);
                g = MOBA_MFMA(ah, qr, g); g = MOBA_MFMA(al, qr, g); }
            int nb = 4 * hi; asm volatile("" : "+v"(nb));
#pragma unroll
            for (int r = 0; r < 16; ++r) { const int n = nb + (r & 3) + 8 * (r >> 2); const float gv = (n < cur) ? g[r] : -INFINITY; ins3(gv, (n < cur) ? n : 255, g1, i1, g2, i2, g3, i3); }
        }
        {
            const float og1 = __uint_as_float(__builtin_amdgcn_permlane32_swap(__float_as_uint(g1), __float_as_uint(g1), false, false)[hi ? 0 : 1]);
            const float og2 = __uint_as_float(__builtin_amdgcn_permlane32_swap(__float_as_uint(g2), __float_as_uint(g2), false, false)[hi ? 0 : 1]);
            const float og3 = __uint_as_float(__builtin_amdgcn_permlane32_swap(__float_as_uint(g3), __float_as_uint(g3), false, false)[hi ? 0 : 1]);
            const int oi1 = (int)__builtin_amdgcn_permlane32_swap((unsigned)i1, (unsigned)i1, false, false)[hi ? 0 : 1];
            const int oi2 = (int)__builtin_amdgcn_permlane32_swap((unsigned)i2, (unsigned)i2, false, false)[hi ? 0 : 1];
            const int oi3 = (int)__builtin_amdgcn_permlane32_swap((unsigned)i3, (unsigned)i3, false, false)[hi ? 0 : 1];
            if (oi1 != 255) ins3(og1, oi1, g1, i1, g2, i2, g3, i3);
            if (oi2 != 255) ins3(og2, oi2, g1, i1, g2, i2, g3, i3);
            if (oi3 != 255) ins3(og3, oi3, g1, i1, g2, i2, g3, i3);
        }
        unsigned ps1 = 0, ps2 = 0, ps3 = 0;
        if (hi == 0) {
            if (i1 != 255) ps1 = __hip_atomic_fetch_add(cntL + i1, 1u, __ATOMIC_RELAXED, __HIP_MEMORY_SCOPE_WORKGROUP);
            if (i2 != 255) ps2 = __hip_atomic_fetch_add(cntL + i2, 1u, __ATOMIC_RELAXED, __HIP_MEMORY_SCOPE_WORKGROUP);
            if (i3 != 255) ps3 = __hip_atomic_fetch_add(cntL + i3, 1u, __ATOMIC_RELAXED, __HIP_MEMORY_SCOPE_WORKGROUP);
        }
        LDS_WAIT(); __syncthreads();
        if (tid < cur) { const unsigned cn = cntL[tid]; cntL[32 + tid] = cn ? __hip_atomic_fetch_add(F.ctl + CW_TOT + bh * 32 + tid, cn, RLX_AGENT) : 0u; }
        LDS_WAIT(); __syncthreads();
        if (hi == 0) {
            if (i1 != 255) seglist[(size_t)(bh * 32 + i1) * LCAP + cntL[32 + i1] + ps1] = (unsigned short)tl;
            if (i2 != 255) seglist[(size_t)(bh * 32 + i2) * LCAP + cntL[32 + i2] + ps2] = (unsigned short)(tl | (1 << 13));
            if (i3 != 255) seglist[(size_t)(bh * 32 + i3) * LCAP + cntL[32 + i3] + ps3] = (unsigned short)(tl | (2 << 13));
        }
        LDS_WAIT(); __syncthreads();
    }
}

__device__ __forceinline__ void p3_gathered(Frame& F, const Ptrs& P, int pass = 0) {
    const int tid_l = ltid(), lane_l = tid_l & 63; (void)lane_l;
    using namespace moba;
    unsigned char* ws = P.ws;
    const bf16* Q = (const bf16*)(ws + WS_Q); const bf16* K = (const bf16*)(ws + WS_K); const bf16* V = (const bf16*)(ws + WS_V);
    const unsigned short* seglist = (const unsigned short*)(ws + WS_SEGLIST);
    float* plse = (float*)(ws + WS_PLSE);
    LAS unsigned short* ql = (LAS unsigned short*)(F.lds + L_QL); LAS unsigned* misc = (LAS unsigned*)(F.lds + L_MISC);
    LAS float* wsf = (LAS float*)(F.lds + L_WS) + F.wave * 256; LAS unsigned short* stg = (LAS unsigned short*)(F.lds + L_STG) + F.wave * 2048;
    const int tid = tid_l, lane = lane_l, wid = F.wave, r32 = lane & 31, hi = lane >> 5;
    if (tid == 0) misc[0] = __hip_atomic_fetch_add(F.ctl + CW_Q3 + 64 * pass, 1u, RLX_AGENT);
    LDS_WAIT(); __syncthreads();
    for (;;) {
        const int item = (int)misc[0];
        if (item >= 31 * 32) break;
        const int j = item >> 5, bh = item & 31, b = bh >> 4, h = bh & 15;
        stage_kv(K, V, b, h, j, F.lds, wid, lane);
        const int n = (int)__hip_atomic_load(F.ctl + CW_TOT + bh * 32 + j, RLX_AGENT);
        unsigned nxt = 0; if (tid == 0) nxt = __hip_atomic_fetch_add(F.ctl + CW_Q3 + 64 * pass, 1u, RLX_AGENT);
        const unsigned short* sp = seglist + (size_t)(bh * 32 + j) * LCAP;
        const int ngroups = (n + 31) >> 5;
        bf16x8 qn[4];
        if (wid < ngroups) { const int idx = wid * 32 + r32; const unsigned e = sp[idx < n ? idx : n - 1]; const bf16* qp = Q + ((size_t)(b * NH + h) * SEQ + (int)(e & 8191u)) * HD + hi * 8;
#pragma unroll
            for (int d0 = 0; d0 < 4; ++d0) qn[d0] = *(const bf16x8*)(qp + d0 * 16); }
        for (int i = tid; i < n; i += NWAVES * 64) ql[i] = sp[i];
        stage_wait();
        for (int g = wid; g < ngroups; g += NWAVES) {
            const int idx = g * 32 + r32; const unsigned e = ql[idx < n ? idx : n - 1]; const int tl = (int)(e & 8191u);
            bf16x8 qr[4];
#pragma unroll
            for (int d0 = 0; d0 < 4; ++d0) qr[d0] = qn[d0];
            if (g + NWAVES < ngroups) { const int ix = (g + NWAVES) * 32 + r32; const unsigned en = ql[ix < n ? ix : n - 1]; const bf16* qp = Q + ((size_t)(b * NH + h) * SEQ + (int)(en & 8191u)) * HD + hi * 8;
#pragma unroll
                for (int d0 = 0; d0 < 4; ++d0) qn[d0] = *(const bf16x8*)(qp + d0 * 16); }
            f32x16 o0, o1; float mhat, lsum;
            wave_block<false>(qr, (lds_cptr)(F.lds + L_K), (lds_cptr)(F.lds + L_V), 4, 0, wsf, lane, o0, o1, mhat, lsum);
#if defined(PROBE3_EPI2)
            _Pragma("unroll 1") for (int rep3_ = 0; rep3_ < 2; ++rep3_) {
#else
            {
#endif
            stage_o(o0, o1, lsum, wsf, stg, lane);
            if (hi == 0 && idx < n) plse[((size_t)(e >> 13) * M + (size_t)(b * SEQ + tl)) * 16 + h] = mhat + __builtin_amdgcn_logf(lsum);
#pragma unroll
            for (int i = 0; i < 4; ++i) { const int row = i * 8 + (lane >> 3), ch = lane & 7, ix = g * 32 + row;
                if (ix < n) { const unsigned e2 = ql[ix]; const unsigned rk = e2 >> 13; const size_t t2 = (size_t)(b * SEQ) + (e2 & 8191u);
                    unsigned char* pb = (rk == 2u) ? (ws + WS_P2) : ((unsigned char*)P.out + (size_t)rk * PART_STRIDE);
                    *(u32x4*)(pb + (t2 * D + h * HD + ch * 8) * 2) = *(const LAS u32x4*)(stg + row * 64 + ch * 8); } }
            LDS_WAIT();
            }
        }
        LDS_WAIT(); __syncthreads();
        if (tid == 0) misc[0] = nxt;
        LDS_WAIT(); __syncthreads();
    }
}

__device__ __forceinline__ void p4_own_combine(Frame& F, const Ptrs& P) {
    const int tid_l = ltid(), lane_l = tid_l & 63; (void)lane_l;
    using namespace moba;
    unsigned char* ws = P.ws; asm volatile("" : "+v"(ws));
    unsigned char* outp = (unsigned char*)P.out; asm volatile("" : "+v"(outp));
    const bf16* Q = (const bf16*)(ws + WS_Q); const bf16* K = (const bf16*)(ws + WS_K); const bf16* V = (const bf16*)(ws + WS_V); bf16* O = (bf16*)(ws + WS_AB);
    const float* plse = (const float*)(ws + WS_PLSE);
    const int lane = lane_l, wid = F.wave, r32 = lane & 31, hi = lane >> 5, widv = tid_l >> 6;
    LAS float* wsf = (LAS float*)(F.lds + L_WS) + widv * 256; LAS unsigned short* stg = (LAS unsigned short*)(F.lds + L_STG) + widv * 2048;
    for (int unit = F.vcu; unit < BATCH * NH * NBLK; unit += F.G) {
        const int bh = unit >> 5, cur = unit & 31, b = bh >> 4, h = bh & 15;
        stage_kv(K, V, b, h, cur, F.lds, wid, lane);
        const size_t t0 = (size_t)b * SEQ + (size_t)cur * MB + widv * 32;
        const bf16* qp = Q + ((size_t)(b * NH + h) * SEQ + (size_t)cur * MB + widv * 32 + r32) * HD + hi * 8;
        bf16x8 qr[4];
#pragma unroll
        for (int d0 = 0; d0 < 4; ++d0) qr[d0] = *(const bf16x8*)(qp + d0 * 16);
        const int nv = cur < 3 ? cur : 3;
        float lr[3];
#pragma unroll
        for (int r = 0; r < 3; ++r) lr[r] = (r < nv) ? plse[((size_t)r * M + t0 + r32) * 16 + h] : -INFINITY;
        stage_wait();
#if defined(PROBE4_STAGE2)
        stage_kv(K, V, b, h, cur, F.lds, wid, lane); stage_wait();
#endif
        f32x16 o0, o1; float mhat, lsum;
        wave_block<true>(qr, (lds_cptr)(F.lds + L_K), (lds_cptr)(F.lds + L_V), (wid >> 1) + 1, widv * 32 + r32, wsf, lane, o0, o1, mhat, lsum);
#if defined(PROBE4_COMP2)
        asm volatile("" : "+v"(o0), "+v"(o1), "+v"(mhat), "+v"(lsum)); wave_block<true>(qr, (lds_cptr)(F.lds + L_K), (lds_cptr)(F.lds + L_V), (wid >> 1) + 1, widv * 32 + r32, wsf, lane, o0, o1, mhat, lsum);
#endif
        stage_o(o0, o1, lsum, wsf, stg, lane);
        { const float l0 = mhat + __builtin_amdgcn_logf(lsum); float mx = l0;
#pragma unroll
          for (int r = 0; r < 3; ++r) mx = __builtin_fmaxf(mx, lr[r]);
          const float w0 = __builtin_amdgcn_exp2f(l0 - mx); float wr[3]; float ws_ = w0;
#pragma unroll
          for (int r = 0; r < 3; ++r) { wr[r] = __builtin_amdgcn_exp2f(lr[r] - mx); ws_ += wr[r]; }
          const float inv = 1.0f / ws_;
          if (hi == 0) { wsf[64 + r32 * 4] = w0 * inv; wsf[64 + r32 * 4 + 1] = wr[0] * inv; wsf[64 + r32 * 4 + 2] = wr[1] * inv; wsf[64 + r32 * 4 + 3] = wr[2] * inv; } }
        LDS_WAIT();
#if defined(PROBE4_COMB2)
        _Pragma("unroll 1") for (int rep2_ = 0; rep2_ < 2; ++rep2_) {
#else
        {
#endif
        u32x4 pwv[4][3];
#pragma unroll
        for (int i = 0; i < 4; ++i) { const size_t off = (t0 + i * 8 + (lane >> 3)) * D + h * HD + (lane & 7) * 8;
#pragma unroll
            for (int r = 0; r < 3; ++r) { const int rr = (r < nv) ? r : 0; const unsigned char* pb = (rr == 2) ? (ws + WS_P2) : (outp + (size_t)rr * PART_STRIDE); pwv[i][r] = __builtin_nontemporal_load((const u32x4*)(pb + off * 2)); } }
#pragma unroll
        for (int i = 0; i < 4; ++i) { const int row = i * 8 + (lane >> 3), ch = lane & 7; const size_t off = (t0 + row) * D + h * HD + ch * 8;
            const u32x4 ow = *(const LAS u32x4*)(stg + row * 64 + ch * 8); const float w0 = wsf[64 + row * 4];
            float a[8] = {w0 * bflo(ow.x), w0 * bfhi(ow.x), w0 * bflo(ow.y), w0 * bfhi(ow.y), w0 * bflo(ow.z), w0 * bfhi(ow.z), w0 * bflo(ow.w), w0 * bfhi(ow.w)};
#pragma unroll
            for (int r = 0; r < 3; ++r) { const u32x4 pw = pwv[i][r]; const float w = (r < nv) ? wsf[64 + row * 4 + 1 + r] : 0.f; const bool ok = r < nv;
                a[0] += ok ? w * bflo(pw.x) : 0.f; a[1] += ok ? w * bfhi(pw.x) : 0.f; a[2] += ok ? w * bflo(pw.y) : 0.f; a[3] += ok ? w * bfhi(pw.y) : 0.f;
                a[4] += ok ? w * bflo(pw.z) : 0.f; a[5] += ok ? w * bfhi(pw.z) : 0.f; a[6] += ok ? w * bflo(pw.w) : 0.f; a[7] += ok ? w * bfhi(pw.w) : 0.f; }
            v4u w; w.x = pk2(a[0], a[1]); w.y = pk2(a[2], a[3]); w.z = pk2(a[4], a[5]); w.w = pk2(a[6], a[7]); *(v4u*)(O + off) = w; }
        }
        LDS_WAIT(); __syncthreads();
    }
}

namespace mls {
using namespace moba;
typedef float f32x4v __attribute__((ext_vector_type(4)));
constexpr int XTRA_OFF = LDSCTL_OFF + 512;
__device__ __forceinline__ float softcap_f(float g) { const float x = g * (1.0f / SOFTCAP); const float e = fexp(2.0f * x); return SOFTCAP * (e - 1.0f) / (e + 1.0f); }
__device__ __forceinline__ float logsigmoid_f(float f) { return fminf(f, 0.f) - __builtin_amdgcn_logf(1.0f + fexp(-fabsf(f))) * 0.6931471805599453f; }
__device__ __forceinline__ float scan_add(float v, int lane) {
#pragma unroll
    for (int o = 1; o < 64; o <<= 1) { const float t = __shfl_up(v, o); if (lane >= o) v += t; }
    return v; }
__device__ __forceinline__ float scan_max(float v, int lane) {
#pragma unroll
    for (int o = 1; o < 64; o <<= 1) { const float t = __shfl_up(v, o); if (lane >= o) v = fmaxf(v, t); }
    return v; }
__device__ __forceinline__ bf16x8 trfrag(lds_cptr p, int ks) { const s16x4 lo = vtr(p + ks * 1024), hi = vtr(p + ks * 1024 + 512); return (bf16x8){lo[0], lo[1], lo[2], lo[3], hi[0], hi[1], hi[2], hi[3]}; }
__device__ __forceinline__ v4u scale8(const v4u w, float s) { v4u o; o.x = cvtpk_s(bflo(w.x) * s, bfhi(w.x) * s); o.y = cvtpk_s(bflo(w.y) * s, bfhi(w.y) * s); o.z = cvtpk_s(bflo(w.z) * s, bfhi(w.z) * s); o.w = cvtpk_s(bflo(w.w) * s, bfhi(w.w) * s); return o; }
}

__device__ __forceinline__ void pa_mlstm_local(Frame& F, const Ptrs& P) {
    const int tid_l = ltid(), lane_l = tid_l & 63; (void)lane_l;
    using namespace mls;
    unsigned char* ws = P.ws;
    const bf16* HB = (const bf16*)(ws + WS_AB); const bf16* MK = (const bf16*)(ws + WS_MK); const bf16* MV = (const bf16*)(ws + WS_MV);
    const bf16* WGb = (const bf16*)(ws + WS_WG); const float* ssq = (const float*)(ws + WS_SSQ) + (size_t)2 * M * 16;
    bf16* cloc = (bf16*)(ws + WS_CLOC); float* nloc = (float*)(ws + WS_NLOC); float* scal = (float*)(ws + WS_SCAL); float* BIG = (float*)(ws + WS_BIG);
    const int tid = tid_l, lane = tid & 63, wid = F.wave, r32 = lane & 31, hi = lane >> 5, fr = lane & 15, fq = lane >> 4;
    LAS float* gpart = (LAS float*)(F.lds + RING_OFF);
    LAS float* igA = (LAS float*)(F.lds + XTRA_OFF); LAS float* lfA = igA + 8 * 64;
    LAS unsigned char* kimg = F.lds + RING_OFF + wid * 16384; LAS unsigned char* vimg = kimg + 8192;
    const lds_cptr ktr = (lds_cptr)kimg + ((lane >> 4) & 1) * 32 + (lane & 3) * 8 + (4 * hi + ((lane & 15) >> 2)) * 64;
    const lds_cptr vtrp = ktr + 8192;
    for (int unit = F.vcu; unit < BATCH * NCH; unit += F.G) {
        const int b = unit >> 7, c = unit & 127; const size_t t0 = (size_t)b * SEQ + (size_t)c * LCH;
        {
            pg8::f32x4 acc[4];
#pragma unroll
            for (int m = 0; m < 4; ++m) acc[m] = (pg8::f32x4){0.f, 0.f, 0.f, 0.f};
#pragma unroll
            for (int ks = 0; ks < 4; ++ks) { const int k0 = wid * 128 + ks * 32 + fq * 8;
                const bf16x8 bw = *(const bf16x8*)(WGb + (size_t)fr * D + k0);
#pragma unroll
                for (int m = 0; m < 4; ++m) { const bf16x8 a = *(const bf16x8*)(HB + (t0 + m * 16 + fr) * D + k0); acc[m] = __builtin_amdgcn_mfma_f32_16x16x32_bf16(a, bw, acc[m], 0, 0, 0); } }
#pragma unroll
            for (int m = 0; m < 4; ++m)
#pragma unroll
                for (int r = 0; r < 4; ++r) gpart[(wid * 64 + m * 16 + 4 * fq + r) * 16 + fr] = acc[m][r];
        }
        LDS_WAIT(); __syncthreads();
#pragma unroll
        for (int e = 0; e < 2; ++e) { const int o = tid * 2 + e, row = o >> 4, col = o & 15; float s = 0.f;
#pragma unroll
            for (int w = 0; w < 8; ++w) s += gpart[(w * 64 + row) * 16 + col];
            const float val = softcap_f(s * pg8::row_rstd(ssq, (int)t0 + row) + P.b_gates[col]);
            if (col < 8) igA[col * 64 + row] = val; else lfA[(col - 8) * 64 + row] = logsigmoid_f(val); }
        LDS_WAIT(); __syncthreads();
        const int h = wid, mu = (b * MH + h) * NCH + c;
        const float ig = igA[h * 64 + lane], bcum = scan_add(lfA[h * 64 + lane], lane), bL = __shfl(bcum, 63);
        const float a = bL - bcum + ig, ml = wave_max(a), wgt = fexp(a - ml);
        BIG[(size_t)mu * 128 + lane] = bcum; BIG[(size_t)mu * 128 + 64 + lane] = ig;
        if (lane == 0) { scal[mu] = ml; scal[NUNIT + mu] = bL; }
        const int lr = lane >> 3, lc = lane & 7;
        {
            const v4u* kp = (const v4u*)(MK + ((size_t)(b * MH + h) * SEQ + (size_t)c * LCH + lr) * DK) + lc; v4u kx[8];
#pragma unroll
            for (int i = 0; i < 8; ++i) kx[i] = kp[(size_t)i * 64];
#pragma unroll
            for (int i = 0; i < 8; ++i) *(LAS v4u*)(kimg + (lc >> 2) * 4096 + (8 * i + lr) * 64 + (lc & 3) * 16) = scale8(kx[i], __shfl(wgt, 8 * i + lr));
        }
#pragma unroll 1
        for (int rv = 0; rv < 2; ++rv) {
            { const v4u* vp = (const v4u*)(MV + ((size_t)(b * MH + h) * SEQ + (size_t)c * LCH + lr) * DV + rv * 64) + lc; v4u vx[8];
#pragma unroll
              for (int i = 0; i < 8; ++i) vx[i] = vp[(size_t)i * 8 * 16];
#pragma unroll
              for (int i = 0; i < 8; ++i) *(LAS v4u*)(vimg + (lc >> 2) * 4096 + (8 * i + lr) * 64 + (lc & 3) * 16) = vx[i]; }
            LDS_WAIT();
#pragma unroll
            for (int kt = 0; kt < 2; ++kt) {
                bf16x8 af[4];
#pragma unroll
                for (int ks = 0; ks < 4; ++ks) af[ks] = trfrag(ktr + kt * 4096, ks);
#pragma unroll
                for (int vt = 0; vt < 2; ++vt) {
                    f32x16 d = f32x16{};
#pragma unroll
                    for (int ks = 0; ks < 4; ++ks) d = MOBA_MFMA(af[ks], trfrag(vtrp + vt * 4096, ks), d);
                    bf16* cp = cloc + (size_t)mu * 8192 + (size_t)(rv * 64 + vt * 32 + r32) * 64 + kt * 32 + 4 * hi;
#pragma unroll
                    for (int g = 0; g < 4; ++g) { uint2 w; w.x = cvtpk_s(d[4 * g], d[4 * g + 1]); w.y = cvtpk_s(d[4 * g + 2], d[4 * g + 3]); *(uint2*)(cp + 8 * g) = w; }
                }
                if (rv == 0) {
                    const bf16x8 ones = (bf16x8){0x3F80, 0x3F80, 0x3F80, 0x3F80, 0x3F80, 0x3F80, 0x3F80, 0x3F80};
                    f32x16 d = f32x16{};
#pragma unroll
                    for (int ks = 0; ks < 4; ++ks) d = MOBA_MFMA(af[ks], ones, d);
                    if (r32 == 0) {
#pragma unroll
                        for (int r = 0; r < 16; ++r) nloc[(size_t)mu * 64 + kt * 32 + crow(r, hi)] = d[r]; }
                }
            }
            LDS_WAIT();
        }
        LDS_WAIT(); __syncthreads();
    }
}
__device__ __forceinline__ void pb_mlstm_scan(Frame& F, const Ptrs& P, bool dry = false) {
    const int tid_l = ltid(), lane_l = tid_l & 63; (void)lane_l;
    unsigned char* ws = P.ws;
    bf16* cloc = (bf16*)(ws + WS_CLOC); float* nloc = (float*)(ws + WS_NLOC); float* scal = (float*)(ws + WS_SCAL);
    LAS float* dec = (LAS float*)(F.lds + RING_OFF); LAS float* scl = dec + NCH;
    const int tid = tid_l;
    for (int unit = F.vcu; unit < BATCH * MH * 16; unit += F.G) {
        const int bh = unit >> 4, sl = unit & 15;
        if (tid < 64) {
            float mp = 0.f;
            for (int c = 0; c < NCH; ++c) { const int mu = bh * NCH + c; const float ml = scal[mu], bl = scal[NUNIT + mu];
                const float mn = fmaxf(bl + mp, ml);
                if (tid == 0) { dec[c] = fexp(bl + mp - mn); scl[c] = fexp(ml - mn); if (sl == 0 && !dry) scal[2 * NUNIT + mu] = mp; }
                mp = mn; }
        }
        LDS_WAIT(); __syncthreads();
        { bf16* p = cloc + (size_t)bh * NCH * 8192 + sl * 512 + tid; bf16* pw = dry ? p + (size_t)32 * MiB / 2 : p; float st = 0.f;
#pragma unroll 1
          for (int c0 = 0; c0 < NCH; c0 += 32) { unsigned short x[32];
#pragma unroll
              for (int i = 0; i < 32; ++i) x[i] = p[(size_t)(c0 + i) * 8192];
#pragma unroll
              for (int i = 0; i < 32; ++i) { pw[(size_t)(c0 + i) * 8192] = (bf16)f2bf(st); st = dec[c0 + i] * st + scl[c0 + i] * bf2f(x[i]); } } }
        if (sl == 0 && tid < 64 && !dry) { float* p = nloc + (size_t)bh * NCH * 64 + tid; float st = 0.f;
#pragma unroll 1
            for (int c0 = 0; c0 < NCH; c0 += 16) { float x[16];
#pragma unroll
                for (int i = 0; i < 16; ++i) x[i] = p[(size_t)(c0 + i) * 64];
#pragma unroll
                for (int i = 0; i < 16; ++i) { p[(size_t)(c0 + i) * 64] = st; st = dec[c0 + i] * st + scl[c0 + i] * x[i]; } } }
        LDS_WAIT(); __syncthreads();
    }
}
__device__ __forceinline__ void pc_mlstm_out(Frame& F, const Ptrs& P) {
    const int tid_l = ltid(), lane_l = tid_l & 63; (void)lane_l;
    using namespace mls;
    unsigned char* ws = P.ws;
    const bf16* MQ = (const bf16*)(ws + WS_MQ); const bf16* MK = (const bf16*)(ws + WS_MK); const bf16* MV = (const bf16*)(ws + WS_MV); const bf16* OG = (const bf16*)(ws + WS_OG);
    const bf16* cin = (const bf16*)(ws + WS_CLOC); const float* nin = (const float*)(ws + WS_NLOC); const float* scal = (const float*)(ws + WS_SCAL); const float* BIG = (const float*)(ws + WS_BIG);
    bf16* Y = (bf16*)(ws + WS_Y);
    const int tid = tid_l, lane = tid & 63, wid = F.wave, r32 = lane & 31, hi = lane >> 5, qg = wid & 1, vt = wid >> 1;
    constexpr int LBUF = 24576, LK = 0, LV = 8192, LH = 2 * LBUF, HP = 132;
    LAS float* hst = (LAS float*)(F.lds + RING_OFF + LH);
    LAS float* arrs = (LAS float*)(F.lds + mls::XTRA_OFF); LAS float* wsf = arrs + 2 * 256 + wid * 64;
    const int l = qg * 32 + r32, rl = tid >> 3, rvb = (tid & 7) * 16;
    bf16x8 qn[4], cn[4]; v4u ogn[2]; f32x4 hnn[4]; float m_in_n = 0.f;
#define PC_ISSUE(unit_, par_) do { const int u_ = (unit_), bh_ = u_ >> 7, c_ = u_ & 127, b_ = bh_ >> 3, h_ = bh_ & 7; const size_t t_ = (size_t)b_ * SEQ + (size_t)c_ * LCH, r_ = (size_t)bh_ * SEQ + (size_t)c_ * LCH; (void)t_; (void)h_; \
        const unsigned lds0_ = (unsigned)(uintptr_t)(F.lds + RING_OFF) + (par_) * LBUF; \
        glds16(MK + (r_ + lane) * DK + wid * 8, (unsigned)__builtin_amdgcn_readfirstlane(lds0_ + LK + wid * 1024)); \
        _Pragma("unroll") for (int i_ = 0; i_ < 2; ++i_) { const int p_ = wid + 8 * i_; \
            glds16(MV + (r_ + 16 * (p_ & 3) + (lane >> 2)) * DV + (p_ >> 2) * 32 + (lane & 3) * 8, (unsigned)__builtin_amdgcn_readfirstlane(lds0_ + LV + p_ * 1024)); } \
        { const bf16* qp_ = MQ + (r_ + l) * DK + hi * 8; _Pragma("unroll") for (int d0 = 0; d0 < 4; ++d0) qn[d0] = *(const bf16x8*)(qp_ + d0 * 16); \
          const bf16* cp_ = cin + (size_t)u_ * 8192 + (size_t)(vt * 32 + r32) * 64 + hi * 8; _Pragma("unroll") for (int d0 = 0; d0 < 4; ++d0) cn[d0] = *(const bf16x8*)(cp_ + d0 * 16); } \
        { const v4u* gp_ = (const v4u*)(OG + (r_ + rl) * DV + rvb); ogn[0] = gp_[0]; ogn[1] = gp_[1]; const f32x4* np_ = (const f32x4*)(P.head_norm + h_ * DV + rvb); hnn[0] = np_[0]; hnn[1] = np_[1]; hnn[2] = np_[2]; hnn[3] = np_[3]; } \
        m_in_n = scal[2 * NUNIT + u_]; \
        if (wid == 0) { LAS float* a_ = arrs + (par_) * 256; const float bc_ = BIG[(size_t)u_ * 128 + lane], g_ = BIG[(size_t)u_ * 128 + 64 + lane] - bc_; \
            a_[lane] = g_; a_[64 + lane] = fmaxf(m_in_n, scan_max(g_, lane)); a_[128 + lane] = bc_; a_[192 + lane] = nin[(size_t)u_ * 64 + lane]; } } while (0)
    int it = 0;
    if (F.vcu < NUNIT) PC_ISSUE(F.vcu, 0);
    for (int unit = F.vcu; unit < NUNIT; unit += F.G, ++it) {
        const int par = it & 1, bh = unit >> 7, c = unit & 127, b = bh >> 3, h = bh & 7; const size_t t0 = (size_t)b * SEQ + (size_t)c * LCH;
        asm volatile("s_waitcnt vmcnt(0) lgkmcnt(0)\n\ts_barrier" ::: "memory");
        bf16x8 qr[4], cf[4]; v4u ogv[2]; f32x4 hnv[4];
#pragma unroll
        for (int d0 = 0; d0 < 4; ++d0) { qr[d0] = qn[d0]; cf[d0] = cn[d0]; hnv[d0] = hnn[d0]; }
        ogv[0] = ogn[0]; ogv[1] = ogn[1];
        const float m_in = m_in_n; const size_t roff = (t0 + rl) * D + h * DV + rvb;
        if (unit + F.G < NUNIT) PC_ISSUE(unit + F.G, par ^ 1);
        LAS float* garr = arrs + par * 256; LAS float* mmarr = garr + 64; LAS float* barr = garr + 128; LAS float* nn = garr + 192;
        const lds_cptr kp0 = (lds_cptr)(F.lds + RING_OFF + par * LBUF + LK) + hi * 1024 + r32 * 16;
        const lds_cptr vp0 = (lds_cptr)(F.lds + RING_OFF + par * LBUF + LV) + vt * 4096 + ((lane >> 4) & 1) * 32 + (lane & 3) * 8 + (4 * hi + ((lane & 15) >> 2)) * 64;
        {
            bf16x8 kf[8];
#pragma unroll
            for (int d0 = 0; d0 < 4; ++d0) { kf[2 * d0] = *(const LAS bf16x8*)(kp0 + d0 * 2048); kf[2 * d0 + 1] = *(const LAS bf16x8*)(kp0 + d0 * 2048 + 512); }
            f32x16 c0 = f32x16{}, c1 = f32x16{};
#pragma unroll
            for (int d0 = 0; d0 < 4; ++d0) { c0 = MOBA_MFMA(kf[2 * d0], qr[d0], c0); c1 = MOBA_MFMA(kf[2 * d0 + 1], qr[d0], c1); }
            const float mml = mmarr[l];
            float rsum = 0.f; int lrel = l - 4 * hi; asm volatile("" : "+v"(lrel));
#pragma unroll
            for (int r = 0; r < 16; ++r) { const int s0 = crow(r, hi), s1 = s0 + 32, sr = (r & 3) + 8 * (r >> 2);
                const float e0 = __builtin_amdgcn_exp2f((garr[s0] - mml) * LOG2E), e1 = __builtin_amdgcn_exp2f((garr[s1] - mml) * LOG2E);
                c0[r] = __builtin_bit_cast(float, __builtin_bit_cast(unsigned, c0[r] * e0) & ~(unsigned)((lrel - sr) >> 31));
                c1[r] = __builtin_bit_cast(float, __builtin_bit_cast(unsigned, c1[r] * e1) & ~(unsigned)((lrel - sr - 32) >> 31)); rsum += c0[r] + c1[r]; }
            rsum = halves_sum(rsum);
            float qn = 0.f;
#pragma unroll
            for (int d0 = 0; d0 < 4; ++d0)
#pragma unroll
                for (int j = 0; j < 8; ++j) qn += bf2f((unsigned short)qr[d0][j]) * nn[d0 * 16 + hi * 8 + j];
            qn = halves_sum(qn);
            const float inter = fexp(m_in - mml), den = inter * qn + rsum, rd = 1.0f / fmaxf(fabsf(den), fexp(-(barr[l] + mml)));
            if (hi == 0) { wsf[r32] = inter; wsf[32 + r32] = rd; }
            f32x16 o = f32x16{};
#pragma unroll
            for (int d0 = 0; d0 < 4; ++d0) o = MOBA_MFMA(qr[d0], cf[d0], o);
            asm volatile("s_waitcnt lgkmcnt(0)" ::: "memory");
#pragma unroll
            for (int r = 0; r < 16; ++r) o[r] *= wsf[crow(r, hi)];
            u32x4 pw0, pw1, pw2, pw3;
            pw0 = (u32x4){cvtpk_s(c0[0], c0[1]), cvtpk_s(c0[2], c0[3]), cvtpk_s(c0[4], c0[5]), cvtpk_s(c0[6], c0[7])}; pw1 = (u32x4){cvtpk_s(c0[8], c0[9]), cvtpk_s(c0[10], c0[11]), cvtpk_s(c0[12], c0[13]), cvtpk_s(c0[14], c0[15])};
            pw2 = (u32x4){cvtpk_s(c1[0], c1[1]), cvtpk_s(c1[2], c1[3]), cvtpk_s(c1[4], c1[5]), cvtpk_s(c1[6], c1[7])}; pw3 = (u32x4){cvtpk_s(c1[8], c1[9]), cvtpk_s(c1[10], c1[11]), cvtpk_s(c1[12], c1[13]), cvtpk_s(c1[14], c1[15])};
            o = MOBA_MFMA(__builtin_bit_cast(bf16x8, pw0), trfrag(vp0, 0), o); o = MOBA_MFMA(__builtin_bit_cast(bf16x8, pw1), trfrag(vp0, 1), o);
            o = MOBA_MFMA(__builtin_bit_cast(bf16x8, pw2), trfrag(vp0, 2), o); o = MOBA_MFMA(__builtin_bit_cast(bf16x8, pw3), trfrag(vp0, 3), o);
#pragma unroll
            for (int r = 0; r < 16; ++r) hst[(qg * 32 + crow(r, hi)) * HP + vt * 32 + r32] = o[r] * wsf[32 + crow(r, hi)];
        }
        LDS_WAIT(); __syncthreads();
        {
            float hv[16]; float ss = 0.f;
#pragma unroll
            for (int j = 0; j < 4; ++j) { const mls::f32x4v x = *(const LAS mls::f32x4v*)(hst + rl * HP + rvb + 4 * j); hv[4 * j] = x.x; hv[4 * j + 1] = x.y; hv[4 * j + 2] = x.z; hv[4 * j + 3] = x.w; ss += (x.x * x.x + x.y * x.y) + (x.z * x.z + x.w * x.w); }
            ss += __shfl_xor(ss, 1); ss += __shfl_xor(ss, 2); ss += __shfl_xor(ss, 4);
            const float r = __builtin_amdgcn_rsqf(ss * (1.0f / 128.0f) + RMS_EPS);
            float y[16];
#pragma unroll
            for (int i = 0; i < 2; ++i) { const v4u u = ogv[i]; const f32x4 n0 = hnv[2 * i], n1 = hnv[2 * i + 1];
                y[8 * i] = bflo(u.x) * hv[8 * i] * r * n0.x; y[8 * i + 1] = bfhi(u.x) * hv[8 * i + 1] * r * n0.y; y[8 * i + 2] = bflo(u.y) * hv[8 * i + 2] * r * n0.z; y[8 * i + 3] = bfhi(u.y) * hv[8 * i + 3] * r * n0.w;
                y[8 * i + 4] = bflo(u.z) * hv[8 * i + 4] * r * n1.x; y[8 * i + 5] = bfhi(u.z) * hv[8 * i + 5] * r * n1.y; y[8 * i + 6] = bflo(u.w) * hv[8 * i + 6] * r * n1.z; y[8 * i + 7] = bfhi(u.w) * hv[8 * i + 7] * r * n1.w; }
            v4u* yp = (v4u*)(Y + roff);
#pragma unroll
            for (int i = 0; i < 2; ++i) { v4u o; o.x = pk2(y[8 * i], y[8 * i + 1]); o.y = pk2(y[8 * i + 2], y[8 * i + 3]); o.z = pk2(y[8 * i + 4], y[8 * i + 5]); o.w = pk2(y[8 * i + 6], y[8 * i + 7]); yp[i] = o; }
        }
    }
#undef PC_ISSUE
    LDS_WAIT(); __syncthreads();
}
__device__ __forceinline__ void p_final_norm(Frame& F, const Ptrs& P, bool dry = false) {
    const int tid_l = ltid(), lane_l = tid_l & 63; (void)lane_l;
    const int gw = F.vcu * NWAVES + F.wave, NGW = F.G * NWAVES;
    const bf16* hb = (const bf16*)(P.ws + WS_AB); const float* ssq = (const float*)(P.ws + WS_SSQ);
    f32x4 wn[4];
#pragma unroll
    for (int j = 0; j < 4; ++j) wn[j] = ((const f32x4*)P.final_norm)[lane_l * 4 + j];
    for (int m = gw; m < M; m += NGW) {
        const v4u* hr = (const v4u*)(hb + (size_t)m * D) + lane_l * 2;
        const v4u a = hr[0], b = hr[1];
        const float r = pg8::row_rstd(ssq, m);
        float* orow = (dry ? (float*)(P.ws + WS_Q) : P.out) + (size_t)m * D + lane_l * 16;
        f32x4 o0 = (f32x4){bflo(a.x), bfhi(a.x), bflo(a.y), bfhi(a.y)} * r * wn[0], o1 = (f32x4){bflo(a.z), bfhi(a.z), bflo(a.w), bfhi(a.w)} * r * wn[1];
        f32x4 o2 = (f32x4){bflo(b.x), bfhi(b.x), bflo(b.y), bfhi(b.y)} * r * wn[2], o3 = (f32x4){bflo(b.z), bfhi(b.z), bflo(b.w), bfhi(b.w)} * r * wn[3];
        ((f32x4*)orow)[0] = o0; ((f32x4*)orow)[1] = o1; ((f32x4*)orow)[2] = o2; ((f32x4*)orow)[3] = o3;
    }
}

struct Args { Ptrs p; };
__device__ __forceinline__ Ptrs load_ptrs() {
#if defined(__HIP_DEVICE_COMPILE__)
    typedef __attribute__((address_space(4))) const unsigned long long* kptr_t;
    kptr_t kp = (kptr_t)__builtin_amdgcn_kernarg_segment_ptr();
    asm volatile("" : "+s"(kp));
    Ptrs p;
    p.x = (const float*)kp[0]; p.attn_norm = (const float*)kp[1]; p.w_qkv = (const float*)kp[2]; p.w_o = (const float*)kp[3]; p.mlstm_norm = (const float*)kp[4]; p.w_in = (const float*)kp[5];
    p.b_gates = (const float*)kp[6]; p.head_norm = (const float*)kp[7]; p.w_out = (const float*)kp[8]; p.ffn_norm = (const float*)kp[9]; p.w_gu = (const float*)kp[10]; p.w_down = (const float*)kp[11];
    p.final_norm = (const float*)kp[12]; p.out = (float*)kp[13]; p.ws = (unsigned char*)kp[14];
    return p;
#else
    return Ptrs{};
#endif
}
__global__ void __launch_bounds__(NWAVES * 64, 2) mk_fwd(Args args) {
    extern __shared__ __attribute__((aligned(16))) unsigned char lds[];
    Frame F;
    F.lds = (LAS unsigned char*)lds;
    F.MISC = (volatile LAS unsigned*)(F.lds + MISC_OFF);
    F.wave = __builtin_amdgcn_readfirstlane((int)threadIdx.x >> 6);
    F.G = gridDim.x; { const int bx = blockIdx.x; F.vcu = (F.G % 8 == 0) ? (bx % 8) * (F.G / 8) + bx / 8 : bx; }
    F.ctl = (gu32*)(args.p.ws + WS_CTL);
    for (int u = ((int)threadIdx.x); u < (LDS_BYTES - LDSCTL_OFF) / 4; u += NWAVES * 64) ((LAS unsigned*)(F.lds + LDSCTL_OFF))[u] = 0u;
    __syncthreads();
    XcdBarrier bar = xcd_barrier_post((unsigned*)(F.ctl + CW_BAR), F.MISC + 8);
#define GRID_BAR() xcd_barrier(bar)
#ifndef PH_MASK
#define PH_MASK 0xFFFFF
#endif
#define PH(k) ((PH_MASK >> (k)) & 1)
#ifndef DUP_MASK
#define DUP_MASK 0
#endif
#ifndef EXTRA_BARS
#define EXTRA_BARS 0
#endif
#define REP(k) for (int rep_ = 0; rep_ <= ((DUP_MASK >> (k)) & 1); ++rep_)
#ifndef STAGGER_TICKS
#define STAGGER_TICKS 0
#endif
#define STAGGER() do { if (STAGGER_TICKS && (blockIdx.x & 1)) { const unsigned long long t0_ = __builtin_amdgcn_s_memrealtime(); while (__builtin_amdgcn_s_memrealtime() - t0_ < STAGGER_TICKS) __builtin_amdgcn_s_sleep(8); } } while (0)
#define PHASE_PTRS() const Ptrs P = load_ptrs(); unsigned char* const ws = P.ws; (void)ws
#define SSQ(i) ((float*)(ws + WS_SSQ) + (size_t)(i) * M * 16)

    REP(0) if (PH(0)) { PHASE_PTRS(); p0_prologue(F, P); } GRID_BAR();
    _Pragma("unroll 1") for (int xb_ = 0; xb_ < EXTRA_BARS; ++xb_) GRID_BAR();
    REP(1) if (PH(1)) { PHASE_PTRS(); pg8::Gemm g{(const bf16*)(ws + WS_AB), (const bf16*)(ws + WS_WQKV), M, 3 * D, D}; pg8::StaticOrder S; S.init(M, 3 * D, F.G, (int)blockIdx.x);
      pg8::EpiQKV E{(bf16*)(ws + WS_Q), (size_t)(WS_K - WS_Q) / 2, SSQ(0), (const float*)(ws + WS_ROPE), (float*)(ws + WS_KMEAN)};
      pg8::gemm_phase<pg8::EpiQKV, pg8::StaticOrder, PG8_ALIGN, PG8_SP2>(F.lds + RING_OFF, g, S, E); } GRID_BAR();
    REP(2) if (PH(2)) { PHASE_PTRS(); p2_gating(F, P); } GRID_BAR();
    REP(3) if (PH(3)) { PHASE_PTRS(); p3_gathered(F, P, rep_); } GRID_BAR();
    REP(15) if (PH(15)) { PHASE_PTRS(); p4_own_combine(F, P); } GRID_BAR();
    REP(4) if (PH(4)) { PHASE_PTRS(); pg8::Gemm g{(const bf16*)(ws + WS_AB), (const bf16*)(ws + WS_WO), M, D, D}; pg8::StaticOrder S; S.init(M, D, F.G, (int)blockIdx.x);
      pg8::EpiRes<true, false> E{P.x, ws + WS_HB1, SSQ(1)};
      pg8::gemm_phase<pg8::EpiRes<true, false>, pg8::StaticOrder, PG8_ALIGN, PG8_SP2>(F.lds + RING_OFF, g, S, E); } GRID_BAR();
    REP(5) if (PH(5)) { PHASE_PTRS(); STAGGER(); pg8::Gemm g{(const bf16*)(ws + WS_HB1), (const bf16*)(ws + WS_WGU), M, NGU, D}; pg8::StaticOrder S; S.init(M, NGU, F.G, (int)blockIdx.x);
      pg8::EpiSwiGLU E{(bf16*)(ws + WS_ACT), SSQ(1)};
      pg8::gemm_phase<pg8::EpiSwiGLU, pg8::StaticOrder, PG8_ALIGN, PG8_SP2>(F.lds + RING_OFF, g, S, E); } GRID_BAR();
    REP(6) if (PH(6)) { PHASE_PTRS(); pg8::Gemm g{(const bf16*)(ws + WS_ACT), (const bf16*)(ws + WS_WD), M, D, DFF}; pg8::StaticOrder S; S.init(M, D, F.G, (int)blockIdx.x);
      pg8::EpiRes<false, false> E{ws + WS_HB1, ws + WS_AB, SSQ(2)};
      pg8::gemm_phase<pg8::EpiRes<false, false>, pg8::StaticOrder, PG8_ALIGN, PG8_SP2>(F.lds + RING_OFF, g, S, E); } GRID_BAR();
    REP(7) if (PH(7)) { PHASE_PTRS(); pg8::Gemm g{(const bf16*)(ws + WS_AB), (const bf16*)(ws + WS_WIN), M, NIN, D}; pg8::StaticOrder S; S.init(M, NIN, F.G, (int)blockIdx.x);
      pg8::EpiMlstmIn E{(bf16*)(ws + WS_MQ), (bf16*)(ws + WS_MK), (bf16*)(ws + WS_MV), (bf16*)(ws + WS_OG), SSQ(2)};
      pg8::gemm_phase<pg8::EpiMlstmIn, pg8::StaticOrder, PG8_ALIGN, PG8_SP2>(F.lds + RING_OFF, g, S, E); } GRID_BAR();
    REP(8) if (PH(8)) { PHASE_PTRS(); pa_mlstm_local(F, P); } GRID_BAR();
    REP(9) if (PH(9)) { PHASE_PTRS(); pb_mlstm_scan(F, P, rep_ < ((DUP_MASK >> 9) & 1)); } GRID_BAR();
    REP(10) if (PH(10)) { PHASE_PTRS(); pc_mlstm_out(F, P); } GRID_BAR();
    if (PH(11)) { PHASE_PTRS(); pg8::Gemm g{(const bf16*)(ws + WS_Y), (const bf16*)(ws + WS_WOUT), M, D, D}; pg8::StaticOrder S; S.init(M, D, F.G, (int)blockIdx.x);
      pg8::EpiRes<false, false> E{ws + WS_AB, ws + WS_HB1, SSQ(3)};
      pg8::gemm_phase<pg8::EpiRes<false, false>, pg8::StaticOrder, PG8_ALIGN, PG8_SP2>(F.lds + RING_OFF, g, S, E); } GRID_BAR();
    if (PH(12)) { PHASE_PTRS(); STAGGER(); pg8::Gemm g{(const bf16*)(ws + WS_HB1), (const bf16*)(ws + WS_WGU) + (size_t)NGU * D, M, NGU, D}; pg8::StaticOrder S; S.init(M, NGU, F.G, (int)blockIdx.x);
      pg8::EpiSwiGLU E{(bf16*)(ws + WS_ACT), SSQ(3)};
      pg8::gemm_phase<pg8::EpiSwiGLU, pg8::StaticOrder, PG8_ALIGN, PG8_SP2>(F.lds + RING_OFF, g, S, E); } GRID_BAR();
    if (PH(13)) { PHASE_PTRS(); pg8::Gemm g{(const bf16*)(ws + WS_ACT), (const bf16*)(ws + WS_WD) + (size_t)D * DFF, M, D, DFF}; pg8::StaticOrder S; S.init(M, D, F.G, (int)blockIdx.x);
      pg8::EpiRes<false, false> E{ws + WS_HB1, ws + WS_AB, SSQ(0)};
      pg8::gemm_phase<pg8::EpiRes<false, false>, pg8::StaticOrder, PG8_ALIGN, PG8_SP2>(F.lds + RING_OFF, g, S, E); } GRID_BAR();
    REP(14) if (PH(14)) { PHASE_PTRS(); p_final_norm(F, P, rep_ < ((DUP_MASK >> 14) & 1)); }
}

extern "C" void kernel_launch(void* const* d_in, const int* in_sizes, int n_in, void* d_out, int out_size, void* d_ws, size_t ws_size, hipStream_t stream) {
    static int grid = 0;
    if (grid == 0) {
        if (n_in != 13 || in_sizes[0] != M * D || out_size != M * D || ws_size < WS_END) { fprintf(stderr, "kernel_launch: unexpected shapes (n_in %d, in0 %d, out %d, ws %zu); nothing launched\n", n_in, n_in > 0 ? in_sizes[0] : -1, out_size, ws_size); grid = -1; return; }
        int dev = 0, cus = 0, per_cu = 0;
        if (hipGetDevice(&dev) != hipSuccess || hipDeviceGetAttribute(&cus, hipDeviceAttributeMultiprocessorCount, dev) != hipSuccess) { grid = -1; return; }
        if (hipFuncSetAttribute((const void*)mk_fwd, hipFuncAttributeMaxDynamicSharedMemorySize, LDS_BYTES) != hipSuccess) { fprintf(stderr, "kernel_launch: hipFuncSetAttribute failed\n"); grid = -1; return; }
        if (hipOccupancyMaxActiveBlocksPerMultiprocessor(&per_cu, (const void*)mk_fwd, NWAVES * 64, LDS_BYTES) != hipSuccess || per_cu < 1) { fprintf(stderr, "kernel_launch: occupancy query reports %d blocks per CU\n", per_cu); }
        (void)hipGetLastError();
        grid = cus;
    }
    if (grid < 0) return;
    if (hipMemsetAsync((char*)d_ws + WS_CTL, 0, CTL_ZERO_BYTES, stream) != hipSuccess) { fprintf(stderr, "kernel_launch: hipMemsetAsync failed\n"); return; }
    Args a{};
    a.p.x = (const float*)d_in[0]; a.p.attn_norm = (const float*)d_in[1]; a.p.w_qkv = (const float*)d_in[2]; a.p.w_o = (const float*)d_in[3];
    a.p.mlstm_norm = (const float*)d_in[4]; a.p.w_in = (const float*)d_in[5]; a.p.b_gates = (const float*)d_in[6]; a.p.head_norm = (const float*)d_in[7]; a.p.w_out = (const float*)d_in[8];
    a.p.ffn_norm = (const float*)d_in[9]; a.p.w_gu = (const float*)d_in[10]; a.p.w_down = (const float*)d_in[11]; a.p.final_norm = (const float*)d_in[12];
    a.p.out = (float*)d_out; a.p.ws = (unsigned char*)d_ws;
    hipLaunchKernelGGL(mk_fwd, dim3(grid), dim3(NWAVES * 64), LDS_BYTES, stream, a);
    const hipError_t le = hipPeekAtLastError();
    if (le != hipSuccess) fprintf(stderr, "kernel_launch: launch failed: %s\n", hipGetErrorName(le));
}
```
